# Optimizing an MI355X kernel written in HIP

```python
import jax, jax.numpy as jnp
from jax import lax
import numpy as np

D_MODEL = 1024
BATCH = 4
SEQ = 8192
DEPTH = 2

CHUNK = 64
MEM_TOKENS = 256
RMS_EPS = 1e-6
XA_HEADS = 4
XA_HEAD_DIM = D_MODEL // XA_HEADS
HGRN_HEADS = 4
HGRN_DK = 128
HGRN_DV = 128
HGRN_WIDTH = HGRN_HEADS * HGRN_DV
GLA_HEADS = 4
GLA_DK = 64
GLA_DV = 128
GLA_RANK = 16
GLA_GATE_NORMALIZER = 16.0
GLA_WIDTH = GLA_HEADS * GLA_DV
MLSTM_HEADS = 4
MLSTM_DH = 128
MLSTM_WIDTH = MLSTM_HEADS * MLSTM_DH
MLSTM_CONV = 4
MLSTM_QKV_BLOCK = 4

MIX_WIDTH = HGRN_WIDTH + GLA_WIDTH + MLSTM_WIDTH
IN_SPLITS = [
    HGRN_HEADS * HGRN_DK,
    HGRN_HEADS * HGRN_DK,
    HGRN_WIDTH,
    HGRN_WIDTH,
    GLA_HEADS * GLA_DK,
    GLA_HEADS * GLA_DK,
    GLA_WIDTH,
    GLA_RANK,
    GLA_WIDTH,
    MLSTM_WIDTH,
    MLSTM_WIDTH,
    MLSTM_HEADS,
    MLSTM_HEADS,
]
IN_COLS = 4 * HGRN_WIDTH + 2 * GLA_HEADS * GLA_DK + 2 * GLA_WIDTH + GLA_RANK + 2 * MLSTM_WIDTH + 2 * MLSTM_HEADS

kernel_name = "hybrid_hgrn2_gla_mlstm_memxattn"


def rms_norm(x, g):
    xf = x.astype(jnp.float32)
    y = xf * lax.rsqrt(jnp.mean(xf * xf, axis=-1, keepdims=True) + RMS_EPS)
    return (y * g.astype(jnp.float32)).astype(x.dtype)


def head_rms_norm(o, g):
    y = o * lax.rsqrt(jnp.mean(o * o, axis=-1, keepdims=True) + RMS_EPS) * g.astype(jnp.float32)
    return y.reshape(o.shape[0], o.shape[1], -1)


def head_layer_norm(o, g):
    mu = jnp.mean(o, axis=-1, keepdims=True)
    oc = o - mu
    y = oc * lax.rsqrt(jnp.mean(oc * oc, axis=-1, keepdims=True) + RMS_EPS)
    return y.reshape(o.shape[0], o.shape[1], -1) * g.astype(jnp.float32)


def split_heads(t, n_heads):
    return t.reshape(t.shape[0], t.shape[1], n_heads, -1)


def to_chunks(t):
    B, S, H, d = t.shape
    return t.reshape(B, S // CHUNK, CHUNK, H, d).transpose(1, 0, 3, 2, 4)


def from_chunks(t):
    n, B, H, C, d = t.shape
    return t.transpose(1, 0, 3, 2, 4).reshape(B, n * C, H, d)


def chunked_decay_linear_attention(q, k, v, log_a):
    B, S, H, dk = q.shape
    dv = v.shape[-1]
    causal = jnp.tril(jnp.ones((CHUNK, CHUNK), dtype=bool))

    def step(state, inp):
        qi, ki, vi, gi = inp
        b = jnp.cumsum(gi, axis=2)
        o_inter = jnp.einsum('bhcd,bhde->bhce', qi * jnp.exp(b), state)
        diff = b[:, :, :, None, :] - b[:, :, None, :, :]
        decay = jnp.where(causal[:, :, None], jnp.exp(jnp.minimum(diff, 0.0)), 0.0)
        scores = jnp.einsum('bhid,bhjd,bhijd->bhij', qi, ki, decay)
        o_intra = jnp.einsum('bhij,bhje->bhie', scores, vi)
        b_last = b[:, :, -1:, :]
        k_dec = ki * jnp.exp(b_last - b)
        new_state = jnp.exp(b_last[:, :, 0, :])[..., None] * state + jnp.einsum('bhjd,bhje->bhde', k_dec, vi)
        return new_state, o_inter + o_intra

    state0 = jnp.zeros((B, H, dk, dv), jnp.float32)
    _, o = lax.scan(step, state0, (to_chunks(q), to_chunks(k), to_chunks(v), to_chunks(log_a)))
    return from_chunks(o)


def chunked_mlstm(q, k, v, i_pre, log_f):
    B, S, H, dk = q.shape
    dv = v.shape[-1]
    causal = jnp.tril(jnp.ones((CHUNK, CHUNK), dtype=bool))

    def gate_chunks(g):
        return g.reshape(B, S // CHUNK, CHUNK, H).transpose(1, 0, 3, 2)

    def step(carry, inp):
        c_state, n_state, m_state = carry
        qi, ki, vi, ii, fi = inp
        b = jnp.cumsum(fi, axis=-1)
        log_d = b[..., :, None] - b[..., None, :] + ii[..., None, :]
        log_d = jnp.where(causal, log_d, -jnp.inf)
        m_inter = b + m_state[..., None]
        m_i = jnp.maximum(m_inter, jnp.max(log_d, axis=-1))
        w_inter = jnp.exp(m_inter - m_i)
        s = jnp.einsum('bhid,bhjd->bhij', qi, ki) * jnp.exp(log_d - m_i[..., None])
        num = w_inter[..., None] * jnp.einsum('bhid,bhde->bhie', qi, c_state) + jnp.einsum('bhij,bhje->bhie', s, vi)
        den = w_inter * jnp.einsum('bhid,bhd->bhi', qi, n_state) + jnp.sum(s, axis=-1)
        h = num / jnp.maximum(jnp.abs(den), jnp.exp(-m_i))[..., None]
        b_last = b[..., -1]
        log_w = b_last[..., None] - b + ii
        m_new = jnp.maximum(b_last + m_state, jnp.max(log_w, axis=-1))
        w_prev = jnp.exp(b_last + m_state - m_new)
        wj = jnp.exp(log_w - m_new[..., None])
        c_new = w_prev[..., None, None] * c_state + jnp.einsum('bhj,bhjd,bhje->bhde', wj, ki, vi)
        n_new = w_prev[..., None] * n_state + jnp.einsum('bhj,bhjd->bhd', wj, ki)
        return (c_new, n_new, m_new), h

    carry0 = (jnp.zeros((B, H, dk, dv), jnp.float32), jnp.zeros((B, H, dk), jnp.float32), jnp.zeros((B, H), jnp.float32))
    _, h = lax.scan(step, carry0, (to_chunks(q), to_chunks(k), to_chunks(v), gate_chunks(i_pre), gate_chunks(log_f)))
    return from_chunks(h)


def causal_depthwise_conv(u, w, b):
    S = u.shape[1]
    up = jnp.pad(u, ((0, 0), (MLSTM_CONV - 1, 0), (0, 0)))
    out = b.astype(jnp.float32)
    for tap in range(MLSTM_CONV):
        out = out + up[:, tap:tap + S, :] * w[tap].astype(jnp.float32)
    return out


def block_diag_proj(t, w):
    B, S, C = t.shape
    tg = t.reshape(B, S, w.shape[0], w.shape[1])
    return jnp.einsum('bsgi,gio->bsgo', tg, w.astype(jnp.float32)).reshape(B, S, C)


def memory_cross_attention(h, m, wq, wk, wv, wo):
    B, S, D = h.shape
    M = m.shape[1]
    q = (h @ wq).reshape(B, S, XA_HEADS, XA_HEAD_DIM)
    k = (m @ wk).reshape(B, M, XA_HEADS, XA_HEAD_DIM)
    v = (m @ wv).reshape(B, M, XA_HEADS, XA_HEAD_DIM)
    s = jnp.einsum('bshd,bmhd->bhsm', q, k).astype(jnp.float32) * (XA_HEAD_DIM ** -0.5)
    p = jax.nn.softmax(s, axis=-1).astype(v.dtype)
    o = jnp.einsum('bhsm,bmhd->bshd', p, v).reshape(B, S, D)
    return o @ wo


def setup_inputs(seed: int = 0) -> dict:
    key = jax.random.key(seed)
    ks = jax.random.split(key, 26)

    def nrm(k, shape, scale):
        return jax.random.normal(k, shape, jnp.float32) * scale

    def gain(k, shape):
        return 1.0 + nrm(k, shape, 0.02)

    n_blk = MLSTM_WIDTH // MLSTM_QKV_BLOCK
    return {
        "x": nrm(ks[0], (BATCH, SEQ, D_MODEL), 1.0),
        "mem": nrm(ks[1], (BATCH, MEM_TOKENS, D_MODEL), 1.0),
        "norm_mix": gain(ks[2], (DEPTH, D_MODEL)),
        "w_in": nrm(ks[3], (DEPTH, D_MODEL, IN_COLS), D_MODEL ** -0.5),
        "hgrn_lb_logits": nrm(ks[4], (DEPTH, HGRN_HEADS * HGRN_DK), 0.5),
        "hgrn_norm": gain(ks[5], (DEPTH, HGRN_DV)),
        "gla_gate_up": nrm(ks[6], (DEPTH, GLA_RANK, GLA_HEADS * GLA_DK), GLA_RANK ** -0.5),
        "gla_gate_bias": nrm(ks[7], (DEPTH, GLA_HEADS * GLA_DK), 0.1),
        "gla_norm": gain(ks[8], (DEPTH, GLA_DV)),
        "mlstm_conv_w": nrm(ks[9], (DEPTH, MLSTM_CONV, MLSTM_WIDTH), MLSTM_CONV ** -0.5),
        "mlstm_conv_b": nrm(ks[10], (DEPTH, MLSTM_WIDTH), 0.02),
        "mlstm_wq": nrm(ks[11], (DEPTH, n_blk, MLSTM_QKV_BLOCK, MLSTM_QKV_BLOCK), MLSTM_QKV_BLOCK ** -0.5),
        "mlstm_wk": nrm(ks[12], (DEPTH, n_blk, MLSTM_QKV_BLOCK, MLSTM_QKV_BLOCK), MLSTM_QKV_BLOCK ** -0.5),
        "mlstm_wv": nrm(ks[13], (DEPTH, n_blk, MLSTM_QKV_BLOCK, MLSTM_QKV_BLOCK), MLSTM_QKV_BLOCK ** -0.5),
        "mlstm_igate_bias": nrm(ks[14], (DEPTH, MLSTM_HEADS), 0.1),
        "mlstm_fgate_bias": jnp.linspace(3.0, 6.0, MLSTM_HEADS, dtype=jnp.float32)[None, :] + nrm(ks[15], (DEPTH, MLSTM_HEADS), 0.1),
        "mlstm_skip": gain(ks[16], (DEPTH, MLSTM_WIDTH)),
        "mlstm_norm": gain(ks[17], (DEPTH, MLSTM_WIDTH)),
        "w_out": nrm(ks[18], (DEPTH, MIX_WIDTH, D_MODEL), MIX_WIDTH ** -0.5),
        "norm_xattn": gain(ks[19], (DEPTH, D_MODEL)),
        "norm_mem": gain(ks[20], (DEPTH, D_MODEL)),
        "xa_wq": nrm(ks[21], (DEPTH, D_MODEL, D_MODEL), D_MODEL ** -0.5),
        "xa_wk": nrm(ks[22], (DEPTH, D_MODEL, D_MODEL), D_MODEL ** -0.5),
        "xa_wv": nrm(ks[23], (DEPTH, D_MODEL, D_MODEL), D_MODEL ** -0.5),
        "xa_wo": nrm(ks[24], (DEPTH, D_MODEL, D_MODEL), D_MODEL ** -0.5),
        "norm_final": gain(ks[25], (D_MODEL,)),
    }


def reference(x, mem, norm_mix, w_in, hgrn_lb_logits, hgrn_norm, gla_gate_up, gla_gate_bias, gla_norm,
              mlstm_conv_w, mlstm_conv_b, mlstm_wq, mlstm_wk, mlstm_wv, mlstm_igate_bias, mlstm_fgate_bias,
              mlstm_skip, mlstm_norm, w_out, norm_xattn, norm_mem, xa_wq, xa_wk, xa_wv, xa_wo, norm_final):
    B, S, _ = x.shape
    split_idx = np.cumsum(IN_SPLITS)[:-1].tolist()
    lb_all = jnp.cumsum(jax.nn.softmax(hgrn_lb_logits.astype(jnp.float32), axis=0), axis=0)
    lb_all = lb_all - lb_all[0:1]

    for l in range(DEPTH):
        h = rms_norm(x, norm_mix[l])
        proj = jnp.einsum('bsd,dc->bsc', h, w_in[l]).astype(jnp.float32)
        (a_q, a_f, a_i, a_z, g_q, g_k, g_v, g_a, g_z, m_u, m_z, m_i, m_f) = jnp.split(proj, split_idx, axis=-1)

        lb = lb_all[l]
        log_f_a = jnp.logaddexp(jnp.log(lb), jnp.log1p(-lb) + jax.nn.log_sigmoid(a_f))
        k_a = (1.0 - lb) * jax.nn.sigmoid(-a_f)
        o_a = chunked_decay_linear_attention(split_heads(jax.nn.silu(a_q), HGRN_HEADS), split_heads(k_a, HGRN_HEADS),
                                             split_heads(a_i, HGRN_HEADS), split_heads(log_f_a, HGRN_HEADS))
        o_a = head_rms_norm(o_a, hgrn_norm[l]) * jax.nn.silu(a_z)

        log_alpha = jax.nn.log_sigmoid(g_a @ gla_gate_up[l].astype(jnp.float32) + gla_gate_bias[l].astype(jnp.float32)) / GLA_GATE_NORMALIZER
        o_b = chunked_decay_linear_attention(split_heads(g_q * (GLA_DK ** -0.5), GLA_HEADS), split_heads(g_k, GLA_HEADS),
                                             split_heads(g_v, GLA_HEADS), split_heads(log_alpha, GLA_HEADS))
        o_b = head_rms_norm(o_b, gla_norm[l]) * jax.nn.silu(g_z)

        conv = jax.nn.silu(causal_depthwise_conv(m_u, mlstm_conv_w[l], mlstm_conv_b[l]))
        q_c = block_diag_proj(conv, mlstm_wq[l])
        k_c = block_diag_proj(conv, mlstm_wk[l]) * (MLSTM_DH ** -0.5)
        v_c = block_diag_proj(m_u, mlstm_wv[l])
        i_pre = m_i + mlstm_igate_bias[l].astype(jnp.float32)
        log_f_c = jax.nn.log_sigmoid(m_f + mlstm_fgate_bias[l].astype(jnp.float32))
        o_c = chunked_mlstm(split_heads(q_c, MLSTM_HEADS), split_heads(k_c, MLSTM_HEADS), split_heads(v_c, MLSTM_HEADS), i_pre, log_f_c)
        o_c = (head_layer_norm(o_c, mlstm_norm[l]) + mlstm_skip[l].astype(jnp.float32) * conv) * jax.nn.silu(m_z)

        mix = jnp.concatenate([o_a, o_b, o_c], axis=-1).astype(x.dtype)
        x = x + jnp.einsum('bsc,cd->bsd', mix, w_out[l])

        x = x + memory_cross_attention(rms_norm(x, norm_xattn[l]), rms_norm(mem, norm_mem[l]),
                                       xa_wq[l], xa_wk[l], xa_wv[l], xa_wo[l])

    return rms_norm(x, norm_final)
```

```cpp
#include <hip/hip_runtime.h>
namespace nv {
constexpr int D = 1024, NB = 4, S = 8192, MEMT = 256, INC = 4632, MIXW = 1536;
constexpr int C_AQ = 0, C_AF = 512, C_AI = 1024, C_AZ = 1536, C_GQ = 2048, C_GK = 2304, C_GV = 2560, C_GA = 3072, C_GZ = 3088, C_MU = 3600, C_MZ = 4112, C_MI = 4624, C_MF = 4628;

__device__ __forceinline__ float sigm(float x) { return 1.0f / (1.0f + expf(-x)); }
__device__ __forceinline__ float silu(float x) { return x / (1.0f + expf(-x)); }
__device__ __forceinline__ float logsig(float x) { return fminf(x, 0.f) - log1pf(expf(-fabsf(x))); }
__device__ __forceinline__ float wsum(float v) {
#pragma unroll
    for (int o = 32; o >= 1; o >>= 1) v += __shfl_xor(v, o);
    return v; }

__global__ __launch_bounds__(256) void k_rmsnorm(const float* in, const float* g, float* out, int rows) {
    const int row = blockIdx.x * 4 + (threadIdx.x >> 6), lane = threadIdx.x & 63;
    if (row >= rows) return;
    const float* p = in + (size_t)row * D; float v[16]; float s = 0.f;
#pragma unroll
    for (int i = 0; i < 16; ++i) { v[i] = p[lane + 64 * i]; s += v[i] * v[i]; }
    s = wsum(s); const float r = rsqrtf(s * (1.0f / D) + 1e-6f);
#pragma unroll
    for (int i = 0; i < 16; ++i) out[(size_t)row * D + lane + 64 * i] = v[i] * r * g[lane + 64 * i];
}

template <bool ACC>
__global__ __launch_bounds__(256) void k_gemm(const float* A, const float* Bm, float* C, int M, int N, int K, int lda, int ldb, int ldc) {
    __shared__ float As[16][68]; __shared__ float Bs[16][68];
    const int tx = threadIdx.x & 15, ty = threadIdx.x >> 4, m0 = blockIdx.y * 64, n0 = blockIdx.x * 64;
    float acc[4][4];
#pragma unroll
    for (int i = 0; i < 4; ++i)
#pragma unroll
        for (int j = 0; j < 4; ++j) acc[i][j] = 0.f;
    for (int k0 = 0; k0 < K; k0 += 16) {
#pragma unroll
        for (int i = 0; i < 4; ++i) { const int idx = threadIdx.x + i * 256, m = idx >> 4, k = idx & 15; As[k][m] = A[(size_t)(m0 + m) * lda + k0 + k]; }
#pragma unroll
        for (int i = 0; i < 4; ++i) { const int idx = threadIdx.x + i * 256, k = idx >> 6, n = idx & 63; Bs[k][n] = (n0 + n < N) ? Bm[(size_t)(k0 + k) * ldb + n0 + n] : 0.f; }
        __syncthreads();
#pragma unroll
        for (int k = 0; k < 16; ++k) {
            float a[4], b[4];
#pragma unroll
            for (int i = 0; i < 4; ++i) { a[i] = As[k][ty * 4 + i]; b[i] = Bs[k][tx * 4 + i]; }
#pragma unroll
            for (int i = 0; i < 4; ++i)
#pragma unroll
                for (int j = 0; j < 4; ++j) acc[i][j] += a[i] * b[j];
        }
        __syncthreads();
    }
#pragma unroll
    for (int i = 0; i < 4; ++i)
#pragma unroll
        for (int j = 0; j < 4; ++j) { const int n = n0 + tx * 4 + j; if (n < N) { float* c = C + (size_t)(m0 + ty * 4 + i) * ldc + n; *c = (ACC ? *c : 0.f) + acc[i][j]; } }
}

__global__ void k_lb(const float* logits, float* lb) {
    const int c = blockIdx.x * blockDim.x + threadIdx.x; if (c >= 512) return;
    const float a = logits[c], b = logits[512 + c], m = fmaxf(a, b), ea = expf(a - m), eb = expf(b - m);
    lb[c] = 0.f; lb[512 + c] = eb / (ea + eb);
}

struct MixP {
    const float* proj;
    float* mix;
    const float *lb, *hgrn_norm, *gla_up, *gla_bias, *gla_norm, *conv_w, *conv_b, *wq, *wk, *wv, *ig_bias, *fg_bias, *skip, *mnorm;
};

constexpr int T = 8;
struct MixS { float qs[T][128], ks[T][128], as_[T][128], vs[T][128], cs[T][128], part[T][8][128], denp[T][8], fsc[T], isc[T]; };
template <int mixer> __device__ __forceinline__ void mix_body(const MixP& p, MixS& sm, const int h) {
    float (&qs)[T][128] = sm.qs; float (&ks)[T][128] = sm.ks; float (&as_)[T][128] = sm.as_; float (&vs)[T][128] = sm.vs; float (&cs)[T][128] = sm.cs; float (&part)[T][8][128] = sm.part; float (&denp)[T][8] = sm.denp; float (&fsc)[T] = sm.fsc; float (&isc)[T] = sm.isc;
    const int tid = threadIdx.x, e = tid & 127, ds = tid >> 7;
    constexpr int DK = (mixer == 1) ? 64 : 128, dper = DK / 8;
    float St[dper], nst[dper];
#pragma unroll
    for (int i = 0; i < dper; ++i) { St[i] = 0.f; nst[i] = 0.f; }
    for (int t0 = 0; t0 < S; t0 += T) {
        if (mixer == 2) {
            { const int t = tid >> 7, c = tid & 127, ch = h * 128 + c, tt = t0 + t;
              float a = p.conv_b[ch];
#pragma unroll
              for (int tap = 0; tap < 4; ++tap) { const int ts = tt - 3 + tap; if (ts >= 0) a += p.proj[(size_t)ts * INC + C_MU + ch] * p.conv_w[tap * 512 + ch]; }
              cs[t][c] = silu(a);
              if (c == 0) { fsc[t] = sigm(p.proj[(size_t)tt * INC + C_MF + h] + p.fg_bias[h]); isc[t] = expf(p.proj[(size_t)tt * INC + C_MI + h] + p.ig_bias[h]); } }
            __syncthreads();
            { const int t = tid >> 7, d = tid & 127, ch = h * 128 + d, g = ch >> 2, o = ch & 3, tt = t0 + t;
              float q = 0.f, k = 0.f, v = 0.f;
#pragma unroll
              for (int i = 0; i < 4; ++i) { const float cv = cs[t][(d & ~3) + i]; q += cv * p.wq[g * 16 + i * 4 + o]; k += cv * p.wk[g * 16 + i * 4 + o];
                  v += p.proj[(size_t)tt * INC + C_MU + (ch & ~3) + i] * p.wv[g * 16 + i * 4 + o]; }
              qs[t][d] = q; ks[t][d] = k * 0.08838834764831845f * isc[t]; as_[t][d] = fsc[t]; vs[t][d] = v; }
        } else if (mixer == 0) {
            const int t = tid >> 7, d = tid & 127, ch = h * 128 + d, tt = t0 + t; const float* r = p.proj + (size_t)tt * INC;
            const float lbv = p.lb[ch], f = lbv + (1.f - lbv) * sigm(r[C_AF + ch]);
            qs[t][d] = silu(r[C_AQ + ch]); ks[t][d] = (1.f - lbv) * sigm(-r[C_AF + ch]); as_[t][d] = f; vs[t][d] = r[C_AI + ch];
        } else {
            const int t = tid >> 7, d = tid & 127, tt = t0 + t; const float* r = p.proj + (size_t)tt * INC;
            vs[t][d] = r[C_GV + h * 128 + d];
            if (d < 64) { const int ch = h * 64 + d; float s = p.gla_bias[ch];
#pragma unroll
                for (int i = 0; i < 16; ++i) s += r[C_GA + i] * p.gla_up[i * 256 + ch];
                qs[t][d] = r[C_GQ + ch] * 0.125f; ks[t][d] = r[C_GK + ch]; as_[t][d] = expf(logsig(s) * (1.0f / 16.0f)); }
        }
        __syncthreads();
        for (int t = 0; t < T; ++t) {
            const float v = vs[t][e]; float acc = 0.f, dacc = 0.f;
#pragma unroll
            for (int i = 0; i < dper; ++i) { const int d = ds * dper + i; const float a = as_[t][d], k = ks[t][d], q = qs[t][d];
                St[i] = a * St[i] + k * v; acc += q * St[i]; if (mixer == 2) { nst[i] = a * nst[i] + k; dacc += q * nst[i]; } }
            part[t][ds][e] = acc; if (e == 0) denp[t][ds] = dacc;
        }
        __syncthreads();
        { const int w = tid >> 6, lane = tid & 63;
          if (w < T) { const int tt = t0 + w; float o[2], den = 0.f;
#pragma unroll
              for (int j = 0; j < 2; ++j) { const int ee = lane + 64 * j; float s = 0.f;
#pragma unroll
                  for (int k = 0; k < 8; ++k) s += part[w][k][ee]; o[j] = s; }
#pragma unroll
              for (int k = 0; k < 8; ++k) den += denp[w][k];
              const float* r = p.proj + (size_t)tt * INC; float* mo = p.mix + (size_t)tt * MIXW + mixer * 512 + h * 128;
              if (mixer == 2) { const float dn = fmaxf(fabsf(den), 1.0f); o[0] /= dn; o[1] /= dn;
                  const float mu = wsum(o[0] + o[1]) * (1.0f / 128.0f); const float d0 = o[0] - mu, d1 = o[1] - mu; const float var = wsum(d0 * d0 + d1 * d1) * (1.0f / 128.0f), rs = rsqrtf(var + 1e-6f);
#pragma unroll
                  for (int j = 0; j < 2; ++j) { const int ee = lane + 64 * j, ch = h * 128 + ee; const float y = (o[j] - mu) * rs * p.mnorm[ch] + p.skip[ch] * cs[w][ee]; mo[ee] = y * silu(r[C_MZ + ch]); }
              } else { const float ss = wsum(o[0] * o[0] + o[1] * o[1]) * (1.0f / 128.0f), rs = rsqrtf(ss + 1e-6f); const float* g = mixer == 0 ? p.hgrn_norm : p.gla_norm; const int zc = mixer == 0 ? C_AZ : C_GZ;
#pragma unroll
                  for (int j = 0; j < 2; ++j) { const int ee = lane + 64 * j; mo[ee] = o[j] * rs * g[ee] * silu(r[zc + h * 128 + ee]); } } } }
        __syncthreads();
    }
}
__global__ __launch_bounds__(1024) void k_mix(MixP p) {
    __shared__ MixS sm;
    const int mixer = blockIdx.x >> 2, h = blockIdx.x & 3;
    if (mixer == 0) mix_body<0>(p, sm, h); else if (mixer == 1) mix_body<1>(p, sm, h); else mix_body<2>(p, sm, h);
}

__global__ __launch_bounds__(256) void k_xattn(const float* Q, const float* Kx, const float* Vx, float* O) {
    __shared__ float qs[8][256], ps[8][256], red[8][4];
    const int blk = blockIdx.x, h = blk & 3, st = (blk >> 2) & 1023, b = blk >> 12, tid = threadIdx.x, w = tid >> 6, lane = tid & 63;
    const size_t row0 = (size_t)b * S + st * 8;
#pragma unroll
    for (int i = 0; i < 8; ++i) qs[i][tid] = Q[(row0 + i) * D + h * 256 + tid];
    __syncthreads();
    float sc[8];
#pragma unroll
    for (int i = 0; i < 8; ++i) sc[i] = 0.f;
    { const float* kr = Kx + (size_t)(b * MEMT + tid) * D + h * 256;
      for (int d = 0; d < 256; ++d) { const float kv = kr[d];
#pragma unroll
          for (int i = 0; i < 8; ++i) sc[i] += qs[i][d] * kv; } }
#pragma unroll
    for (int i = 0; i < 8; ++i) { sc[i] *= 0.0625f; float m = sc[i];
#pragma unroll
        for (int o = 32; o >= 1; o >>= 1) m = fmaxf(m, __shfl_xor(m, o));
        if (lane == 0) red[i][w] = m; }
    __syncthreads();
    float ex[8];
#pragma unroll
    for (int i = 0; i < 8; ++i) { const float m = fmaxf(fmaxf(red[i][0], red[i][1]), fmaxf(red[i][2], red[i][3])); ex[i] = expf(sc[i] - m); }
    __syncthreads();
#pragma unroll
    for (int i = 0; i < 8; ++i) { const float s = wsum(ex[i]); if (lane == 0) red[i][w] = s; }
    __syncthreads();
#pragma unroll
    for (int i = 0; i < 8; ++i) ps[i][tid] = ex[i] / (red[i][0] + red[i][1] + red[i][2] + red[i][3]);
    __syncthreads();
    float o[8];
#pragma unroll
    for (int i = 0; i < 8; ++i) o[i] = 0.f;
    for (int m = 0; m < 256; ++m) { const float v = Vx[(size_t)(b * MEMT + m) * D + h * 256 + tid];
#pragma unroll
        for (int i = 0; i < 8; ++i) o[i] += ps[i][m] * v; }
#pragma unroll
    for (int i = 0; i < 8; ++i) O[(row0 + i) * D + h * 256 + tid] = o[i];
}

struct Bufs { float *X, *H, *P, *MIX, *Mn, *Kx, *Vx, *lb; };

static void gemm(bool acc, const float* A, const float* Bm, float* C, int M, int N, int K, int lda, int ldb, int ldc, hipStream_t st) {
    dim3 g((N + 63) / 64, M / 64);
    if (acc) k_gemm<true><<<g, 256, 0, st>>>(A, Bm, C, M, N, K, lda, ldb, ldc); else k_gemm<false><<<g, 256, 0, st>>>(A, Bm, C, M, N, K, lda, ldb, ldc);
}

static void mixer_layer(void* const* d_in, int l, const Bufs& bf, hipStream_t st) {
    const float* norm_mix = (const float*)d_in[2] + l * D; const float* w_in = (const float*)d_in[3] + (size_t)l * D * INC; const float* w_out = (const float*)d_in[18] + (size_t)l * MIXW * D;
    k_rmsnorm<<<NB * S / 4, 256, 0, st>>>(bf.X, norm_mix, bf.H, NB * S);
    for (int b = 0; b < NB; ++b) {
        gemm(false, bf.H + (size_t)b * S * D, w_in, bf.P, S, INC, D, D, INC, INC, st);
        MixP p; p.proj = bf.P; p.mix = bf.MIX; p.lb = bf.lb + l * 512; p.hgrn_norm = (const float*)d_in[5] + l * 128; p.gla_up = (const float*)d_in[6] + l * 16 * 256; p.gla_bias = (const float*)d_in[7] + l * 256;
        p.gla_norm = (const float*)d_in[8] + l * 128; p.conv_w = (const float*)d_in[9] + l * 4 * 512; p.conv_b = (const float*)d_in[10] + l * 512; p.wq = (const float*)d_in[11] + l * 128 * 16; p.wk = (const float*)d_in[12] + l * 128 * 16;
        p.wv = (const float*)d_in[13] + l * 128 * 16; p.ig_bias = (const float*)d_in[14] + l * 4; p.fg_bias = (const float*)d_in[15] + l * 4; p.skip = (const float*)d_in[16] + l * 512; p.mnorm = (const float*)d_in[17] + l * 512;
        k_mix<<<12, 1024, 0, st>>>(p);
        gemm(true, bf.MIX, w_out, bf.X + (size_t)b * S * D, S, D, MIXW, MIXW, D, D, st);
    }
}
static void xattn_layer(void* const* d_in, int l, const Bufs& bf, hipStream_t st) {
    const float* mem = (const float*)d_in[1];
    const float* wq = (const float*)d_in[21] + (size_t)l * D * D; const float* wk = (const float*)d_in[22] + (size_t)l * D * D; const float* wv = (const float*)d_in[23] + (size_t)l * D * D; const float* wo = (const float*)d_in[24] + (size_t)l * D * D;
    k_rmsnorm<<<NB * S / 4, 256, 0, st>>>(bf.X, (const float*)d_in[19] + l * D, bf.H, NB * S);
    k_rmsnorm<<<NB * MEMT / 4, 256, 0, st>>>(mem, (const float*)d_in[20] + l * D, bf.Mn, NB * MEMT);
    gemm(false, bf.H, wq, bf.P, NB * S, D, D, D, D, D, st);
    gemm(false, bf.Mn, wk, bf.Kx, NB * MEMT, D, D, D, D, D, st);
    gemm(false, bf.Mn, wv, bf.Vx, NB * MEMT, D, D, D, D, D, st);
    k_xattn<<<NB * 1024 * 4, 256, 0, st>>>(bf.P, bf.Kx, bf.Vx, bf.H);
    gemm(true, bf.H, wo, bf.X, NB * S, D, D, D, D, D, st);
}
}
extern "C" void kernel_launch(void* const* d_in, const int* in_sizes, int n_in, void* d_out, int out_size, void* d_ws, size_t ws_size, hipStream_t stream) {
    using namespace nv;
    char* ws = (char*)d_ws; Bufs bf;
    bf.X = (float*)d_out;
    bf.H = (float*)ws; ws += (size_t)NB * S * D * 4;
    bf.P = (float*)ws; ws += (size_t)S * INC * 4;
    bf.MIX = (float*)ws; ws += (size_t)S * MIXW * 4;
    bf.Mn = (float*)ws; ws += (size_t)NB * MEMT * D * 4;
    bf.Kx = (float*)ws; ws += (size_t)NB * MEMT * D * 4;
    bf.Vx = (float*)ws; ws += (size_t)NB * MEMT * D * 4;
    bf.lb = (float*)ws; ws += 4096;
    hipMemcpyAsync(bf.X, d_in[0], (size_t)NB * S * D * 4, hipMemcpyDeviceToDevice, stream);
    k_lb<<<2, 256, 0, stream>>>((const float*)d_in[4], bf.lb);
    for (int l = 0; l < 2; ++l) { mixer_layer(d_in, l, bf, stream); xattn_layer(d_in, l, bf, stream); }
    k_rmsnorm<<<NB * S / 4, 256, 0, stream>>>(bf.X, (const float*)d_in[25], bf.X, NB * S);
}
```

```cpp
#include <hip/hip_runtime.h>
#include <cstdio>
namespace pg8 {
#define PG8_LAS __attribute__((address_space(3)))
typedef unsigned short bf16_t;
typedef short bf16x8 __attribute__((ext_vector_type(8)));
typedef float f32x4 __attribute__((ext_vector_type(4)));
typedef unsigned u32x4 __attribute__((ext_vector_type(4)));
constexpr int BM = 256, BK = 64, HALF = 128, HTB = HALF * BK * 2  , STAGE_BYTES = 8 * HTB, NXCD = 8, WGM = 8;

__host__ __device__ __forceinline__ int lds_byte(int r, int c) { const int st = (r >> 4) * 2 + (c >> 5), rr = r & 15, cc = c & 31, ob = rr * 64 + cc * 2; return st * 1024 + (ob ^ (((ob >> 9) & 1) << 5)); }
__host__ __device__ __forceinline__ void stage_rc(int b, int& R, int& C) { const int st = b / 1024, sb = b % 1024, swz = sb ^ (((sb >> 9) & 1) << 5); R = (st >> 1) * 16 + swz / 64; C = (st & 1) * 32 + (swz % 64) / 2; }
__host__ __device__ __forceinline__ int perm32(int rho) { const int n = rho >> 4, i = rho & 15; return 8 * (i >> 2) + 4 * n + (i & 3); }

struct Unit { int pm, pn; };
struct Gemm { const bf16_t* A; const bf16_t* Bt; int M, N, K; };

struct StaticOrder {
    int nM, nN, nwg, G, c, rev;
    __host__ __device__ void init(int M, int N, int G_, int c_, int rev_ = 0) { nM = M / BM; nN = N / BM; nwg = nM * nN; G = G_; c = c_; rev = rev_; }
    __host__ __device__ bool next(int i, Unit& u) const {
        const int nr = c < nwg ? (nwg - c + G - 1) / G : 0;
        if (i >= nr) return false;
        const long L = (long)(rev ? nr - 1 - i : i) * G + c;
        int wgid = (int)L; { const int q = nwg / NXCD, r = nwg % NXCD, xcd = wgid % NXCD, off = wgid / NXCD; wgid = (xcd < r ? xcd * (q + 1) : r * (q + 1) + (xcd - r) * q) + off; }
        const int nig = WGM * nN, gid = wgid / nig, fm = gid * WGM, gsz = (nM - fm) < WGM ? (nM - fm) : WGM;
        u.pm = fm + ((wgid % nig) % gsz); u.pn = (wgid % nig) / gsz; return true;
    }
    __device__ __forceinline__ void a_ready(const Unit&) const {}
    __device__ __forceinline__ void done(const Unit&) const {}
};
__device__ __forceinline__ unsigned cvt_pk_bf16(float lo, float hi) { unsigned r; asm volatile("v_cvt_pk_bf16_f32 %0, %1, %2" : "=v"(r) : "v"(lo), "v"(hi)); return r; }
typedef float f32x2e __attribute__((ext_vector_type(2)));
__device__ __forceinline__ float fsigm(float v) { return __builtin_amdgcn_rcpf(1.0f + __expf(-v)); }
__device__ __forceinline__ unsigned pk_h2(float a, float b) { const _Float16 ha = (_Float16)a, hb = (_Float16)b; return (unsigned)__builtin_bit_cast(unsigned short, ha) | ((unsigned)__builtin_bit_cast(unsigned short, hb) << 16); }
__device__ __forceinline__ float log2_1mk(float k) { const float ser = -(k + k * k * (0.5f + k * (0.33333334f + 0.25f * k))) * 1.4426950408889634f; return k < 0.03f ? ser : __log2f(1.0f - k); }

struct EpiInProj {
    static constexpr bool PERM = true, AFTER_DRAIN = false; static constexpr int ID = 0;
    bf16_t* proj; float* ext; const float* ssq; const float* lb;
    static constexpr bool PRE = true;
    __device__ __forceinline__ const float* pre_src(const Unit& u, int wr) const { return ssq + u.pm * BM + wr * 64; }
    __device__ __forceinline__ void operator()(const f32x4 (&acc)[2][2][4][2], const Unit& u, int wr, int wc, int fr, int fq, const float (&pre)[8]) const {
        const int row0 = u.pm * BM + wr * 64 + fr, pn = u.pn;
        const int kind = (pn == 18) ? 4 : (pn == 2 || pn == 3) ? 2 : (pn == 8) ? 3 : (pn == 0 || pn == 1 || pn == 6 || pn == 7 || pn == 12 || pn == 13 || pn == 16 || pn == 17) ? 1 : 0;
        const int col0 = pn * BM + wc * 32 + 8 * fq;
        if (kind == 4) {
#pragma unroll
            for (int ai = 0; ai < 2; ++ai)
#pragma unroll
                for (int m = 0; m < 4; ++m) { const int r = row0 + ai * HALF + m * 16; const float rs = rsqrtf(pre[ai * 4 + m] * (1.0f / 1024.0f) + 1e-6f);
                    if (wc == 0) { float* e = ext + (size_t)r * 32 + 8 * fq; *(f32x4*)e = acc[ai][0][m][0] * rs; *(f32x4*)(e + 4) = acc[ai][0][m][1] * rs; } }
            return;
        }
        float rsv[2][4];
#pragma unroll
        for (int ai = 0; ai < 2; ++ai)
#pragma unroll
            for (int m = 0; m < 4; ++m) rsv[ai][m] = rsqrtf(pre[ai * 4 + m] * (1.0f / 1024.0f) + 1e-6f);
#pragma unroll
        for (int bj = 0; bj < 2; ++bj) {
            float lbv[8];
#pragma unroll
            for (int j = 0; j < 8; ++j) lbv[j] = (kind == 2) ? lb[(pn - 2) * BM + bj * HALF + wc * 32 + 8 * fq + j] : 0.f;
#pragma unroll
            for (int ai = 0; ai < 2; ++ai)
#pragma unroll
                for (int m = 0; m < 4; ++m) {
                    const int r = row0 + ai * HALF + m * 16; const float rs = rsv[ai][m];
                    bf16_t* rowp = proj + (size_t)r * 4608 + col0;
                    float v[8];
#pragma unroll
                    for (int j = 0; j < 4; ++j) { v[j] = acc[ai][bj][m][0][j] * rs; v[4 + j] = acc[ai][bj][m][1][j] * rs; }
                    u32x4 w;
                    if (kind == 2) {
#pragma unroll
                        for (int j = 0; j < 8; ++j) { const float k = (1.0f - lbv[j]) * fsigm(-v[j]); v[j] = log2_1mk(k); }
                        w.x = pk_h2(v[0], v[1]); w.y = pk_h2(v[2], v[3]); w.z = pk_h2(v[4], v[5]); w.w = pk_h2(v[6], v[7]);
                    } else {
                        if (kind == 1) {
#pragma unroll
                            for (int j = 0; j < 8; ++j) v[j] = v[j] * fsigm(v[j]);
                        } else if (kind == 3) {
#pragma unroll
                            for (int j = 0; j < 8; ++j) v[j] *= 0.125f;
                        }
                        w.x = cvt_pk_bf16(v[0], v[1]); w.y = cvt_pk_bf16(v[2], v[3]); w.z = cvt_pk_bf16(v[4], v[5]); w.w = cvt_pk_bf16(v[6], v[7]);
                    }
                    *(u32x4*)(rowp + bj * HALF) = w;
                }
        }
    }
};

struct EpiResid {
    static constexpr bool PERM = true, AFTER_DRAIN = false; static constexpr int ID = 1;
    const float* x32; bf16_t* xb; float* ssq;
    static constexpr bool PRE = false;
    __device__ __forceinline__ void operator()(const f32x4 (&acc)[2][2][4][2], const Unit& u, int wr, int wc, int fr, int fq, const float (&)[8]) const {
        const int row0 = u.pm * BM + wr * 64 + fr, col0 = u.pn * BM + wc * 32 + 8 * fq;
        const int ln = fq * 16 + fr;
#pragma unroll
        for (int ai = 0; ai < 2; ++ai) {
            f32x4 xo[4][2][2];
            if (x32) {
#pragma unroll
                for (int m = 0; m < 4; ++m)
#pragma unroll
                    for (int bj = 0; bj < 2; ++bj) { const size_t off = (size_t)(row0 + ai * HALF + m * 16) * 1024 + col0 + bj * HALF; xo[m][bj][0] = *(const f32x4*)(x32 + off); xo[m][bj][1] = *(const f32x4*)(x32 + off + 4); }
            } else {
                u32x4 ob[4][2];
#pragma unroll
                for (int m = 0; m < 4; ++m)
#pragma unroll
                    for (int bj = 0; bj < 2; ++bj) ob[m][bj] = *(const u32x4*)(xb + (size_t)(row0 + ai * HALF + m * 16) * 1024 + col0 + bj * HALF);
#pragma unroll
                for (int m = 0; m < 4; ++m)
#pragma unroll
                    for (int bj = 0; bj < 2; ++bj) { const u32x4 o = ob[m][bj];
                        xo[m][bj][0] = (f32x4){__uint_as_float(o.x << 16), __uint_as_float(o.x & 0xffff0000u), __uint_as_float(o.y << 16), __uint_as_float(o.y & 0xffff0000u)};
                        xo[m][bj][1] = (f32x4){__uint_as_float(o.z << 16), __uint_as_float(o.z & 0xffff0000u), __uint_as_float(o.w << 16), __uint_as_float(o.w & 0xffff0000u)}; }
            }
#pragma unroll
            for (int m = 0; m < 4; ++m) {
                const int r = row0 + ai * HALF + m * 16; const size_t off = (size_t)r * 1024 + col0; float ss = 0.f;
#pragma unroll
                for (int bj = 0; bj < 2; ++bj) {
                    const f32x4 x0 = xo[m][bj][0] + acc[ai][bj][m][0], x1 = xo[m][bj][1] + acc[ai][bj][m][1];
                    u32x4 w; w.x = cvt_pk_bf16(x0[0], x0[1]); w.y = cvt_pk_bf16(x0[2], x0[3]); w.z = cvt_pk_bf16(x1[0], x1[1]); w.w = cvt_pk_bf16(x1[2], x1[3]);
                    *(u32x4*)(xb + off + bj * HALF) = w;
                    ss += (x0[0] * x0[0] + x0[1] * x0[1]) + (x0[2] * x0[2] + x0[3] * x0[3]) + (x1[0] * x1[0] + x1[1] * x1[1]) + (x1[2] * x1[2] + x1[3] * x1[3]);
                }
                ss += __builtin_bit_cast(float, __builtin_amdgcn_ds_bpermute((ln ^ 16) << 2, __builtin_bit_cast(int, ss))); ss += __builtin_bit_cast(float, __builtin_amdgcn_ds_bpermute((ln ^ 32) << 2, __builtin_bit_cast(int, ss)));
                if (fq == 0) unsafeAtomicAdd(ssq + r, ss);
            }
            asm volatile("" ::: "memory");
        }
    }
};

struct EpiBf16S {
    static constexpr bool PERM = true, AFTER_DRAIN = false; static constexpr int ID = 2;
    bf16_t* O; int ldc; const float* ssq;
    static constexpr bool PRE = true;
    __device__ __forceinline__ const float* pre_src(const Unit& u, int wr) const { return ssq ? ssq + u.pm * BM + wr * 64 : (const float*)O; }
    __device__ __forceinline__ void operator()(const f32x4 (&acc)[2][2][4][2], const Unit& u, int wr, int wc, int fr, int fq, const float (&pre)[8]) const {
        const int row0 = u.pm * BM + wr * 64 + fr, col0 = u.pn * BM + wc * 32 + 8 * fq;
#pragma unroll
        for (int ai = 0; ai < 2; ++ai)
#pragma unroll
            for (int m = 0; m < 4; ++m) {
                const int r = row0 + ai * HALF + m * 16; const float rs = ssq ? rsqrtf(pre[ai * 4 + m] * (1.0f / 1024.0f) + 1e-6f) : 1.0f;
                bf16_t* rowp = O + (size_t)r * ldc + col0;
#pragma unroll
                for (int bj = 0; bj < 2; ++bj) { const f32x4 v0 = acc[ai][bj][m][0] * rs, v1 = acc[ai][bj][m][1] * rs;
                    u32x4 w; w.x = cvt_pk_bf16(v0[0], v0[1]); w.y = cvt_pk_bf16(v0[2], v0[3]); w.z = cvt_pk_bf16(v1[0], v1[1]); w.w = cvt_pk_bf16(v1[2], v1[3]);
                    *(u32x4*)(rowp + bj * HALF) = w;
#ifdef EPI_DUP
                    if (ssq) *(u32x4*)(rowp + bj * HALF + (size_t)32768 * 1024) = w;
#endif
                    }
            }
    }
};

struct EpiVt {
    static constexpr bool PERM = true, AFTER_DRAIN = false; static constexpr int ID = 3;
    bf16_t* O;
    static constexpr bool PRE = false;
    __device__ __forceinline__ void operator()(const f32x4 (&acc)[2][2][4][2], const Unit& u, int wr, int wc, int fr, int fq, const float (&)[8]) const {
        const int row0 = u.pm * BM + wr * 64 + fr, colb = u.pn * BM + wc * 32;
        typedef unsigned u32x2 __attribute__((ext_vector_type(2)));
#pragma unroll
        for (int ai = 0; ai < 2; ++ai)
#pragma unroll
            for (int m = 0; m < 4; ++m) {
                bf16_t* rowp = O + (size_t)(row0 + ai * HALF + m * 16) * 1024 + colb;
#pragma unroll
                for (int bj = 0; bj < 2; ++bj)
#pragma unroll
                    for (int n = 0; n < 2; ++n) { const f32x4 v = acc[ai][bj][m][n]; const int p = (fq >> 1) * 16 + n * 8 + (fq & 1) * 4;
                        u32x2 w; w.x = cvt_pk_bf16(v[0], v[1]); w.y = cvt_pk_bf16(v[2], v[3]); *(u32x2*)(rowp + bj * HALF + p) = w; }
            }
    }
};
template <class Epi, class Sched, bool STAMP = false>
__device__ __forceinline__ void gemm_phase(PG8_LAS unsigned char* lds, const Gemm g, const Sched& S, const Epi& E, unsigned long long* stamps, const int wv_) {
    int tid_; asm volatile("v_mbcnt_lo_u32_b32 %0, -1, 0\n\tv_mbcnt_hi_u32_b32 %0, -1, %0" : "=v"(tid_)); tid_ += wv_ * 64;
    const int tid = tid_, wid = __builtin_amdgcn_readfirstlane(tid >> 6), lane = tid & 63, wr = wid >> 2, wc = wid & 3, fr = lane & 15, fq = lane >> 4;
    const int K = g.K, nt = K / BK;
    int ts_lo = 0, ts_hi = 0, nts = 0; const unsigned long long rt_entry = STAMP ? (unsigned long long)wall_clock64() : 0ull;
#define PG8_STAMP() do { if (STAMP && wid == 0 && nts < 64) { const unsigned long long _c = (unsigned long long)clock64(); \
        ts_lo = (lane == nts) ? (int)(unsigned)_c : ts_lo; ts_hi = (lane == nts) ? (int)(unsigned)(_c >> 32) : ts_hi; ++nts; } } while (0)
    PG8_STAMP();
    unsigned voffA[2], voffB[2];
#pragma unroll
    for (int i = 0; i < 2; ++i) { int R, C; stage_rc(tid * 16 + i * 8192, R, C); const int Rb = Epi::PERM ? ((R & ~31) + perm32(R & 31)) : R;
        voffA[i] = (unsigned)(R * K + C) * 2u; voffB[i] = (unsigned)(Rb * K + C) * 2u; }
    const size_t kstep = (size_t)(BK * 2);
    const size_t hstep = (size_t)HALF * K * 2;
    const size_t tstep = 2 * hstep;
    const unsigned lds_u = (unsigned)(size_t)lds;
    const unsigned ldsw = (unsigned)wid * 1024u;
    const int aoff = lds_byte(wr * 64 + fr, fq * 8), boff = lds_byte(wc * 32 + fr, fq * 8);
#define PG8_SA(b, h) (((b) * 2 + (h)) * HTB)
#define PG8_SB(b, h) ((4 + (b) * 2 + (h)) * HTB)
#define PG8_STAGE(bufoff, gbase, voff) do { _Pragma("unroll") for (int _i = 0; _i < 2; ++_i) { unsigned _keep; \
        asm volatile("s_mov_b32 %0, m0\n\ts_mov_b32 m0, %3\n\ts_nop 0\n\tglobal_load_lds_dwordx4 %1, %2\n\ts_mov_b32 m0, %0" : "=&s"(_keep) : "v"((voff)[_i]), "s"((const void*)(gbase)), "s"((unsigned)(lds_u + (unsigned)(bufoff) + ldsw + _i * 8192)) : "memory"); } } while (0)
#define PG8_LDA(dst, b, h) do { _Pragma("unroll") for (int m = 0; m < 4; ++m) _Pragma("unroll") for (int k = 0; k < 2; ++k) dst[m][k] = *(const PG8_LAS bf16x8*)(lds + PG8_SA(b, h) + aoff + m * 2048 + k * 1024); } while (0)
#define PG8_LDB(dst, b, h) do { _Pragma("unroll") for (int n = 0; n < 2; ++n) _Pragma("unroll") for (int k = 0; k < 2; ++k) dst[n][k] = *(const PG8_LAS bf16x8*)(lds + PG8_SB(b, h) + boff + n * 2048 + k * 1024); } while (0)
#define PG8_MMA(ai, bj, At, Bt) do { __builtin_amdgcn_s_setprio(1); _Pragma("unroll") for (int m = 0; m < 4; ++m) _Pragma("unroll") for (int n = 0; n < 2; ++n) _Pragma("unroll") for (int k = 0; k < 2; ++k) \
        acc[ai][bj][m][n] = __builtin_amdgcn_mfma_f32_16x16x32_bf16(Bt[n][k], At[m][k], acc[ai][bj][m][n], 0, 0, 0); __builtin_amdgcn_s_setprio(0); } while (0)
#define PG8_WAIT_V(n) asm volatile("s_waitcnt vmcnt(" #n ")" ::: "memory")
#define PG8_WAIT_L(n) asm volatile("s_waitcnt lgkmcnt(" #n ")" ::: "memory")
#define PG8_BAR __builtin_amdgcn_s_barrier()
#define PG8_SCHED __builtin_amdgcn_sched_barrier(0)
#ifdef GPROBE
#define GP_BEGIN(k) unsigned long long gp_t0_##k = 0; if (GPROBE == (k) && Epi::ID == GPROBE_ID) gp_t0_##k = __builtin_amdgcn_s_memrealtime();
#define GP_END(k) do { if (GPROBE == (k) && Epi::ID == GPROBE_ID && wid == 0) { const unsigned long long d_ = __builtin_amdgcn_s_memrealtime() - gp_t0_##k; if (lane == 0) *(volatile PG8_LAS unsigned long long*)(lds + 163840 - 32) += d_; } } while (0)
#else
#define GP_BEGIN(k)
#define GP_END(k) do { } while (0)
#endif
    Unit cur, nxt; int ui = 0;
    if (!S.next(0, cur)) return;
    f32x4 acc[2][2][4][2];
#pragma unroll
    for (int a = 0; a < 2; ++a)
#pragma unroll
        for (int b = 0; b < 2; ++b)
#pragma unroll
            for (int m = 0; m < 4; ++m)
#pragma unroll
                for (int n = 0; n < 2; ++n) acc[a][b][m][n] = (f32x4){0.f, 0.f, 0.f, 0.f};
    bf16x8 At[4][2], B0[2][2], B1[2][2];
    float pre[8];
#pragma unroll
    for (int i = 0; i < 8; ++i) pre[i] = 0.f;
    const char* cA = (const char*)g.A + (size_t)cur.pm * tstep; const char* cB = (const char*)g.Bt + (size_t)cur.pn * tstep;
    S.a_ready(cur);
    PG8_STAGE(PG8_SB(0, 0), cB, voffB); PG8_STAGE(PG8_SA(0, 0), cA, voffA); PG8_STAGE(PG8_SB(0, 1), cB + hstep, voffB); PG8_STAGE(PG8_SA(0, 1), cA + hstep, voffA);
    if (wr == 1) PG8_BAR;
    PG8_WAIT_V(4); PG8_BAR;
    PG8_STAGE(PG8_SB(1, 0), cB + kstep, voffB); PG8_STAGE(PG8_SA(1, 0), cA + kstep, voffA); PG8_STAGE(PG8_SB(1, 1), cB + hstep + kstep, voffB);
    PG8_WAIT_V(6); PG8_BAR;
    PG8_STAMP();
    for (;;) {
        const bool has_next = S.next(ui + 1, nxt);
        const char* nA = has_next ? (const char*)g.A + (size_t)nxt.pm * tstep : cA; const char* nB = has_next ? (const char*)g.Bt + (size_t)nxt.pn * tstep : cB;
        GP_BEGIN(4)
        for (int t = 0; t < nt; t += 2) {
            const bool last = (t == nt - 2);
            GP_BEGIN(2) GP_BEGIN(3)
            const char* a1 = cA + (size_t)(t + 1) * kstep;
            const char* a2 = last ? nA : cA + (size_t)(t + 2) * kstep; const char* b2 = last ? nB : cB + (size_t)(t + 2) * kstep;
            const char* a3 = a2 + kstep; const char* b3 = b2 + kstep;
            if (last && has_next) S.a_ready(nxt);
            if constexpr (Epi::PRE) { if (last) { const float* ps = E.pre_src(cur, wr);
#pragma unroll
                for (int _i = 0; _i < 2; ++_i) { unsigned _keep;
                    asm volatile("s_mov_b32 %0, m0\n\ts_mov_b32 m0, %3\n\ts_nop 0\n\tglobal_load_lds_dword %1, %2\n\ts_mov_b32 m0, %0" : "=&s"(_keep) : "v"((unsigned)(lane * 4)), "s"((const void*)(ps + _i * HALF)), "s"((unsigned)(lds_u + 8u * HTB + (unsigned)wid * 512u + _i * 256u)) : "memory"); } } }
            PG8_LDB(B0, 0, 0); PG8_SCHED; PG8_LDA(At, 0, 0); PG8_STAGE(PG8_SA(1, 1), a1 + hstep, voffA);
            PG8_WAIT_L(8); PG8_BAR; PG8_WAIT_L(0); PG8_MMA(0, 0, At, B0); PG8_BAR; PG8_SCHED;
            PG8_LDB(B1, 0, 1); PG8_STAGE(PG8_SB(0, 0), b2, voffB);
            PG8_BAR; PG8_WAIT_L(0); PG8_MMA(0, 1, At, B1); PG8_BAR;
            PG8_LDA(At, 0, 1); PG8_STAGE(PG8_SA(0, 0), a2, voffA);
            PG8_BAR; PG8_WAIT_L(0); PG8_MMA(1, 0, At, B0); PG8_BAR; PG8_SCHED;
            PG8_STAGE(PG8_SB(0, 1), b2 + hstep, voffB);
            PG8_WAIT_V(6); PG8_BAR; PG8_MMA(1, 1, At, B1); PG8_BAR;
            PG8_LDB(B0, 1, 0); PG8_SCHED; PG8_LDA(At, 1, 0); PG8_STAGE(PG8_SA(0, 1), a2 + hstep, voffA);
            PG8_WAIT_L(8); PG8_BAR; PG8_WAIT_L(0); PG8_MMA(0, 0, At, B0); PG8_BAR; PG8_SCHED;
            PG8_LDB(B1, 1, 1); PG8_STAGE(PG8_SB(1, 0), b3, voffB);
            PG8_BAR; PG8_WAIT_L(0); PG8_MMA(0, 1, At, B1); PG8_BAR;
            PG8_LDA(At, 1, 1); PG8_STAGE(PG8_SA(1, 0), a3, voffA);
            PG8_BAR; PG8_WAIT_L(0); PG8_MMA(1, 0, At, B0); PG8_BAR; PG8_SCHED;
            PG8_STAGE(PG8_SB(1, 1), b3 + hstep, voffB);
            PG8_WAIT_V(6); PG8_BAR; PG8_MMA(1, 1, At, B1); PG8_BAR;
            if (t == 0 && ui > 0) GP_END(2); if (t == 4 && ui > 0) GP_END(3);
        }
        GP_END(4);
        PG8_STAMP();
        GP_BEGIN(1)
        if constexpr (!Epi::AFTER_DRAIN) { if constexpr (Epi::PRE) {
#pragma unroll
                for (int i = 0; i < 8; ++i) pre[i] = *(const PG8_LAS float*)(lds + 8 * HTB + wid * 512 + (i >> 2) * 256 + ((i & 3) * 16 + fr) * 4); }
            E(acc, cur, wr, wc, fr, fq, pre); S.done(cur); }
        GP_END(1);
#ifdef GPROBE
        { GP_BEGIN(5) if (GPROBE == 5 && Epi::ID == GPROBE_ID) PG8_WAIT_V(0); GP_END(5); }
#endif
        PG8_STAMP();
        if (!has_next) break;
#pragma unroll
        for (int a = 0; a < 2; ++a)
#pragma unroll
            for (int b = 0; b < 2; ++b)
#pragma unroll
                for (int m = 0; m < 4; ++m)
#pragma unroll
                    for (int n = 0; n < 2; ++n) acc[a][b][m][n] = (f32x4){0.f, 0.f, 0.f, 0.f};
        cur = nxt; cA = nA; cB = nB; ++ui;
    }
    PG8_WAIT_V(0);
    if (wr == 0) PG8_BAR;
    PG8_BAR;
    if constexpr (Epi::AFTER_DRAIN) { E.fused(acc, cur, wr, wc, fr, fq, lds, wid, lane); S.done(cur); }
    PG8_STAMP();
    if (STAMP && wid == 0) { stamps[lane] = lane < nts ? (((unsigned long long)(unsigned)ts_hi << 32) | (unsigned)ts_lo) : 0ull;
        if (lane == 62) stamps[62] = rt_entry; if (lane == 63) stamps[63] = (unsigned long long)wall_clock64(); }
#undef PG8_STAMP
#undef PG8_SA
#undef PG8_SB
#undef PG8_STAGE
#undef PG8_LDA
#undef PG8_LDB
#undef PG8_MMA
#undef PG8_WAIT_V
#undef PG8_WAIT_L
#undef PG8_BAR
#undef PG8_SCHED
}
}
namespace fk {
using pg8::bf16_t;
typedef float f32x4 __attribute__((ext_vector_type(4)));
typedef unsigned u32x4 __attribute__((ext_vector_type(4)));
typedef unsigned u32x2 __attribute__((ext_vector_type(2)));
typedef short bf16x8 __attribute__((ext_vector_type(8)));
#ifndef FK_MR
#define FK_MR 32768
#endif
constexpr int D = 1024, S = 8192, MR = FK_MR, NBT = MR / S, NPROJ = 4608, NPAD = 4864, MIXW = 1536, MEMT = 256, INC = 4632;
#ifndef FK_REVQ
#define FK_REVQ 0
#endif
constexpr int NTHR = 512, LDS_BYTES = 163840, LDS_BAR = LDS_BYTES - 16, LDS_TP = LDS_BYTES - 32;

constexpr size_t OFF_CTL = 0, OFF_SSQ = 65536, SSQ_BYTES = (size_t)32768 * 4, ZERO_BYTES = OFF_SSQ + 5 * SSQ_BYTES;
constexpr size_t OFF_LB = ZERO_BYTES, OFF_WIN = OFF_LB + 4096, SZ_WIN = (size_t)NPAD * D * 2, OFF_WOUT = OFF_WIN + 2 * SZ_WIN, SZ_WOUT = (size_t)D * MIXW * 2;
constexpr size_t SZ_SQ = (size_t)D * D * 2, OFF_WQ = OFF_WOUT + 2 * SZ_WOUT, OFF_WO = OFF_WQ + 2 * SZ_SQ, OFF_WK = OFF_WO + 2 * SZ_SQ, OFF_WV = OFF_WK + 2 * SZ_SQ;
constexpr size_t OFF_MEMN = OFF_WV + 2 * SZ_SQ, OFF_KM = OFF_MEMN + 2 * SZ_SQ, OFF_VT = OFF_KM + 2 * SZ_SQ;
constexpr size_t OFF_XB = OFF_VT + 2 * SZ_SQ, SZ_XB = (size_t)MR * D * 2, OFF_PROJ = OFF_XB + SZ_XB, SZ_PROJ = (size_t)MR * NPROJ * 2;
constexpr size_t OFF_EXT = OFF_PROJ + SZ_PROJ, SZ_EXT = (size_t)MR * 32 * 4, OFF_MIX = OFF_EXT + SZ_EXT, SZ_MIX = (size_t)MR * MIXW * 2, WS_END = OFF_MIX + SZ_MIX;
constexpr size_t OFF_Q = OFF_PROJ, OFF_O = OFF_PROJ + SZ_XB;
static_assert(WS_END <= (size_t)536870912, "workspace");
static_assert(2 * SZ_XB <= SZ_PROJ, "q/o overlay");

#define XB_TMO      128
#define XB_XCNT(j)  (256  + 64 * (j))
#define XB_XSUB(j)  (1280 + 64 * (j))
#define XB_XGEN(j)  (2304 + 64 * (j))
#define XB_TOP      3328
#define XB_TOPGEN   3392
#define XCD_BAR_WORDS 3456
#define XB_SPIN_CAP (1u << 18)
#define LAS __attribute__((address_space(3)))

__device__ __forceinline__ unsigned xb_ld(unsigned* p)              { return __hip_atomic_load(p, __ATOMIC_RELAXED, __HIP_MEMORY_SCOPE_AGENT); }
__device__ __forceinline__ unsigned xb_add(unsigned* p, unsigned v) { return __hip_atomic_fetch_add(p, v, __ATOMIC_RELAXED, __HIP_MEMORY_SCOPE_AGENT); }
__device__ __forceinline__ unsigned xb_xcc_id() { return (unsigned)__builtin_amdgcn_s_getreg((3 << 11) | 20) & 0xFu; }
#define XB_SPIN(cond, bar) do { unsigned _sp = 0; while (cond) { __builtin_amdgcn_s_sleep(1); \
    if ((++_sp & 255u) == 0u) { if (xb_ld(&(bar)[XB_TMO])) break; if (_sp > XB_SPIN_CAP) { atomicAdd(&(bar)[XB_TMO], 1u); break; } } } } while (0)

__device__ __forceinline__ int xb_lane() { int l_; asm volatile("v_mbcnt_lo_u32_b32 %0, -1, 0\n\tv_mbcnt_hi_u32_b32 %0, -1, %0" : "=v"(l_)); return l_; }
struct XcdBarrier {
    unsigned* bar; unsigned x;
    volatile LAS unsigned* st;
};

__device__ __forceinline__ XcdBarrier xcd_barrier_post(unsigned* bar, volatile LAS unsigned* st, int wv) {
    XcdBarrier b; b.bar = bar; b.x = xb_xcc_id(); b.st = st;
    if (wv == 0 && xb_lane() == 0) (void)xb_add(&bar[XB_XCNT(b.x)], 1u);
    return b;
}
__device__ __forceinline__ void xcd_barrier_complete(unsigned* bar, unsigned x, unsigned& nloc, unsigned& nx) {
    const unsigned G = gridDim.x * gridDim.y * gridDim.z;
    unsigned sum, cnt, mine, sp = 0u;
    for (;;) {
        sum = 0u; cnt = 0u; mine = 0u;
#pragma unroll
        for (unsigned j = 0; j < 16; ++j) { const unsigned c = xb_ld(&bar[XB_XCNT(j)]); sum += c; cnt += (c > 0u) ? 1u : 0u; mine = (j == x) ? c : mine; }
        if (sum == G) break;
        __builtin_amdgcn_s_sleep(1);
        if ((++sp & 255u) == 0u) { if (xb_ld(&bar[XB_TMO])) break; if (sp > XB_SPIN_CAP) { atomicAdd(&bar[XB_TMO], 1u); break; } }
    }
    nloc = mine > 0u ? mine : 1u; nx = cnt > 0u ? cnt : 1u;
}

__device__ __forceinline__ void xcd_barrier(const XcdBarrier& b, int wv) {
    asm volatile("s_waitcnt vmcnt(0)" ::: "memory");
    __syncthreads();
    if (wv == 0 && xb_lane() == 0) {
        unsigned* bar = b.bar;
        __builtin_amdgcn_s_waitcnt(0);
        unsigned nloc = b.st[0], nx = b.st[1];
        if (nloc == 0u) { xcd_barrier_complete(bar, b.x, nloc, nx); b.st[0] = nloc; b.st[1] = nx; }
        const unsigned old = xb_add(&bar[XB_XSUB(b.x)], 1u);
        const unsigned gen = old / nloc;
        if (old + 1u == (gen + 1u) * nloc) {
            __builtin_amdgcn_fence(__ATOMIC_RELEASE, "agent");
            asm volatile("s_waitcnt vmcnt(0)" ::: "memory");
            const unsigned og = xb_add(&bar[XB_TOP], 1u);
            const unsigned tg = og / nx;
            if (og + 1u == (tg + 1u) * nx) xb_add(&bar[XB_TOPGEN], 1u);
            else XB_SPIN(xb_ld(&bar[XB_TOPGEN]) == tg, bar);
            __builtin_amdgcn_fence(__ATOMIC_ACQUIRE, "agent");
            xb_add(&bar[XB_XGEN(b.x)], 1u);
            asm volatile("s_waitcnt vmcnt(0)" ::: "memory");
        } else {
            XB_SPIN(xb_ld(&bar[XB_XGEN(b.x)]) == gen, bar);
            __builtin_amdgcn_fence(__ATOMIC_ACQUIRE, "agent");
            asm volatile("s_waitcnt vmcnt(0)" ::: "memory");
        }
    }
    __syncthreads();
}

#define GB_CNT(g)  (4096 + 64 * (g))
#define GB_MASK(g) (4608 + 64 * (g))
__device__ __forceinline__ void grp_census_post(const XcdBarrier& b, int g, int wv) { if (wv == 0 && xb_lane() == 0) (void)__hip_atomic_fetch_or(&b.bar[GB_MASK(g)], 1u << b.x, __ATOMIC_RELAXED, __HIP_MEMORY_SCOPE_AGENT); }
__device__ __forceinline__ void grp_census_read(const XcdBarrier& b, int g, int wv) {
    if (wv == 0 && xb_lane() == 0) { const unsigned m = xb_ld(&b.bar[GB_MASK(g)]); b.st[2] = (m != 0u && (m & (m - 1u)) == 0u) ? 1u : 0u; } }
__device__ __forceinline__ void grp_barrier(const XcdBarrier& b, int g, unsigned ng, int wv) {
    asm volatile("s_waitcnt vmcnt(0)" ::: "memory");
    __syncthreads();
    if (wv == 0 && xb_lane() == 0) {
        unsigned* bar = b.bar;
        __builtin_amdgcn_s_waitcnt(0);
        if (b.st[2] == 0u) { __builtin_amdgcn_fence(__ATOMIC_RELEASE, "agent"); asm volatile("s_waitcnt vmcnt(0)" ::: "memory"); }
        const unsigned old = xb_add(&bar[GB_CNT(g)], 1u);
        const unsigned tgt = (old / ng + 1u) * ng;
        XB_SPIN(xb_ld(&bar[GB_CNT(g)]) < tgt, bar);
        __builtin_amdgcn_fence(__ATOMIC_ACQUIRE, "agent");
        asm volatile("s_waitcnt vmcnt(0)" ::: "memory");
    }
    __syncthreads();
}
__device__ __forceinline__ int fk_lane() { int l_; asm volatile("v_mbcnt_lo_u32_b32 %0, -1, 0\n\tv_mbcnt_hi_u32_b32 %0, -1, %0" : "=v"(l_)); return l_; }

struct Args { const float* in[26]; float* out; unsigned char* ws; int ph_lo, ph_hi; };

__device__ __forceinline__ unsigned short bf16r(float f) { unsigned u = __float_as_uint(f); u += 0x7fffu + ((u >> 16) & 1u); return (unsigned short)(u >> 16); }
__device__ __forceinline__ float bf2f(unsigned short b) { return __uint_as_float(((unsigned)b) << 16); }
__device__ __forceinline__ float wsum(float v, int lane) {
#pragma unroll
    for (int o = 32; o >= 1; o >>= 1) v += __builtin_bit_cast(float, __builtin_amdgcn_ds_bpermute((lane ^ o) << 2, __builtin_bit_cast(int, v)));
    return v; }

__device__ __forceinline__ int win_src(int np) { return np < 3072 ? np : np < 4608 ? np + 16 : np < 4624 ? np - 4608 + 3072 : np < 4632 ? np : -1; }
__device__ __forceinline__ void p0_transpose(LAS float* tile, const float* W, int K, int N, bf16_t* WT, int NT, int mode, const float* gain, float scale, int& tbase, int wg, int nwg, int wv) {
    const int tk = K / 128, ntile = tk * (NT / 64);
    float vn[16];
    auto load_tile = [&](int t) { const int tl = wv * 64 + fk_lane(); const int c = tl & 63, k0 = (t % tk) * 128, n0 = (t / tk) * 64, np = n0 + c, src = mode ? win_src(np) : (np < N ? np : -1);
#pragma unroll
        for (int i = 0; i < 16; ++i) { const int r = (tl >> 6) + 8 * i; vn[i] = (src >= 0) ? W[(size_t)(k0 + r) * N + src] * (gain ? gain[k0 + r] : 1.0f) * scale : 0.f; } };
    const int tfirst = ((wg - tbase) % nwg + nwg) % nwg;
    if (tfirst < ntile) load_tile(tfirst);
    for (int t = tfirst; t < ntile; t += nwg) {
        const int tl = wv * 64 + fk_lane();
        const int c = tl & 63, k0 = (t % tk) * 128, n0 = (t / tk) * 64;
        asm volatile("s_waitcnt lgkmcnt(0)" ::: "memory"); __builtin_amdgcn_s_barrier(); asm volatile("" ::: "memory");
#pragma unroll
        for (int i = 0; i < 16; ++i) tile[((tl >> 6) + 8 * i) * 65 + c] = vn[i];
        if (t + nwg < ntile) load_tile(t + nwg);
        asm volatile("s_waitcnt lgkmcnt(0)" ::: "memory"); __builtin_amdgcn_s_barrier(); asm volatile("" ::: "memory");
#pragma unroll
        for (int i = 0; i < 2; ++i) { const int item = tl + i * NTHR, rn = item >> 4, kc = item & 15;
            float v[8];
#pragma unroll
            for (int j = 0; j < 8; ++j) v[j] = tile[(kc * 8 + j) * 65 + rn];
            u32x4 w; w.x = pg8::cvt_pk_bf16(v[0], v[1]); w.y = pg8::cvt_pk_bf16(v[2], v[3]); w.z = pg8::cvt_pk_bf16(v[4], v[5]); w.w = pg8::cvt_pk_bf16(v[6], v[7]);
            *(u32x4*)(WT + (size_t)(n0 + rn) * K + k0 + kc * 8) = w; }
    }
    tbase = (tbase + ntile) % nwg;
}

__device__ __forceinline__ void p0_weights(const Args& a, LAS unsigned char* lds, int l, int sub, int nsub, int wv) {
    unsigned char* ws = a.ws; LAS float* tile = (LAS float*)lds; int tbase = 0;
    p0_transpose(tile, a.in[3] + (size_t)l * D * INC, D, INC, (bf16_t*)(ws + OFF_WIN + l * SZ_WIN), NPAD, 1, a.in[2] + l * D, 1.0f, tbase, sub, nsub, wv);
    p0_transpose(tile, a.in[18] + (size_t)l * MIXW * D, MIXW, D, (bf16_t*)(ws + OFF_WOUT + l * SZ_WOUT), D, 0, nullptr, 1.0f, tbase, sub, nsub, wv);
    p0_transpose(tile, a.in[21] + (size_t)l * D * D, D, D, (bf16_t*)(ws + OFF_WQ + l * SZ_SQ), D, 0, a.in[19] + l * D, 0.0625f * 1.4426950408889634f, tbase, sub, nsub, wv);
    p0_transpose(tile, a.in[22] + (size_t)l * D * D, D, D, (bf16_t*)(ws + OFF_WK + l * SZ_SQ), D, 0, nullptr, 1.0f, tbase, sub, nsub, wv);
    p0_transpose(tile, a.in[23] + (size_t)l * D * D, D, D, (bf16_t*)(ws + OFF_WV + l * SZ_SQ), D, 0, nullptr, 1.0f, tbase, sub, nsub, wv);
    p0_transpose(tile, a.in[24] + (size_t)l * D * D, D, D, (bf16_t*)(ws + OFF_WO + l * SZ_SQ), D, 0, nullptr, 1.0f, tbase, sub, nsub, wv);
    asm volatile("s_waitcnt vmcnt(0) lgkmcnt(0)" ::: "memory"); __builtin_amdgcn_s_barrier(); asm volatile("" ::: "memory");
}

__device__ __forceinline__ void p0_prologue(const Args& a, LAS unsigned char* lds, int wv) {
    int tid_ = wv * 64 + fk_lane(); asm volatile("" : "+v"(tid_)); const int tid = tid_, lane = tid & 63, wave = tid >> 6, wg = blockIdx.x, nwg = gridDim.x;
    unsigned char* ws = a.ws;
    p0_weights(a, lds, 0, wg, nwg, wv);
    { const float* x = a.in[0]; bf16_t* xb = (bf16_t*)(ws + OFF_XB); float* ssq0 = (float*)(ws + OFF_SSQ);
      for (int row = (wg * 8 + wave) * 4; row < MR; row += nwg * 8 * 4) { f32x4 v[4][4];
#pragma unroll
          for (int r = 0; r < 4; ++r)
#pragma unroll
              for (int i = 0; i < 4; ++i) v[r][i] = *(const f32x4*)(x + (size_t)(row + r) * D + i * 256 + lane * 4);
#pragma unroll
          for (int r = 0; r < 4; ++r) { float ss = 0.f;
#pragma unroll
              for (int i = 0; i < 4; ++i) { const f32x4 t = v[r][i]; ss += (t[0] * t[0] + t[1] * t[1]) + (t[2] * t[2] + t[3] * t[3]);
                  u32x2 w; w.x = pg8::cvt_pk_bf16(t[0], t[1]); w.y = pg8::cvt_pk_bf16(t[2], t[3]); *(u32x2*)(xb + (size_t)(row + r) * D + i * 256 + lane * 4) = w; }
              ss = wsum(ss, lane); if (lane == 0) ssq0[row + r] = ss; } } }
    { const float* mem = a.in[1];
      for (int it = wg * 8 + wave; it < 2 * 4 * MEMT; it += nwg * 8) { const int l = it >> 10, row = it & 1023; const float* g = a.in[20] + l * D; bf16_t* o = (bf16_t*)(ws + OFF_MEMN + l * SZ_SQ) + (size_t)row * D;
          f32x4 v[4]; float ss = 0.f;
#pragma unroll
          for (int i = 0; i < 4; ++i) { v[i] = *(const f32x4*)(mem + (size_t)row * D + i * 256 + lane * 4); ss += (v[i][0] * v[i][0] + v[i][1] * v[i][1]) + (v[i][2] * v[i][2] + v[i][3] * v[i][3]); }
          ss = wsum(ss, lane); const float rs = rsqrtf(ss * (1.0f / 1024.0f) + 1e-6f);
#pragma unroll
          for (int i = 0; i < 4; ++i) { const f32x4 gg = *(const f32x4*)(g + i * 256 + lane * 4); const f32x4 y = v[i] * rs * gg;
              u32x2 w; w.x = pg8::cvt_pk_bf16(y[0], y[1]); w.y = pg8::cvt_pk_bf16(y[2], y[3]); *(u32x2*)(o + i * 256 + lane * 4) = w; } } }
    if (wg == 0) { float* lb = (float*)(ws + OFF_LB); const float* lg = a.in[4];
        const float x0 = lg[tid], x1 = lg[512 + tid], mx = fmaxf(x0, x1), e0 = expf(x0 - mx), e1 = expf(x1 - mx); lb[tid] = 0.f; lb[512 + tid] = e1 / (e0 + e1); }
}
typedef float f32x16a __attribute__((ext_vector_type(16)));
__device__ __forceinline__ float bpx(float x, int mask, int lane) { return __builtin_bit_cast(float, __builtin_amdgcn_ds_bpermute((lane ^ mask) << 2, __builtin_bit_cast(int, x))); }
__device__ __forceinline__ void aglds16(const void* gsrc, unsigned lds_dst) { unsigned keep;
    asm volatile("s_mov_b32 %0, m0\n\ts_mov_b32 m0, %2\n\ts_nop 0\n\tglobal_load_lds_dwordx4 %1, off\n\ts_mov_b32 m0, %0" : "=&s"(keep) : "v"(gsrc), "s"(lds_dst) : "memory"); }
__device__ __forceinline__ void attn_dma_k(unsigned slot, const bf16_t* Kbh, int half, int wave, int lane) {
    asm volatile("" : "+v"(lane));
#pragma unroll
    for (int i = 0; i < 8; ++i) { const int p = i * 8 + wave, row = 2 * p + (lane >> 5), lc = (lane & 31) ^ (row & 15);
        aglds16((const void*)(Kbh + (size_t)(half * 128 + row) * 1024 + lc * 8), (unsigned)__builtin_amdgcn_readfirstlane((int)(slot + p * 1024))); } }
__device__ __forceinline__ void attn_dma_v(unsigned slot, const bf16_t* Vbh, int half, int wave, int lane) {
    asm volatile("" : "+v"(lane));
#pragma unroll
    for (int i = 0; i < 8; ++i) { const int p = i * 8 + wave, row = 4 * p + (lane >> 4), lc = (lane & 15) ^ (row & 15);
        aglds16((const void*)(Vbh + (size_t)row * 1024 + half * 128 + lc * 8), (unsigned)__builtin_amdgcn_readfirstlane((int)(slot + p * 1024))); } }
#ifdef ATP
#define AT_BEGIN(k) unsigned long long at_t0_##k = 0; if (ATP == (k)) at_t0_##k = __builtin_amdgcn_s_memrealtime();
#define AT_END(k) do { if (ATP == (k) && wave == 0) { const unsigned long long d_ = __builtin_amdgcn_s_memrealtime() - at_t0_##k; if (lane == 0) *(volatile LAS unsigned long long*)(lds + LDS_TP) += d_; } } while (0)
#else
#define AT_BEGIN(k)
#define AT_END(k) do { } while (0)
#endif
#define ATT_BAR() do { asm volatile("" ::: "memory"); __builtin_amdgcn_s_barrier(); asm volatile("" ::: "memory"); } while (0)
__device__ __forceinline__ void attn_phase(LAS unsigned char* lds, const bf16_t* q, const bf16_t* Km, const bf16_t* Vt, bf16_t* o, const pg8::StaticOrder& So, int wv) {
    int tid_ = wv * 64 + fk_lane(); asm volatile("" : "+v"(tid_));
    const int tid = tid_, lane0 = tid & 63, wave = wv;
    constexpr int RT = S / 256;
    const unsigned slot0 = (unsigned)(size_t)lds, slot1 = slot0 + 65536u;
    LAS unsigned char* ost = lds + 131072 + wave * 2048;
    pg8::Unit cu, nu; int ui = 0;
    bool have = So.next(0, cu);
    if (have) { const int h = cu.pn, b = cu.pm / RT; const bf16_t* Kbh = Km + (size_t)(b * 256) * 1024 + h * 256; attn_dma_k(slot0, Kbh, 0, wave, lane0); attn_dma_k(slot1, Kbh, 1, wave, lane0); }
    bf16x8 qf[16];
    if (have) { const int h = cu.pn; const size_t qrow = (size_t)cu.pm * 256 + wave * 32 + (lane0 & 31);
#pragma unroll
        for (int ks = 0; ks < 16; ++ks) qf[ks] = *(const bf16x8*)(q + qrow * 1024 + h * 256 + ks * 16 + (lane0 >> 5) * 8); }
    for (; have; ++ui) {
        int lane = lane0; asm volatile("" : "+v"(lane)); const int n = lane & 31, hh = lane >> 5;
        const int rt = cu.pm % RT, h = cu.pn, b = cu.pm / RT;
        const bool has_next = So.next(ui + 1, nu);
        const bf16_t* Vbh = Vt + (size_t)(h * 256) * 1024 + b * 256;
        AT_BEGIN(1)
        if (ui != 0) asm volatile("s_waitcnt vmcnt(16) lgkmcnt(0)" ::: "memory"); else asm volatile("s_waitcnt vmcnt(0) lgkmcnt(0)" ::: "memory");
        ATT_BAR();
        AT_END(1);
        AT_BEGIN(2)
        f32x16a sacc[8];
#pragma unroll
        for (int half = 0; half < 2; ++half) {
            LAS unsigned char* ks_ = lds + half * 65536;
#pragma unroll
            for (int kt = 0; kt < 4; ++kt) { f32x16a a;
#pragma unroll
                for (int r = 0; r < 16; ++r) a[r] = 0.f;
                const int key = kt * 32 + n;
#pragma unroll
                for (int k0 = 0; k0 < 16; k0 += 4) { bf16x8 kf[4];
#pragma unroll
                    for (int ks = 0; ks < 4; ++ks) kf[ks] = *(const LAS bf16x8*)(ks_ + key * 512 + (((2 * (k0 + ks) + hh) ^ (key & 15)) * 16));
#pragma unroll
                    for (int ks = 0; ks < 4; ++ks) a = __builtin_amdgcn_mfma_f32_32x32x16_bf16(kf[ks], qf[k0 + ks], a, 0, 0, 0); }
                sacc[half * 4 + kt] = a; }
            asm volatile("s_waitcnt lgkmcnt(0)" ::: "memory"); ATT_BAR();
            attn_dma_v(half ? slot1 : slot0, Vbh, half, wave, lane);
        }
        AT_END(2);
        AT_BEGIN(3)
        float mx = -3.0e38f;
#pragma unroll
        for (int t = 0; t < 8; ++t)
#pragma unroll
            for (int r = 0; r < 16; ++r) mx = fmaxf(mx, sacc[t][r]);
        mx = fmaxf(mx, bpx(mx, 32, lane));
        float sum = 0.f; bf16x8 pf[16];
#pragma unroll
        for (int t = 0; t < 8; ++t) {
#pragma unroll
            for (int r = 0; r < 16; ++r) { const float p = __builtin_amdgcn_exp2f(sacc[t][r] - mx); sacc[t][r] = p; sum += p; }
#pragma unroll
            for (int s = 0; s < 2; ++s) { u32x4 w; w.x = pg8::cvt_pk_bf16(sacc[t][8 * s], sacc[t][8 * s + 1]); w.y = pg8::cvt_pk_bf16(sacc[t][8 * s + 2], sacc[t][8 * s + 3]);
                w.z = pg8::cvt_pk_bf16(sacc[t][8 * s + 4], sacc[t][8 * s + 5]); w.w = pg8::cvt_pk_bf16(sacc[t][8 * s + 6], sacc[t][8 * s + 7]); pf[2 * t + s] = __builtin_bit_cast(bf16x8, w); } }
        sum += bpx(sum, 32, lane);
        const float inv = 1.0f / sum;
        AT_END(3);
        AT_BEGIN(4)
        f32x16a oacc[8];
#pragma unroll
        for (int dt = 0; dt < 8; ++dt)
#pragma unroll
            for (int r = 0; r < 16; ++r) oacc[dt][r] = 0.f;
        if (!has_next) nu = cu;
        const bf16_t* Kn = Km + (size_t)((nu.pm / RT) * 256) * 1024 + nu.pn * 256;
#pragma unroll
        for (int half = 0; half < 2; ++half) {
            if (half == 0 || has_next) asm volatile("s_waitcnt vmcnt(8)" ::: "memory"); else asm volatile("s_waitcnt vmcnt(0)" ::: "memory");
            ATT_BAR();
            LAS unsigned char* vs_ = lds + half * 65536;
#pragma unroll
            for (int dt = 0; dt < 8; ++dt) { const int dv = dt * 32 + n;
#pragma unroll
                for (int s0 = 0; s0 < 8; s0 += 4) { bf16x8 vf[4];
#pragma unroll
                    for (int s8 = 0; s8 < 4; ++s8) vf[s8] = *(const LAS bf16x8*)(vs_ + dv * 256 + (((2 * (s0 + s8) + hh) ^ (dv & 15)) * 16));
#pragma unroll
                    for (int s8 = 0; s8 < 4; ++s8) oacc[dt] = __builtin_amdgcn_mfma_f32_32x32x16_bf16(vf[s8], pf[half * 8 + s0 + s8], oacc[dt], 0, 0, 0); } }
            asm volatile("s_waitcnt lgkmcnt(0)" ::: "memory"); ATT_BAR();
            if (has_next) attn_dma_k(half ? slot1 : slot0, Kn, half, wave, lane);
        }
        { const int hq = nu.pn; const size_t qrow = (size_t)nu.pm * 256 + wave * 32 + n;
#pragma unroll
          for (int ks = 0; ks < 16; ++ks) qf[ks] = *(const bf16x8*)(q + qrow * 1024 + hq * 256 + ks * 16 + hh * 8); }
        AT_END(4);
        AT_BEGIN(5)
        bf16_t* obase = o + ((size_t)b * S + rt * 256 + wave * 32) * 1024 + h * 256;
#pragma unroll
        for (int dt = 0; dt < 8; ++dt) {
#pragma unroll
            for (int rg = 0; rg < 4; ++rg) { const f32x16a& oa = oacc[dt]; u32x2 w; w.x = pg8::cvt_pk_bf16(oa[4 * rg] * inv, oa[4 * rg + 1] * inv); w.y = pg8::cvt_pk_bf16(oa[4 * rg + 2] * inv, oa[4 * rg + 3] * inv);
                *(LAS u32x2*)(ost + n * 64 + (8 * rg + 4 * hh) * 2) = w; }
            asm volatile("s_waitcnt lgkmcnt(0)" ::: "memory");
            { const int row = lane >> 1, hf = lane & 1; const u32x4 t0 = *(const LAS u32x4*)(ost + row * 64 + hf * 32), t1 = *(const LAS u32x4*)(ost + row * 64 + hf * 32 + 16);
              bf16_t* dst = obase + (size_t)row * 1024 + dt * 32 + hf * 16; *(u32x4*)dst = t0; *(u32x4*)(dst + 8) = t1; }
            asm volatile("s_waitcnt lgkmcnt(0)" ::: "memory");
        }
        AT_END(5);
        cu = nu; have = has_next;
    }
    asm volatile("s_waitcnt vmcnt(0) lgkmcnt(0)" ::: "memory"); ATT_BAR();
}
constexpr int SEGC = 8, SEGT = 512, NSEG = S / SEGT, NBH = NBT * 4;
constexpr int P_AQ = 0, P_AF = 512, P_AI = 1024, P_AZ = 1536, P_GQ = 2048, P_GK = 2304, P_GV = 2560, P_GZ = 3072, P_MU = 3584, P_MZ = 4096;
constexpr int USZ = 16384 + 256;
constexpr int L_Q0 = 0, L_KM = 16384, L_QM = 32768, L_RF = 49152, L_ST = 65536, L_V0 = 98304, L_V1 = 114688, L_CV = 132096, L_CST = 148480;
constexpr int C_G = 0, C_SKIP = 512, C_ADEC = 1024, C_NVEC = 1536  , C_DINT = 2560, C_DPART = 2816, C_C1 = 3328, C_W = 3840  , C_HALO = 12544  , C_NINC = 14592  ;
typedef float f32x16 __attribute__((ext_vector_type(16)));
typedef short s16x4 __attribute__((ext_vector_type(4)));

__device__ __forceinline__ unsigned off_b(unsigned row, unsigned ch) { return 256u * row + 16u * (ch ^ (((row & 3u) << 2) | ((row >> 2) & 3u))); }
__device__ __forceinline__ unsigned rr_addr(unsigned lane, unsigned rowbase, unsigned s) { return off_b(rowbase + (lane & 31u), 2u * s + (lane >> 5)); }
__device__ __forceinline__ unsigned tr_addr(unsigned lane, unsigned c, unsigned ks, unsigned t) { const unsigned h = lane >> 5, blk = (lane >> 4) & 1u, q = (lane & 15u) >> 2, p = lane & 3u; return off_b(16u * ks + 8u * h + 4u * t + q, 4u * c + 2u * blk + (p >> 1)) + 8u * (p & 1u); }
__device__ __forceinline__ bf16x8 ld_frag(LAS unsigned char* p) { return *(const LAS bf16x8*)p; }
__device__ __forceinline__ bf16x8 tr_frag(LAS unsigned char* img, unsigned lane, unsigned c, unsigned ks) {
    const s16x4 lo = __builtin_bit_cast(s16x4, __builtin_amdgcn_ds_read_tr16_b64_v4i16((LAS s16x4*)(img + tr_addr(lane, c, ks, 0))));
    const s16x4 hi = __builtin_bit_cast(s16x4, __builtin_amdgcn_ds_read_tr16_b64_v4i16((LAS s16x4*)(img + tr_addr(lane, c, ks, 1))));
    return (bf16x8){lo[0], lo[1], lo[2], lo[3], hi[0], hi[1], hi[2], hi[3]}; }
__device__ __forceinline__ bf16x8 tr_fragb(LAS unsigned char* img, const unsigned (&tb)[2], unsigned ks) {
    const s16x4 lo = __builtin_bit_cast(s16x4, __builtin_amdgcn_ds_read_tr16_b64_v4i16((LAS s16x4*)(img + tb[0] + 4096u * ks)));
    const s16x4 hi = __builtin_bit_cast(s16x4, __builtin_amdgcn_ds_read_tr16_b64_v4i16((LAS s16x4*)(img + tb[1] + 4096u * ks)));
    return (bf16x8){lo[0], lo[1], lo[2], lo[3], hi[0], hi[1], hi[2], hi[3]}; }
__device__ __forceinline__ void glds16(const void* gsrc, unsigned lds_dst) { unsigned keep;
    asm volatile("s_mov_b32 %0, m0\n\ts_mov_b32 m0, %2\n\ts_nop 0\n\tglobal_load_lds_dwordx4 %1, off\n\ts_mov_b32 m0, %0" : "=&s"(keep) : "v"(gsrc), "s"(lds_dst) : "memory"); }
__device__ __forceinline__ void dma_tile(LAS unsigned char* img, const bf16_t* src, size_t pitch, int npieces, int wave, int lane) {
    const unsigned base = (unsigned)(size_t)img; asm volatile("" : "+v"(lane));
    for (int p = wave; p < npieces; p += 8) { const int row = p * 4 + (lane >> 4), lc = (lane & 15) ^ (((row & 3) << 2) | ((row >> 2) & 3));
        glds16((const void*)(src + (ptrdiff_t)row * (ptrdiff_t)pitch + lc * 8), (unsigned)__builtin_amdgcn_readfirstlane((int)(base + p * 1024))); } }
template <int CTRL, int RM> __device__ __forceinline__ float dpp1(float x) { return __builtin_bit_cast(float, __builtin_amdgcn_update_dpp(0x3f800000, __builtin_bit_cast(int, x), CTRL, RM, 0xF, false)); }
template <int CTRL, int RM> __device__ __forceinline__ float dpp0(float x) { return __builtin_bit_cast(float, __builtin_amdgcn_update_dpp(0, __builtin_bit_cast(int, x), CTRL, RM, 0xF, true)); }
__device__ __forceinline__ float wave_scan(float v, int lane) {
    (void)lane;
    v += dpp0<0x111, 0xF>(v); v += dpp0<0x112, 0xF>(v); v += dpp0<0x114, 0xF>(v); v += dpp0<0x118, 0xF>(v);
    v += dpp0<0x142, 0xA>(v); v += dpp0<0x143, 0xC>(v);
    return v; }
__device__ __forceinline__ float shx(float x, int mask, int lane) { return __builtin_bit_cast(float, __builtin_amdgcn_ds_bpermute((lane ^ mask) << 2, __builtin_bit_cast(int, x))); }
__device__ __forceinline__ float sum8(float v) { v += dpp0<0xB1, 0xF>(v); v += dpp0<0x4E, 0xF>(v); v += dpp0<0x141, 0xF>(v); return v; }
__device__ __forceinline__ float rdlane(float x, int l) { return __builtin_bit_cast(float, __builtin_amdgcn_readlane(__builtin_bit_cast(int, x), l)); }
__device__ __forceinline__ float ex2(float x) { return __builtin_amdgcn_exp2f(x); }
__device__ __forceinline__ float h2f(unsigned short h) { return (float)__builtin_bit_cast(_Float16, h); }
__device__ __forceinline__ u32x4 pack8(const float (&v)[8]) { u32x4 w; w.x = pg8::cvt_pk_bf16(v[0], v[1]); w.y = pg8::cvt_pk_bf16(v[2], v[3]); w.z = pg8::cvt_pk_bf16(v[4], v[5]); w.w = pg8::cvt_pk_bf16(v[6], v[7]); return w; }
__device__ __forceinline__ float log2sig(float x) { return (fminf(x, 0.f) - __logf(1.0f + __expf(-fabsf(x)))) * 1.4426950408889634f; }

struct MixArgs {
    const bf16_t* proj; const float* ext; bf16_t* mix; float* U;
    const float *hgrn_norm, *gla_up, *gla_bias, *gla_norm, *conv_w, *conv_b, *wq, *wk, *wv, *ig_bias, *fg_bias, *skip, *mnorm;
};

struct Fac { float E0, Km, a63; };
__device__ __forceinline__ Fac factors(float b, float kboost, int lane) {
    (void)lane; Fac f; f.E0 = ex2(fmaxf(b, -120.f)); f.Km = __builtin_amdgcn_rcpf(f.E0) * ex2(kboost); f.a63 = rdlane(f.E0, 63); return f; }
__device__ __forceinline__ f32x16 mfma32(bf16x8 a, bf16x8 b, f32x16 c) { return __builtin_amdgcn_mfma_f32_32x32x16_bf16(a, b, c, 0, 0, 0); }

#ifdef TPROBE
#ifndef TP_PASS
#define TP_PASS 1
#endif
#define TP_BEGIN(k) unsigned long long tp_t0_##k = 0; if (TPROBE == (k) && PASS == TP_PASS) tp_t0_##k = __builtin_amdgcn_s_memrealtime();
#define TP_END(k) do { if (TPROBE == (k) && PASS == TP_PASS && wave == 0) { const unsigned long long d_ = __builtin_amdgcn_s_memrealtime() - tp_t0_##k; if (lane == 0) *(volatile LAS unsigned long long*)(lds + LDS_TP) += d_; } } while (0)
#else
#define TP_BEGIN(k)
#define TP_END(k) do { } while (0)
#endif
#define FK_BAR() do { asm volatile("" ::: "memory"); __builtin_amdgcn_s_barrier(); asm volatile("" ::: "memory"); } while (0)
template <int MIXER, int PASS>
__device__ __forceinline__ void mix_unit(LAS unsigned char* lds, const MixArgs& A, int bh, int seg, int wv) {
    constexpr int DK = (MIXER == 1) ? 64 : 128, NKS = DK / 16, NG = DK / 64;
    constexpr int NT = (DK == 128) ? 2 : 1;
    constexpr int LEAD = (PASS == 0 && MIXER != 2) ? 2 : 1;
    int tid_ = wv * 64 + fk_lane(); asm volatile("" : "+v"(tid_));
    const int tid = tid_, lane = tid & 63, wave = wv;
    TP_BEGIN(6)
    const int b = bh >> 2, h = bh & 3;
    const size_t row0 = (size_t)b * S + (size_t)seg * SEGT;
    LAS float* cst = (LAS float*)(lds + L_CST);
    LAS float* c_g = cst + C_G / 4; LAS float* c_skip = cst + C_SKIP / 4; LAS float* c_adec = cst + C_ADEC / 4; LAS float* c_c1 = cst + C_C1 / 4; LAS float* c_nbuf = cst + C_NVEC / 4; LAS float* c_w = cst + C_W / 4; LAS float* c_dint = cst + C_DINT / 4; LAS float* c_dpart = cst + C_DPART / 4; LAS float* c_ninc = cst + C_NINC / 4;
    float* slot = A.U + (size_t)((MIXER * NBH + bh) * NSEG + seg) * USZ;
    const int td = (DK == 128) ? (wave >> 1) : (wave >> 2), te0 = (DK == 128) ? (wave & 1) * 2 : (wave & 3);
    const int ti = wave >> 2, te = wave & 3;
    const int cq = MIXER == 0 ? P_AQ + h * 128 : MIXER == 1 ? P_GQ + h * 64 : P_MU + h * 128;
    const int ck = MIXER == 0 ? P_AF + h * 128 : P_GK + h * 64;
    const int cv = MIXER == 0 ? P_AI + h * 128 : P_GV + h * 128;
    const int cz = MIXER == 0 ? P_AZ + h * 128 : MIXER == 1 ? P_GZ + h * 128 : P_MZ + h * 128;
    const bf16_t* pr = A.proj + row0 * NPROJ;
    auto fbuf = [&](int cn) -> LAS unsigned char* { if (PASS == 1) return lds + L_RF; const int r = cn % 3; return lds + (r == 0 ? L_RF : r == 1 ? L_Q0 : L_QM); };
    auto vbuf = [&](int cn) -> LAS unsigned char* { if (MIXER == 2) return lds + L_V0; if (PASS == 1) return lds + ((cn & 1) ? L_V1 : L_V0); const int r = cn % 3; return lds + (r == 0 ? L_V0 : r == 1 ? L_V1 : L_ST); };
    auto ubuf = [&](int cn) -> LAS unsigned char* { return lds + ((cn & 1) ? L_RF : L_V1); };
    auto hbuf = [&](int cn) -> LAS unsigned char* { return lds + L_CST + C_HALO + (cn & 1) * 1024; };
    auto cix = [&](int cn) -> int { return PASS == 0 ? SEGC - 1 - cn : cn; };
    auto issue_dma = [&](int cn) {
        const bf16_t* prn = pr + (size_t)cix(cn) * 64 * NPROJ;
        if (MIXER == 2) { dma_tile(ubuf(cn), prn + cq, NPROJ, 16, wave, lane); dma_tile(hbuf(cn), prn + cq - 4 * (ptrdiff_t)NPROJ, NPROJ, 1, wave, lane); }
        else { if (PASS == 1) dma_tile(lds + L_CV, prn + cq, NPROJ, 16, wave, lane); dma_tile(fbuf(cn), prn + ck, NPROJ, 16, wave, lane); dma_tile(vbuf(cn), prn + cv, NPROJ, 16, wave, lane); } };
    issue_dma(0);
    if (LEAD == 2) issue_dma(1);
    if (tid < 128) { c_g[tid] = MIXER == 0 ? A.hgrn_norm[tid] : MIXER == 1 ? A.gla_norm[tid] : A.mnorm[h * 128 + tid]; c_skip[tid] = MIXER == 2 ? A.skip[h * 128 + tid] : 0.f; c_nbuf[tid] = (MIXER == 2 && PASS == 1) ? slot[16384 + 128 + tid] : 0.f; }
    if (MIXER == 2) { const int i = tid; c_w[i] = A.wq[h * 512 + i]; c_w[512 + i] = A.wk[h * 512 + i]; c_w[1024 + i] = A.wv[h * 512 + i]; c_w[1536 + i] = A.conv_w[(i >> 7) * 512 + h * 128 + (i & 127)]; if (tid < 128) c_w[2048 + tid] = A.conv_b[h * 128 + tid]; }
    if (MIXER == 1) { for (int i = tid; i < 1024; i += NTHR) c_w[i] = A.gla_up[(i >> 6) * 256 + h * 64 + (i & 63)]; if (tid < 64) c_w[1024 + tid] = A.gla_bias[h * 64 + tid]; }
    f32x16 st[NT];
#pragma unroll
    for (int s = 0; s < NT; ++s)
#pragma unroll
        for (int r = 0; r < 16; ++r) st[s][r] = (PASS == 1) ? slot[((wave * NT + s) * 16 + r) * 64 + lane] : 0.f;
    float carry[NG * 8];
#pragma unroll
    for (int i = 0; i < NG * 8; ++i) carry[i] = 0.f;
    float carry_s = 0.f;
    f32x16 nacc;
#pragma unroll
    for (int r = 0; r < 16; ++r) nacc[r] = 0.f;
    u32x4 zraw[2]; f32x4 gv[4], gvn[4]; float emi = 0.f, emf = 0.f;
    zraw[0] = zraw[1] = (u32x4){0u, 0u, 0u, 0u};
#pragma unroll
    for (int i = 0; i < 4; ++i) { gv[i] = (f32x4){0.f, 0.f, 0.f, 0.f}; gvn[i] = gv[i]; }
    auto prefetch = [&](int cn, bool first) {
        const float* er = A.ext + (row0 + (size_t)cix(cn) * 64 + lane) * 32;
        if (MIXER == 1) {
#pragma unroll
            for (int i = 0; i < 4; ++i) { const f32x4 t4 = *(const f32x4*)(er + 4 * i); if (first) gv[i] = t4; else gvn[i] = t4; } }
        if (MIXER == 2) { emi = er[16 + h]; emf = er[20 + h]; } };
    prefetch(0, true);
    if (PASS == 1) {
#pragma unroll
        for (int s = 0; s < NT; ++s) { const int e = 32 * (te0 + s) + (lane & 31);
#pragma unroll
            for (int rg = 0; rg < 4; ++rg) { const int d0 = 32 * td + 8 * rg + 4 * (lane >> 5);
                u32x2 w; w.x = pg8::cvt_pk_bf16(st[s][4 * rg], st[s][4 * rg + 1]); w.y = pg8::cvt_pk_bf16(st[s][4 * rg + 2], st[s][4 * rg + 3]);
                *(LAS u32x2*)(lds + L_ST + off_b(e, d0 >> 3) + (d0 & 7) * 2) = w; } } }

    TP_END(6);
#pragma unroll 1
    for (int c = 0; c < SEGC; ++c) {
        TP_BEGIN(1)
        const int t0 = seg * SEGT + cix(c) * 64;
        LAS unsigned char* Vimg = vbuf(c);
        if (PASS == 1) { if (c > 0) asm volatile("s_waitcnt vmcnt(2) lgkmcnt(0)" ::: "memory"); else asm volatile("s_waitcnt vmcnt(0) lgkmcnt(0)" ::: "memory"); }
        else if (LEAD == 2) { if (c + 1 < SEGC) asm volatile("s_waitcnt vmcnt(4) lgkmcnt(0)" ::: "memory"); else asm volatile("s_waitcnt vmcnt(0) lgkmcnt(0)" ::: "memory"); }
        else asm volatile("s_waitcnt vmcnt(0) lgkmcnt(0)" ::: "memory");
        FK_BAR();
        TP_END(1);
        TP_BEGIN(2)
        if (PASS == 1) { int lz = lane; asm volatile("" : "+v"(lz)); const int tz = wave * 64 + lz; const bf16_t* zp = pr + (size_t)(c * 64 + (tz >> 3)) * NPROJ + cz + (tz & 7) * 16; zraw[0] = *(const u32x4*)zp; zraw[1] = *(const u32x4*)(zp + 8); }
        if (c > 0) {
            if (MIXER == 1) {
#pragma unroll
                for (int i = 0; i < 4; ++i) { gv[i] = gvn[i]; asm volatile("" : "+v"(gv[i])); } } }
        if (MIXER == 2 && c + 1 < SEGC) issue_dma(c + 1);
        Fac fsc; fsc.E0 = fsc.Km = fsc.a63 = 0.f;
        if (MIXER == 2) {
            const float mi = emi + A.ig_bias[h], mf = emf + A.fg_bias[h];
            const float bs = wave_scan(log2sig(mf), lane);
            if (PASS == 0) { const float r63 = rdlane(bs, 63); fsc.E0 = 0.f; fsc.Km = ex2(r63 - bs + carry_s + mi * 1.4426950408889634f); fsc.a63 = 0.f; carry_s += r63; }
            else fsc = factors(bs, mi * 1.4426950408889634f, lane); }
        bf16x8 rawq[NG], rawk[NG];
        if (MIXER != 2) {
#pragma unroll
            for (int g = 0; g < NG; ++g) { rawk[g] = ld_frag(fbuf(c) + off_b(lane, wave + 8 * g)); rawq[g] = rawk[g]; if (PASS == 1) rawq[g] = ld_frag(lds + L_CV + off_b(lane, wave + 8 * g)); }
            asm volatile("s_waitcnt lgkmcnt(0)" ::: "memory"); FK_BAR();
            if (MIXER == 1 && c + 1 < SEGC) prefetch(c + 1, false);
            if (c + LEAD < SEGC) issue_dma(c + LEAD);
        }
#ifndef REP_S0
#define REP_S0 1
#endif
#ifndef REP_S0M
#define REP_S0M 0
#endif
        _Pragma("unroll 1") for (int rep0 = 0; rep0 < ((PASS == 1 && MIXER == REP_S0M) ? REP_S0 : 1); ++rep0)
#pragma unroll
        for (int g = 0; g < NG; ++g) { const int cc = wave + 8 * g; float q8[8], k8[8], gl8[8], v8[8], ca8[8];
            if (MIXER == 0) {
#pragma unroll
                for (int j = 0; j < 8; ++j) { gl8[j] = h2f((unsigned short)rawk[g][j]); q8[j] = bf2f((unsigned short)rawq[g][j]); v8[j] = 0.f; ca8[j] = 0.f; }
#pragma unroll
                for (int j = 0; j < 8; ++j) k8[j] = 1.0f - ex2(gl8[j]);
            } else if (MIXER == 1) {
                f32x4 sg0 = *(const LAS f32x4*)(c_w + 1024 + cc * 8), sg1 = *(const LAS f32x4*)(c_w + 1024 + cc * 8 + 4);
#pragma unroll
                for (int i = 0; i < 16; ++i) { const f32x4 w0 = *(const LAS f32x4*)(c_w + i * 64 + cc * 8), w1 = *(const LAS f32x4*)(c_w + i * 64 + cc * 8 + 4); const float gi = gv[i >> 2][i & 3];
                    sg0 += gi * w0; sg1 += gi * w1; }
#pragma unroll
                for (int j = 0; j < 8; ++j) { const float sj = j < 4 ? sg0[j & 3] : sg1[j & 3]; gl8[j] = log2sig(sj) * 0.0625f; q8[j] = bf2f((unsigned short)rawq[g][j]); k8[j] = bf2f((unsigned short)rawk[g][j]); v8[j] = 0.f; ca8[j] = 0.f; }
            } else {
                f32x4 u4[4][2];
#pragma unroll
                for (int k = 0; k < 4; ++k) { const int rr = lane - k; const bf16x8 ru = ld_frag(rr >= 0 ? ubuf(c) + off_b(rr, cc) : hbuf(c) + off_b(4 + rr, cc));
#pragma unroll
                    for (int j = 0; j < 8; ++j) u4[k][j >> 2][j & 3] = bf2f((unsigned short)ru[j]);
                    if (t0 == 0 && rr < 0) { u4[k][0] = (f32x4){0.f, 0.f, 0.f, 0.f}; u4[k][1] = u4[k][0]; } }
                f32x4 ac0 = *(const LAS f32x4*)(c_w + 2048 + cc * 8), ac1 = *(const LAS f32x4*)(c_w + 2048 + cc * 8 + 4);
#pragma unroll
                for (int tap = 0; tap < 4; ++tap) { const f32x4 w0 = *(const LAS f32x4*)(c_w + 1536 + tap * 128 + cc * 8), w1 = *(const LAS f32x4*)(c_w + 1536 + tap * 128 + cc * 8 + 4);
                    ac0 += u4[3 - tap][0] * w0; ac1 += u4[3 - tap][1] * w1; }
#pragma unroll
                for (int j = 0; j < 8; ++j) { const float aj = j < 4 ? ac0[j & 3] : ac1[j & 3]; ca8[j] = aj * pg8::fsigm(aj); }
                f32x4 qv4[2], kv4[2], vv4[2];
#pragma unroll
                for (int hg = 0; hg < 2; ++hg) { qv4[hg] = (f32x4){0.f, 0.f, 0.f, 0.f}; kv4[hg] = qv4[hg]; vv4[hg] = qv4[hg]; }
#pragma unroll
                for (int i = 0; i < 4; ++i)
#pragma unroll
                    for (int hg = 0; hg < 2; ++hg) { const f32x4 wq4 = *(const LAS f32x4*)(c_w + (cc * 2 + hg) * 16 + i * 4), wk4 = *(const LAS f32x4*)(c_w + 512 + (cc * 2 + hg) * 16 + i * 4), wv4 = *(const LAS f32x4*)(c_w + 1024 + (cc * 2 + hg) * 16 + i * 4);
                        qv4[hg] += ca8[hg * 4 + i] * wq4; kv4[hg] += ca8[hg * 4 + i] * wk4; vv4[hg] += u4[0][hg][i] * wv4; }
#pragma unroll
                for (int j = 0; j < 8; ++j) { q8[j] = qv4[j >> 2][j & 3]; k8[j] = kv4[j >> 2][j & 3] * 0.08838834764831845f; v8[j] = vv4[j >> 2][j & 3]; gl8[j] = 0.f; }
            }
            float E0[8], Km[8], a63[8];
            if (MIXER != 2) {
                float bb[8];
#pragma unroll
                for (int j = 0; j < 8; ++j) bb[j] = gl8[j];
#pragma unroll
                for (int j = 0; j < 8; ++j) bb[j] += dpp0<0x111, 0xF>(bb[j]);
#pragma unroll
                for (int j = 0; j < 8; ++j) bb[j] += dpp0<0x112, 0xF>(bb[j]);
#pragma unroll
                for (int j = 0; j < 8; ++j) bb[j] += dpp0<0x114, 0xF>(bb[j]);
#pragma unroll
                for (int j = 0; j < 8; ++j) bb[j] += dpp0<0x118, 0xF>(bb[j]);
#pragma unroll
                for (int j = 0; j < 8; ++j) bb[j] += dpp0<0x142, 0xA>(bb[j]);
#pragma unroll
                for (int j = 0; j < 8; ++j) bb[j] += dpp0<0x143, 0xC>(bb[j]);
                if (PASS == 0) {
#pragma unroll
                    for (int j = 0; j < 8; ++j) { const float r63 = rdlane(bb[j], 63); Km[j] = ex2(r63 - bb[j] + carry[g * 8 + j]); carry[g * 8 + j] += r63; E0[j] = 0.f; a63[j] = 0.f; }
                } else {
#pragma unroll
                    for (int j = 0; j < 8; ++j) { E0[j] = ex2(fmaxf(bb[j], -120.f)); Km[j] = __builtin_amdgcn_rcpf(E0[j]); }
#pragma unroll
                    for (int j = 0; j < 8; ++j) a63[j] = rdlane(E0[j], 63);
                }
            }
            float o0[8], o2[8];
#pragma unroll
            for (int j = 0; j < 8; ++j) { if (MIXER == 2) { o0[j] = q8[j] * fsc.E0; o2[j] = k8[j] * fsc.Km; }
                else { o0[j] = q8[j] * E0[j]; o2[j] = k8[j] * Km[j]; } }
            if (PASS == 1 && lane == 63) {
                if (MIXER == 2) { const f32x4 a4 = (f32x4){fsc.a63, fsc.a63, fsc.a63, fsc.a63}; *(LAS f32x4*)(c_adec + cc * 8) = a4; *(LAS f32x4*)(c_adec + cc * 8 + 4) = a4; }
                else { *(LAS f32x4*)(c_adec + cc * 8) = (f32x4){a63[0], a63[1], a63[2], a63[3]}; *(LAS f32x4*)(c_adec + cc * 8 + 4) = (f32x4){a63[4], a63[5], a63[6], a63[7]}; } }
            *(LAS u32x4*)(lds + L_KM + off_b(lane, cc)) = pack8(o2);
            if (PASS == 1) *(LAS u32x4*)(lds + L_Q0 + off_b(lane, cc)) = pack8(o0);
            if (MIXER == 2) { *(LAS u32x4*)(lds + L_V0 + off_b(lane, cc)) = pack8(v8); if (PASS == 1) *(LAS u32x4*)(lds + L_CV + off_b(lane, cc)) = pack8(ca8); }
            asm volatile("" ::: "memory");
        }
        asm volatile("s_waitcnt lgkmcnt(0)" ::: "memory"); FK_BAR();
        TP_END(2);
        TP_BEGIN(3)
        if (c + 1 < SEGC && MIXER == 2) prefetch(c + 1, false);
        unsigned rrb[8], trE[2], trD[2], trS[NT][2];
        { int lb = lane; asm volatile("" : "+v"(lb));
#pragma unroll
          for (int s = 0; s < 8; ++s) rrb[s] = rr_addr((unsigned)lb, 0u, (unsigned)s);
#pragma unroll
          for (int t = 0; t < 2; ++t) { trE[t] = tr_addr((unsigned)lb, (unsigned)te, 0u, (unsigned)t); trD[t] = tr_addr((unsigned)lb, (unsigned)td, 0u, (unsigned)t);
#pragma unroll
              for (int s = 0; s < NT; ++s) trS[s][t] = tr_addr((unsigned)lb, (unsigned)(te0 + s), 0u, (unsigned)t); } }
        f32x16 oacc, pacc;
#pragma unroll
        for (int r = 0; r < 16; ++r) { oacc[r] = 0.f; pacc[r] = 0.f; }
        if (PASS == 1) {
            int ln1 = lane; asm volatile("" : "+v"(ln1));
#pragma unroll
            for (int s0 = 0; s0 < NKS; s0 += 4) { bf16x8 fa[4], fb[4];
#pragma unroll
              for (int s = 0; s < 4; ++s) { fa[s] = ld_frag(lds + L_Q0 + 8192 * ti + rrb[s0 + s]); fb[s] = ld_frag(lds + L_ST + 8192 * te + rrb[s0 + s]); }
#pragma unroll
              for (int s = 0; s < 4; ++s) oacc = mfma32(fa[s], fb[s], oacc); }
            if (MIXER == 2) {
                const int tid1 = wave * 64 + ln1, row = tid1 >> 3, sg = tid1 & 7; float dsum = 0.f;
#pragma unroll
                for (int hh = 0; hh < 2; ++hh) { const bf16x8 qf = ld_frag(lds + L_Q0 + off_b(row, 2 * sg + hh));
#pragma unroll
                    for (int j = 0; j < 8; ++j) dsum += bf2f((unsigned short)qf[j]) * c_nbuf[(c & 1) * 128 + sg * 16 + hh * 8 + j]; }
                dsum = sum8(dsum);
                if (sg == 0) c_dint[row] = dsum; }
            const int jb = (wave == 1) ? 1 : 0, ib = (wave == 0) ? 0 : 1;
            if (wave < 3) {
#pragma unroll
                for (int s0 = 0; s0 < NKS; s0 += 4) { bf16x8 fa[4], fb[4];
#pragma unroll
                  for (int s = 0; s < 4; ++s) { fa[s] = ld_frag(lds + L_KM + 8192 * jb + rrb[s0 + s]); fb[s] = ld_frag(lds + L_Q0 + 8192 * ib + rrb[s0 + s]); }
#pragma unroll
                  for (int s = 0; s < 4; ++s) pacc = mfma32(fa[s], fb[s], pacc); }
                if (wave < 2) {
#pragma unroll
                    for (int r = 0; r < 16; ++r) { const int jj = (r & 3) + 8 * (r >> 2) + 4 * (ln1 >> 5); if (jj > (ln1 & 31)) pacc[r] = 0.f; } }
                if (MIXER == 2) { float ps = 0.f;
#pragma unroll
                    for (int r = 0; r < 16; ++r) ps += pacc[r];
                    ps += shx(ps, 32, ln1); if (ln1 < 32) c_dpart[wave * 32 + ln1] = ps; } }
            if (wave < 3) {
                int lnp = lane; asm volatile("" : "+v"(lnp));
#pragma unroll
                for (int rg = 0; rg < 4; ++rg) { u32x2 w; w.x = pg8::cvt_pk_bf16(pacc[4 * rg], pacc[4 * rg + 1]); w.y = pg8::cvt_pk_bf16(pacc[4 * rg + 2], pacc[4 * rg + 3]);
                    *(LAS u32x2*)(lds + L_QM + off_b(32 * ib + (lnp & 31), 4 * jb + rg) + 8 * (lnp >> 5)) = w; } }
            asm volatile("s_waitcnt lgkmcnt(0)" ::: "memory"); FK_BAR();
            TP_END(3);
            int ln2 = lane; asm volatile("" : "+v"(ln2));
            { bf16x8 fa[2], fb[2];
#pragma unroll
              for (int s = 0; s < 2; ++s) { fa[s] = ld_frag(lds + L_QM + 8192 * ti + rrb[s]); fb[s] = tr_fragb(Vimg, trE, s); }
#pragma unroll
              for (int s = 0; s < 2; ++s) oacc = mfma32(fa[s], fb[s], oacc);
              if (ti == 1) {
#pragma unroll
                  for (int s = 0; s < 2; ++s) { fa[s] = ld_frag(lds + L_QM + 8192 + rrb[2 + s]); fb[s] = tr_fragb(Vimg, trE, 2 + s); }
#pragma unroll
                  for (int s = 0; s < 2; ++s) oacc = mfma32(fa[s], fb[s], oacc); } }
        }
        TP_BEGIN(4)
        if (PASS == 0) {
            int ln4 = lane; asm volatile("" : "+v"(ln4));
            const short one_or_zero = ((ln4 & 31) == 0) ? (short)0x3f80 : (short)0;
            const bf16x8 onesB = (bf16x8){one_or_zero, one_or_zero, one_or_zero, one_or_zero, one_or_zero, one_or_zero, one_or_zero, one_or_zero};
#pragma unroll
            for (int h4 = 0; h4 < 4; h4 += 2) { bf16x8 fa[2], fb[NT][2];
#pragma unroll
              for (int s4 = 0; s4 < 2; ++s4) { fa[s4] = tr_fragb(lds + L_KM, trD, h4 + s4);
#pragma unroll
                  for (int s = 0; s < NT; ++s) fb[s][s4] = tr_fragb(Vimg, trS[s], h4 + s4); }
#pragma unroll
              for (int s4 = 0; s4 < 2; ++s4) {
#pragma unroll
                  for (int s = 0; s < NT; ++s) st[s] = mfma32(fa[s4], fb[s][s4], st[s]);
                  if (MIXER == 2 && te0 == 0) nacc = mfma32(fa[s4], onesB, nacc); } }
        } else if (c + 1 < SEGC) {
            int ln4 = lane; asm volatile("" : "+v"(ln4));
            f32x16 tmp[NT];
#pragma unroll
            for (int s = 0; s < NT; ++s)
#pragma unroll
                for (int r = 0; r < 16; ++r) tmp[s][r] = 0.f;
#pragma unroll
            for (int h4 = 0; h4 < 4; h4 += 2) { bf16x8 fa[2], fb[NT][2];
#pragma unroll
              for (int s4 = 0; s4 < 2; ++s4) { fa[s4] = tr_fragb(lds + L_KM, trD, h4 + s4);
#pragma unroll
                  for (int s = 0; s < NT; ++s) fb[s][s4] = tr_fragb(Vimg, trS[s], h4 + s4); }
#pragma unroll
              for (int s4 = 0; s4 < 2; ++s4)
#pragma unroll
                  for (int s = 0; s < NT; ++s) tmp[s] = mfma32(fa[s4], fb[s][s4], tmp[s]); }
#pragma unroll
            for (int rg = 0; rg < 4; ++rg) { const f32x4 av = *(const LAS f32x4*)(c_adec + 32 * td + 8 * rg + 4 * (ln4 >> 5));
#pragma unroll
                for (int s = 0; s < NT; ++s)
#pragma unroll
                    for (int q4 = 0; q4 < 4; ++q4) st[s][4 * rg + q4] = (st[s][4 * rg + q4] + tmp[s][4 * rg + q4]) * av[q4]; }
            if (MIXER == 2 && te0 == 0) {
                f32x16 nt;
#pragma unroll
                for (int r = 0; r < 16; ++r) nt[r] = 0.f;
                const short one_or_zero = ((ln4 & 31) == 0) ? (short)0x3f80 : (short)0;
                const bf16x8 onesB = (bf16x8){one_or_zero, one_or_zero, one_or_zero, one_or_zero, one_or_zero, one_or_zero, one_or_zero, one_or_zero};
#pragma unroll
                for (int s4 = 0; s4 < 4; ++s4) nt = mfma32(tr_fragb(lds + L_KM, trD, s4), onesB, nt);
                if ((ln4 & 31) == 0) {
#pragma unroll
                    for (int rg = 0; rg < 4; ++rg) *(LAS f32x4*)(c_ninc + 32 * td + 8 * rg + 4 * (ln4 >> 5)) = (f32x4){nt[4 * rg], nt[4 * rg + 1], nt[4 * rg + 2], nt[4 * rg + 3]}; } }
#pragma unroll
            for (int s = 0; s < NT; ++s) { const int e = 32 * (te0 + s) + (ln4 & 31);
#pragma unroll
                for (int rg = 0; rg < 4; ++rg) { const int d0 = 32 * td + 8 * rg + 4 * (ln4 >> 5);
                    u32x2 w; w.x = pg8::cvt_pk_bf16(st[s][4 * rg], st[s][4 * rg + 1]); w.y = pg8::cvt_pk_bf16(st[s][4 * rg + 2], st[s][4 * rg + 3]);
                    *(LAS u32x2*)(lds + L_ST + off_b(e, d0 >> 3) + (d0 & 7) * 2) = w; } }
        }
        TP_END(4);
        TP_BEGIN(5)
        if (PASS == 1) {
            int ln5 = lane; asm volatile("" : "+v"(ln5));
            asm volatile("s_waitcnt lgkmcnt(0)" ::: "memory"); FK_BAR();
            if (MIXER == 2 && c + 1 < SEGC) { const int t5 = wave * 64 + ln5; if (t5 < 128) c_nbuf[((c + 1) & 1) * 128 + t5] = c_adec[t5] * (c_nbuf[(c & 1) * 128 + t5] + c_ninc[t5]); }
            LAS unsigned char* ob = lds + L_Q0;
#pragma unroll
            for (int r = 0; r < 16; ++r) { const int i = 32 * ti + (r & 3) + 8 * (r >> 2) + 4 * (ln5 >> 5); *(LAS float*)(ob + i * 512 + (32 * te + (ln5 & 31)) * 4) = oacc[r]; }
            asm volatile("s_waitcnt lgkmcnt(0)" ::: "memory"); FK_BAR();
            const int tid5 = wave * 64 + ln5, row = tid5 >> 3, sg = tid5 & 7, e0 = sg * 16; float ov[16], zv[16];
#pragma unroll
            for (int q4 = 0; q4 < 4; ++q4) { const f32x4 t4 = *(const LAS f32x4*)(ob + row * 512 + (e0 + 4 * q4) * 4);
#pragma unroll
                for (int j = 0; j < 4; ++j) ov[4 * q4 + j] = t4[j]; }
#pragma unroll
            for (int hh = 0; hh < 2; ++hh) { const unsigned zz[4] = {zraw[hh].x, zraw[hh].y, zraw[hh].z, zraw[hh].w};
#pragma unroll
                for (int j = 0; j < 4; ++j) { zv[hh * 8 + 2 * j] = __uint_as_float(zz[j] << 16); zv[hh * 8 + 2 * j + 1] = __uint_as_float(zz[j] & 0xffff0000u); } }
            float y[16];
            if (MIXER == 2) {
                const float den = c_dint[row] + (row < 32 ? c_dpart[row] : c_dpart[32 + (row - 32)] + c_dpart[64 + (row - 32)]);
                const float idn = 1.0f / fmaxf(fabsf(den), 1.0f); float sm = 0.f;
#pragma unroll
                for (int j = 0; j < 16; ++j) { ov[j] *= idn; sm += ov[j]; }
                sm = sum8(sm);
                const float mu = sm * (1.0f / 128.0f); float sq = 0.f;
#pragma unroll
                for (int j = 0; j < 16; ++j) { ov[j] -= mu; sq += ov[j] * ov[j]; }
                sq = sum8(sq);
                const float rs = rsqrtf(sq * (1.0f / 128.0f) + 1e-6f);
#pragma unroll
                for (int hh = 0; hh < 2; ++hh) { const bf16x8 cvf = ld_frag(lds + L_CV + off_b(row, 2 * sg + hh));
#pragma unroll
                    for (int j = 0; j < 8; ++j) { const int e = e0 + hh * 8 + j; y[hh * 8 + j] = (ov[hh * 8 + j] * rs * c_g[e] + c_skip[e] * bf2f((unsigned short)cvf[j])) * zv[hh * 8 + j]; } }
            } else {
                float sq = 0.f;
#pragma unroll
                for (int j = 0; j < 16; ++j) sq += ov[j] * ov[j];
                sq = sum8(sq);
                const float rs = rsqrtf(sq * (1.0f / 128.0f) + 1e-6f);
#pragma unroll
                for (int j = 0; j < 16; ++j) y[j] = ov[j] * rs * c_g[e0 + j] * zv[j];
            }
            bf16_t* mo = A.mix + (row0 + (size_t)c * 64 + row) * MIXW + MIXER * 512 + h * 128 + e0;
            u32x4 w0, w1; w0.x = pg8::cvt_pk_bf16(y[0], y[1]); w0.y = pg8::cvt_pk_bf16(y[2], y[3]); w0.z = pg8::cvt_pk_bf16(y[4], y[5]); w0.w = pg8::cvt_pk_bf16(y[6], y[7]);
            w1.x = pg8::cvt_pk_bf16(y[8], y[9]); w1.y = pg8::cvt_pk_bf16(y[10], y[11]); w1.z = pg8::cvt_pk_bf16(y[12], y[13]); w1.w = pg8::cvt_pk_bf16(y[14], y[15]);
            *(u32x4*)mo = w0; *(u32x4*)(mo + 8) = w1;
        }
        TP_END(5);
    }
    if (PASS == 0) {
#pragma unroll
        for (int s = 0; s < NT; ++s)
#pragma unroll
            for (int r = 0; r < 16; ++r) slot[((wave * NT + s) * 16 + r) * 64 + lane] = st[s][r];
        if (lane == 0) {
#pragma unroll
            for (int i = 0; i < NG * 8; ++i) { const int d = (wave + 8 * (i >> 3)) * 8 + (i & 7); slot[16384 + d] = ex2(MIXER == 2 ? carry_s : carry[i]); } }
        if (MIXER == 2 && te0 == 0 && (lane & 31) == 0) {
#pragma unroll
            for (int r = 0; r < 16; ++r) slot[16384 + 128 + 32 * td + (r & 3) + 8 * (r >> 2) + 4 * (lane >> 5)] = nacc[r]; }
    }
    asm volatile("s_waitcnt vmcnt(0) lgkmcnt(0)" ::: "memory"); FK_BAR();
}

__device__ __forceinline__ void mix_combine(float* U, int G, int wg, int wv) {
    int tid_ = wv * 64 + fk_lane(); asm volatile("" : "+v"(tid_)); const int tid = tid_;
    const int nslab = 3 * NBH * 16384, nvec = NBH * 128;
    for (int idx = wg * NTHR + tid; idx < nslab + nvec; idx += G * NTHR) {
        int mixer, bh, e, d; bool isn = false;
        if (idx < nslab) { mixer = idx / (NBH * 16384); const int rem = idx - mixer * (NBH * 16384); bh = rem >> 14; e = rem & 16383;
            if (mixer == 1 && e >= 8192) continue;
            const int ts = e >> 10, r = (e >> 6) & 15, ln = e & 63; const int wv = (mixer == 1) ? ts : (ts >> 1); const int tdd = (mixer == 1) ? (wv >> 2) : (wv >> 1);
            d = 32 * tdd + (r & 3) + 8 * (r >> 2) + 4 * (ln >> 5); }
        else { const int k = idx - nslab; mixer = 2; bh = k >> 7; d = k & 127; e = 16384 + 128 + d; isn = true; }
        (void)isn;
        float* base = U + (size_t)((mixer * NBH + bh) * NSEG) * USZ; float uu[NSEG], aa[NSEG];
#pragma unroll
        for (int sgm = 0; sgm < NSEG; ++sgm) { uu[sgm] = base[(size_t)sgm * USZ + e]; aa[sgm] = base[(size_t)sgm * USZ + 16384 + d]; }
        float carry = 0.f;
#pragma unroll
        for (int sgm = 0; sgm < NSEG; ++sgm) { base[(size_t)sgm * USZ + e] = carry; carry = aa[sgm] * carry + uu[sgm]; }
    }
}
#ifndef REP_INP
#define REP_INP 1
#endif
#ifndef REP_A
#define REP_A 1
#endif
#ifndef REP_B
#define REP_B 1
#endif
#ifndef REP_B0
#define REP_B0 1
#endif
#ifndef REP_B1
#define REP_B1 1
#endif
#ifndef REP_B2
#define REP_B2 1
#endif
#ifndef REP_Q
#define REP_Q 1
#endif
#ifndef REP_ATT
#define REP_ATT 1
#endif
template <class T> __device__ __forceinline__ T* opq(T* p) { auto g = (__attribute__((address_space(1))) T*)p; asm volatile("" : "+s"(g)); return (T*)g; }
__global__ void __launch_bounds__(NTHR, 2) fwd(Args a) {
    extern __shared__ __attribute__((aligned(16))) unsigned char lds_raw[];
    LAS unsigned char* lds = (LAS unsigned char*)lds_raw;
    unsigned char* ws = a.ws;
    const int wv = __builtin_amdgcn_readfirstlane((int)threadIdx.x >> 6);
    if (wv == 0) { const int l0 = fk_lane(); if (l0 < 8) ((LAS unsigned*)(lds + LDS_TP))[l0] = 0u; }
    __syncthreads();
    XcdBarrier bar = xcd_barrier_post((unsigned*)(ws + OFF_CTL), (volatile LAS unsigned*)(lds + LDS_BAR), wv);
    const int lo = a.ph_lo, hi = a.ph_hi, G = gridDim.x, wg = blockIdx.x; (void)lo; (void)hi;
    grp_census_post(bar, wg & 7, wv);
#ifdef FK_PHASE_RANGE
#define IN(k) (lo <= (k) && (k) < hi)
#else
#define IN(k) true
#endif
#ifdef PHPROBE
#define PH_BEGIN(k) unsigned long long ph_t0_##k = 0; if (PHPROBE == (k)) ph_t0_##k = __builtin_amdgcn_s_memrealtime();
#define PH_END(k) do { if (PHPROBE == (k) && wv == 0) { const unsigned long long d_ = __builtin_amdgcn_s_memrealtime() - ph_t0_##k; if (fk_lane() == 0) *(volatile LAS unsigned long long*)(lds + LDS_TP) += d_; } } while (0)
#else
#define PH_BEGIN(k)
#define PH_END(k) do { } while (0)
#endif
#define SEAM(k) do { if (IN(k) && IN((k) + 1)) { PH_BEGIN(100) xcd_barrier(bar, wv); PH_END(100); } } while (0)
#define GSEAM(k) do { if (IN(k) && IN((k) + 1)) { PH_BEGIN(100) if (G == 256) grp_barrier(bar, wg & 7, 32u, wv); else xcd_barrier(bar, wv); PH_END(100); } } while (0)
    float* ssq = (float*)(ws + OFF_SSQ);
    const size_t qoff = (G == 256) ? (size_t)(wg & 7) * ((size_t)4096 * NPROJ * 2 - (size_t)4096 * 2048) : (size_t)0, ooff = (G == 256) ? qoff + (size_t)4096 * 2048 : SZ_XB;
    bf16_t* xb = (bf16_t*)(ws + OFF_XB);

    { PH_BEGIN(0) if (IN(0)) p0_prologue(a, lds, wv); PH_END(0); }
    SEAM(0);
    grp_census_read(bar, wg & 7, wv);
    if (IN(2)) { const int c = wg; int sub = -1, nsub = 96;
        if (G == 256) { if (c >= 144 && !(c >= 160 && c < 176)) sub = c < 160 ? c - 144 : 16 + (c - 176); } else { sub = c; nsub = G; }
        if (sub >= 0) p0_weights(a, lds, 1, sub, nsub, wv); }
#pragma unroll 1
    for (int l = 0; l < 2; ++l) {
        const int pb = 2 + 8 * l;
        if (IN(pb)) {
            { pg8::Gemm g{(const bf16_t*)(opq(ws) + OFF_MEMN + l * SZ_SQ), (const bf16_t*)(opq(ws) + OFF_WK + l * SZ_SQ), 1024, 1024, 1024}; pg8::StaticOrder So; So.init(1024, 1024, G, (wg + G - G / 2) % G);
              pg8::EpiBf16S E{(bf16_t*)(opq(ws) + OFF_KM + l * SZ_SQ), 1024, nullptr}; pg8::gemm_phase<pg8::EpiBf16S, pg8::StaticOrder>(lds, g, So, E, nullptr, wv); }
            { pg8::Gemm g{(const bf16_t*)(opq(ws) + OFF_WV + l * SZ_SQ), (const bf16_t*)(opq(ws) + OFF_MEMN + l * SZ_SQ), 1024, 1024, 1024}; pg8::StaticOrder So; So.init(1024, 1024, G, (wg + G - G / 2 - 32) % G);
              pg8::EpiVt E{(bf16_t*)(opq(ws) + OFF_VT + l * SZ_SQ)}; pg8::gemm_phase<pg8::EpiVt, pg8::StaticOrder>(lds, g, So, E, nullptr, wv); }
        }
#ifdef FK_STAGGER
        if ((wg >> 3) & 1) { for (int i = 0; i < FK_STAGGER; ++i) __builtin_amdgcn_s_sleep(127); }
#endif
        PH_BEGIN(1)
        for (int rep = 0; rep < REP_INP; ++rep) if (IN(pb)) {
            pg8::Gemm g{opq(xb), (const bf16_t*)(opq(ws) + OFF_WIN + l * SZ_WIN), MR, NPAD, D}; pg8::StaticOrder So; So.init(MR, NPAD, G, wg);
            pg8::EpiInProj E{(bf16_t*)(opq(ws) + OFF_PROJ), (float*)(opq(ws) + OFF_EXT), opq(ssq) + (size_t)(2 * l) * 32768, (const float*)(opq(ws) + OFF_LB) + l * 512};
            pg8::gemm_phase<pg8::EpiInProj, pg8::StaticOrder>(lds, g, So, E, nullptr, wv);
        }
        PH_END(1);
        SEAM(pb);
        MixArgs MA{(const bf16_t*)(opq(ws) + OFF_PROJ), (const float*)(opq(ws) + OFF_EXT), (bf16_t*)(opq(ws) + OFF_MIX), opq(a.out)  ,
                   a.in[5] + l * 128, a.in[6] + l * 16 * 256, a.in[7] + l * 256, a.in[8] + l * 128, a.in[9] + l * 4 * 512, a.in[10] + l * 512, a.in[11] + l * 128 * 16, a.in[12] + l * 128 * 16, a.in[13] + l * 128 * 16,
                   a.in[14] + l * 4, a.in[15] + l * 4, a.in[16] + l * 512, a.in[17] + l * 512};
#define MIX_BH(u)  (G == 256 ? ((u) & 7) / 2 * 4 + ((u) >> 6) : (u) / NSEG)
#define MIX_SEG(u) (G == 256 ? ((u) & 1) * 8 + (((u) >> 3) & 7) : (u) % NSEG)
        for (int rep = 0; rep < REP_A; ++rep) {
        PH_BEGIN(2)
        if (IN(pb + 1)) {
            for (int u = wg; u < NBH * NSEG; u += G) mix_unit<0, 0>(lds, MA, MIX_BH(u), MIX_SEG(u), wv);
            for (int u = wg; u < NBH * NSEG; u += G) mix_unit<1, 0>(lds, MA, MIX_BH(u), MIX_SEG(u), wv);
            for (int u = wg; u < NBH * NSEG; u += G) mix_unit<2, 0>(lds, MA, MIX_BH(u), MIX_SEG(u), wv);
        }
        PH_END(2);
        SEAM(pb + 1);
        PH_BEGIN(3)
        if (IN(pb + 2)) mix_combine(MA.U, G, wg, wv);
        PH_END(3);
        SEAM(pb + 2);
        }
        PH_BEGIN(4)
        for (int rep = 0; rep < REP_B; ++rep) if (IN(pb + 3)) {
            for (int r0 = 0; r0 < REP_B0; ++r0) for (int u = wg; u < NBH * NSEG; u += G) mix_unit<0, 1>(lds, MA, MIX_BH(u), MIX_SEG(u), wv);
            for (int r1 = 0; r1 < REP_B1; ++r1) for (int u = wg; u < NBH * NSEG; u += G) mix_unit<1, 1>(lds, MA, MIX_BH(u), MIX_SEG(u), wv);
            for (int r2 = 0; r2 < REP_B2; ++r2) for (int u = wg; u < NBH * NSEG; u += G) mix_unit<2, 1>(lds, MA, MIX_BH(u), MIX_SEG(u), wv);
        }
        PH_END(4);
        GSEAM(pb + 3);
        PH_BEGIN(5)
        if (IN(pb + 4)) {
            pg8::Gemm g{(const bf16_t*)(opq(ws) + OFF_MIX), (const bf16_t*)(opq(ws) + OFF_WOUT + l * SZ_WOUT), MR, D, MIXW}; pg8::StaticOrder So; So.init(MR, D, G, wg);
            pg8::EpiResid E{l == 0 ? opq(a.in[0]) : (const float*)nullptr, opq(xb), opq(ssq) + (size_t)(2 * l + 1) * 32768};
            pg8::gemm_phase<pg8::EpiResid, pg8::StaticOrder>(lds, g, So, E, nullptr, wv);
        }
        PH_END(5);
        GSEAM(pb + 4);
        PH_BEGIN(6)
        for (int rep = 0; rep < REP_Q; ++rep) if (IN(pb + 5)) {
            pg8::Gemm g{opq(xb), (const bf16_t*)(opq(ws) + OFF_WQ + l * SZ_SQ), MR, D, D}; pg8::StaticOrder So; So.init(MR, D, G, wg);
            pg8::EpiBf16S E{(bf16_t*)(opq(ws) + OFF_PROJ + qoff), D, opq(ssq) + (size_t)(2 * l + 1) * 32768};
            pg8::gemm_phase<pg8::EpiBf16S, pg8::StaticOrder>(lds, g, So, E, nullptr, wv);
        }
        PH_END(6);
        PH_BEGIN(7)
        for (int rep = 0; rep < REP_ATT; ++rep) if (IN(pb + 6)) { pg8::StaticOrder So; So.init(MR, D, G, wg);
            attn_phase(lds, (const bf16_t*)(opq(ws) + OFF_PROJ + qoff), (const bf16_t*)(opq(ws) + OFF_KM + l * SZ_SQ), (const bf16_t*)(opq(ws) + OFF_VT + l * SZ_SQ), (bf16_t*)(opq(ws) + OFF_PROJ + ooff), So, wv); }
        PH_END(7);
        GSEAM(pb + 6);
        PH_BEGIN(8)
        if (IN(pb + 7)) {
            pg8::Gemm g{(const bf16_t*)(opq(ws) + OFF_PROJ + ooff), (const bf16_t*)(opq(ws) + OFF_WO + l * SZ_SQ), MR, D, D}; pg8::StaticOrder So; So.init(MR, D, G, wg);
            pg8::EpiResid E{(const float*)nullptr, opq(xb), opq(ssq) + (size_t)(2 * l + 2) * 32768};
            pg8::gemm_phase<pg8::EpiResid, pg8::StaticOrder>(lds, g, So, E, nullptr, wv);
        }
        PH_END(8);
        if (l == 0) { GSEAM(pb + 7);
            if (G == 256 && !(wg & 1)) { if (wv == 0 && fk_lane() == 0) { unsigned* cb = (unsigned*)(ws + OFF_CTL); XB_SPIN(xb_ld(&cb[GB_CNT((wg & 7) + 1)]) < 32u, cb); } __syncthreads(); } }
        else { GSEAM(pb + 7);
            if (G == 256) { if (wv == 0 && fk_lane() < 8) { unsigned* cb = (unsigned*)(ws + OFF_CTL); XB_SPIN(xb_ld(&cb[GB_CNT(fk_lane())]) < 160u, cb); } __syncthreads(); } }
    }
    PH_BEGIN(18)
    if (IN(18)) { const int lane = fk_lane(), wave = wv; const float* gf = a.in[25]; const float* sq = ssq + (size_t)4 * 32768;
        for (int it = 0; it < MR / (G * 8); ++it) { const int row = (G == 256) ? (wg & 7) * 4096 + (wg >> 3) * 128 + it * 8 + wave : (it * G + wg) * 8 + wave;
            const float rs = rsqrtf(sq[row] * (1.0f / 1024.0f) + 1e-6f);
#pragma unroll
            for (int i = 0; i < 2; ++i) { const int c0 = i * 512 + lane * 8; const u32x4 o = *(const u32x4*)(xb + (size_t)row * D + c0); const f32x4 g0 = *(const f32x4*)(gf + c0), g1 = *(const f32x4*)(gf + c0 + 4);
                const f32x4 x0 = (f32x4){__uint_as_float(o.x << 16), __uint_as_float(o.x & 0xffff0000u), __uint_as_float(o.y << 16), __uint_as_float(o.y & 0xffff0000u)};
                const f32x4 x1 = (f32x4){__uint_as_float(o.z << 16), __uint_as_float(o.z & 0xffff0000u), __uint_as_float(o.w << 16), __uint_as_float(o.w & 0xffff0000u)};
                float* p = a.out + (size_t)row * D + c0; *(f32x4*)p = x0 * rs * g0; *(f32x4*)(p + 4) = x1 * rs * g1; } } }
    PH_END(18);
#undef IN
#undef SEAM
#ifdef PHMIN
    { if (wv == 0 && fk_lane() == 0) { const unsigned long long acc = *(volatile LAS unsigned long long*)(lds + LDS_TP); atomicMax((unsigned*)(ws + OFF_CTL) + 16000, 0x80000000u - (unsigned)acc); }
      xcd_barrier(bar, wv);
      if (wv == 0 && fk_lane() == 0) { const unsigned m = __hip_atomic_load((unsigned*)(ws + OFF_CTL) + 16000, __ATOMIC_RELAXED, __HIP_MEMORY_SCOPE_AGENT); *(volatile LAS unsigned long long*)(lds + LDS_TP) = (unsigned long long)(0x80000000u - m); }
      __syncthreads(); }
#endif
#if defined(TPROBE) || defined(PHPROBE) || defined(ATP) || defined(GPROBE)
    if (wv == 0) { asm volatile("s_waitcnt vmcnt(0) lgkmcnt(0)" ::: "memory"); const unsigned long long acc = *(volatile LAS unsigned long long*)(lds + LDS_TP), t0 = __builtin_amdgcn_s_memrealtime(); while (__builtin_amdgcn_s_memrealtime() - t0 < acc) __builtin_amdgcn_s_sleep(8); }
#endif
}
}
static int fk_launch(void* const* d_in, void* d_out, void* d_ws, int lo, int hi, hipStream_t stream) {
    static int grid = 0;
    if (grid == 0) {
        int dev = 0, cus = 0, per_cu = 0;
        if (hipGetDevice(&dev) != hipSuccess || hipDeviceGetAttribute(&cus, hipDeviceAttributeMultiprocessorCount, dev) != hipSuccess) { grid = -1; return -1; }
        if (hipFuncSetAttribute((const void*)fk::fwd, hipFuncAttributeMaxDynamicSharedMemorySize, fk::LDS_BYTES) != hipSuccess) { fprintf(stderr, "hipFuncSetAttribute failed\n"); grid = -1; return -1; }
        if (hipOccupancyMaxActiveBlocksPerMultiprocessor(&per_cu, (const void*)fk::fwd, fk::NTHR, fk::LDS_BYTES) != hipSuccess || per_cu < 1) { fprintf(stderr, "occupancy query: %d\n", per_cu); (void)hipGetLastError(); grid = -1; return -1; }
        grid = cus;
    }
    if (grid < 0) return -1;
    (void)hipMemsetAsync(d_ws, 0, fk::ZERO_BYTES, stream);
    fk::Args a{};
    for (int i = 0; i < 26; ++i) a.in[i] = (const float*)d_in[i];
    a.out = (float*)d_out; a.ws = (unsigned char*)d_ws; a.ph_lo = lo; a.ph_hi = hi;
    hipLaunchKernelGGL(fk::fwd, dim3(grid), dim3(fk::NTHR), fk::LDS_BYTES, stream, a);
    return 0;
}
extern "C" void kernel_launch(void* const* d_in, const int* in_sizes, int n_in, void* d_out, int out_size, void* d_ws, size_t ws_size, hipStream_t stream) {
    if (n_in != 26 || ws_size < fk::WS_END || out_size != fk::MR * fk::D) { fprintf(stderr, "kernel_launch: unexpected shapes (n_in %d, ws %zu, out %d)\n", n_in, ws_size, out_size); return; }
    fk_launch(d_in, d_out, d_ws, 0, 19, stream);
}
```

```cpp
#include <hip/hip_runtime.h>
#include <cstdio>
namespace pg8 {
#define PG8_LAS __attribute__((address_space(3)))
typedef unsigned short bf16_t;
typedef short bf16x8 __attribute__((ext_vector_type(8)));
typedef float f32x4 __attribute__((ext_vector_type(4)));
typedef unsigned u32x4 __attribute__((ext_vector_type(4)));
constexpr int BM = 256, BK = 64, HALF = 128, HTB = HALF * BK * 2  , STAGE_BYTES = 8 * HTB, NXCD = 8, WGM = 8;

__host__ __device__ __forceinline__ int lds_byte(int r, int c) { const int st = (r >> 4) * 2 + (c >> 5), rr = r & 15, cc = c & 31, ob = rr * 64 + cc * 2; return st * 1024 + (ob ^ (((ob >> 9) & 1) << 5)); }
__host__ __device__ __forceinline__ void stage_rc(int b, int& R, int& C) { const int st = b / 1024, sb = b % 1024, swz = sb ^ (((sb >> 9) & 1) << 5); R = (st >> 1) * 16 + swz / 64; C = (st & 1) * 32 + (swz % 64) / 2; }
__host__ __device__ __forceinline__ int perm32(int rho) { const int n = rho >> 4, i = rho & 15; return 8 * (i >> 2) + 4 * n + (i & 3); }

struct Unit { int pm, pn; };
struct Gemm { const bf16_t* A; const bf16_t* Bt; int M, N, K; };

struct StaticOrder {
    int nM, nN, nwg, G, c, rev;
    __host__ __device__ void init(int M, int N, int G_, int c_, int rev_ = 0) { nM = M / BM; nN = N / BM; nwg = nM * nN; G = G_; c = c_; rev = rev_; }
    __host__ __device__ bool next(int i, Unit& u) const {
        const int nr = c < nwg ? (nwg - c + G - 1) / G : 0;
        if (i >= nr) return false;
        const long L = (long)(rev ? nr - 1 - i : i) * G + c;
        int wgid = (int)L; { const int q = nwg / NXCD, r = nwg % NXCD, xcd = wgid % NXCD, off = wgid / NXCD; wgid = (xcd < r ? xcd * (q + 1) : r * (q + 1) + (xcd - r) * q) + off; }
        const int nig = WGM * nN, gid = wgid / nig, fm = gid * WGM, gsz = (nM - fm) < WGM ? (nM - fm) : WGM;
        u.pm = fm + ((wgid % nig) % gsz); u.pn = (wgid % nig) / gsz; return true;
    }
    __device__ __forceinline__ void a_ready(const Unit&) const {}
    __device__ __forceinline__ void done(const Unit&) const {}
};
__device__ __forceinline__ unsigned cvt_pk_bf16(float lo, float hi) { unsigned r; asm volatile("v_cvt_pk_bf16_f32 %0, %1, %2" : "=v"(r) : "v"(lo), "v"(hi)); return r; }
typedef float f32x2e __attribute__((ext_vector_type(2)));
__device__ __forceinline__ float fsigm(float v) { return __builtin_amdgcn_rcpf(1.0f + __expf(-v)); }
__device__ __forceinline__ unsigned pk_h2(float a, float b) { const _Float16 ha = (_Float16)a, hb = (_Float16)b; return (unsigned)__builtin_bit_cast(unsigned short, ha) | ((unsigned)__builtin_bit_cast(unsigned short, hb) << 16); }
__device__ __forceinline__ float log2_1mk(float k) { const float ser = -(k + k * k * (0.5f + k * (0.33333334f + 0.25f * k))) * 1.4426950408889634f; return k < 0.03f ? ser : __log2f(1.0f - k); }

struct EpiInProj {
    static constexpr bool PERM = true, AFTER_DRAIN = false; static constexpr int ID = 0;
    bf16_t* proj; float* ext; const float* ssq; const float* lb;
    static constexpr bool PRE = true;
    __device__ __forceinline__ const float* pre_src(const Unit& u, int wr) const { return ssq + u.pm * BM + wr * 64; }
    __device__ __forceinline__ void operator()(const f32x4 (&acc)[2][2][4][2], const Unit& u, int wr, int wc, int fr, int fq, const float (&pre)[8]) const {
        const int row0 = u.pm * BM + wr * 64 + fr, pn = u.pn;
        const int kind = (pn == 18) ? 4 : (pn == 2 || pn == 3) ? 2 : (pn == 8) ? 3 : (pn == 0 || pn == 1 || pn == 6 || pn == 7 || pn == 12 || pn == 13 || pn == 16 || pn == 17) ? 1 : 0;
        const int col0 = pn * BM + wc * 32 + 8 * fq;
        if (kind == 4) {
#pragma unroll
            for (int ai = 0; ai < 2; ++ai)
#pragma unroll
                for (int m = 0; m < 4; ++m) { const int r = row0 + ai * HALF + m * 16; const float rs = rsqrtf(pre[ai * 4 + m] * (1.0f / 1024.0f) + 1e-6f);
                    if (wc == 0) { float* e = ext + (size_t)r * 32 + 8 * fq; *(f32x4*)e = acc[ai][0][m][0] * rs; *(f32x4*)(e + 4) = acc[ai][0][m][1] * rs; } }
            return;
        }
        float rsv[2][4];
#pragma unroll
        for (int ai = 0; ai < 2; ++ai)
#pragma unroll
            for (int m = 0; m < 4; ++m) rsv[ai][m] = rsqrtf(pre[ai * 4 + m] * (1.0f / 1024.0f) + 1e-6f);
#pragma unroll
        for (int bj = 0; bj < 2; ++bj) {
            float lbv[8];
#pragma unroll
            for (int j = 0; j < 8; ++j) lbv[j] = (kind == 2) ? lb[(pn - 2) * BM + bj * HALF + wc * 32 + 8 * fq + j] : 0.f;
#pragma unroll
            for (int ai = 0; ai < 2; ++ai)
#pragma unroll
                for (int m = 0; m < 4; ++m) {
                    const int r = row0 + ai * HALF + m * 16; const float rs = rsv[ai][m];
                    bf16_t* rowp = proj + (size_t)r * 4608 + col0;
                    float v[8];
#pragma unroll
                    for (int j = 0; j < 4; ++j) { v[j] = acc[ai][bj][m][0][j] * rs; v[4 + j] = acc[ai][bj][m][1][j] * rs; }
                    u32x4 w;
                    if (kind == 2) {
#pragma unroll
                        for (int j = 0; j < 8; ++j) { const float k = (1.0f - lbv[j]) * fsigm(-v[j]); v[j] = log2_1mk(k); }
                        w.x = pk_h2(v[0], v[1]); w.y = pk_h2(v[2], v[3]); w.z = pk_h2(v[4], v[5]); w.w = pk_h2(v[6], v[7]);
                    } else {
                        if (kind == 1) {
#pragma unroll
                            for (int j = 0; j < 8; ++j) v[j] = v[j] * fsigm(v[j]);
                        } else if (kind == 3) {
#pragma unroll
                            for (int j = 0; j < 8; ++j) v[j] *= 0.125f;
                        }
                        w.x = cvt_pk_bf16(v[0], v[1]); w.y = cvt_pk_bf16(v[2], v[3]); w.z = cvt_pk_bf16(v[4], v[5]); w.w = cvt_pk_bf16(v[6], v[7]);
                    }
                    *(u32x4*)(rowp + bj * HALF) = w;
                }
        }
    }
};

struct EpiResid {
    static constexpr bool PERM = true, AFTER_DRAIN = false; static constexpr int ID = 1;
    const float* x32; bf16_t* xb; float* ssq;
    static constexpr bool PRE = false;
    __device__ __forceinline__ void operator()(const f32x4 (&acc)[2][2][4][2], const Unit& u, int wr, int wc, int fr, int fq, const float (&)[8]) const {
        const int row0 = u.pm * BM + wr * 64 + fr, col0 = u.pn * BM + wc * 32 + 8 * fq;
        const int ln = fq * 16 + fr;
#pragma unroll
        for (int ai = 0; ai < 2; ++ai) {
            f32x4 xo[4][2][2];
            if (x32) {
#pragma unroll
                for (int m = 0; m < 4; ++m)
#pragma unroll
                    for (int bj = 0; bj < 2; ++bj) { const size_t off = (size_t)(row0 + ai * HALF + m * 16) * 1024 + col0 + bj * HALF; xo[m][bj][0] = *(const f32x4*)(x32 + off); xo[m][bj][1] = *(const f32x4*)(x32 + off + 4); }
            } else {
                u32x4 ob[4][2];
#pragma unroll
                for (int m = 0; m < 4; ++m)
#pragma unroll
                    for (int bj = 0; bj < 2; ++bj) ob[m][bj] = *(const u32x4*)(xb + (size_t)(row0 + ai * HALF + m * 16) * 1024 + col0 + bj * HALF);
#pragma unroll
                for (int m = 0; m < 4; ++m)
#pragma unroll
                    for (int bj = 0; bj < 2; ++bj) { const u32x4 o = ob[m][bj];
                        xo[m][bj][0] = (f32x4){__uint_as_float(o.x << 16), __uint_as_float(o.x & 0xffff0000u), __uint_as_float(o.y << 16), __uint_as_float(o.y & 0xffff0000u)};
                        xo[m][bj][1] = (f32x4){__uint_as_float(o.z << 16), __uint_as_float(o.z & 0xffff0000u), __uint_as_float(o.w << 16), __uint_as_float(o.w & 0xffff0000u)}; }
            }
#pragma unroll
            for (int m = 0; m < 4; ++m) {
                const int r = row0 + ai * HALF + m * 16; const size_t off = (size_t)r * 1024 + col0; float ss = 0.f;
#pragma unroll
                for (int bj = 0; bj < 2; ++bj) {
                    const f32x4 x0 = xo[m][bj][0] + acc[ai][bj][m][0], x1 = xo[m][bj][1] + acc[ai][bj][m][1];
                    u32x4 w; w.x = cvt_pk_bf16(x0[0], x0[1]); w.y = cvt_pk_bf16(x0[2], x0[3]); w.z = cvt_pk_bf16(x1[0], x1[1]); w.w = cvt_pk_bf16(x1[2], x1[3]);
                    *(u32x4*)(xb + off + bj * HALF) = w;
                    ss += (x0[0] * x0[0] + x0[1] * x0[1]) + (x0[2] * x0[2] + x0[3] * x0[3]) + (x1[0] * x1[0] + x1[1] * x1[1]) + (x1[2] * x1[2] + x1[3] * x1[3]);
                }
                ss += __builtin_bit_cast(float, __builtin_amdgcn_ds_bpermute((ln ^ 16) << 2, __builtin_bit_cast(int, ss))); ss += __builtin_bit_cast(float, __builtin_amdgcn_ds_bpermute((ln ^ 32) << 2, __builtin_bit_cast(int, ss)));
                if (fq == 0) unsafeAtomicAdd(ssq + r, ss);
            }
            asm volatile("" ::: "memory");
        }
    }
};

struct EpiBf16S {
    static constexpr bool PERM = true, AFTER_DRAIN = false; static constexpr int ID = 2;
    bf16_t* O; int ldc; const float* ssq;
    static constexpr bool PRE = true;
    __device__ __forceinline__ const float* pre_src(const Unit& u, int wr) const { return ssq ? ssq + u.pm * BM + wr * 64 : (const float*)O; }
    __device__ __forceinline__ void operator()(const f32x4 (&acc)[2][2][4][2], const Unit& u, int wr, int wc, int fr, int fq, const float (&pre)[8]) const {
        const int row0 = u.pm * BM + wr * 64 + fr, col0 = u.pn * BM + wc * 32 + 8 * fq;
#pragma unroll
        for (int ai = 0; ai < 2; ++ai)
#pragma unroll
            for (int m = 0; m < 4; ++m) {
                const int r = row0 + ai * HALF + m * 16; const float rs = ssq ? rsqrtf(pre[ai * 4 + m] * (1.0f / 1024.0f) + 1e-6f) : 1.0f;
                bf16_t* rowp = O + (size_t)r * ldc + col0;
#pragma unroll
                for (int bj = 0; bj < 2; ++bj) { const f32x4 v0 = acc[ai][bj][m][0] * rs, v1 = acc[ai][bj][m][1] * rs;
                    u32x4 w; w.x = cvt_pk_bf16(v0[0], v0[1]); w.y = cvt_pk_bf16(v0[2], v0[3]); w.z = cvt_pk_bf16(v1[0], v1[1]); w.w = cvt_pk_bf16(v1[2], v1[3]);
                    *(u32x4*)(rowp + bj * HALF) = w;
#ifdef EPI_DUP
                    if (ssq) *(u32x4*)(rowp + bj * HALF + (size_t)32768 * 1024) = w;
#endif
                    }
            }
    }
};

struct EpiVt {
    static constexpr bool PERM = true, AFTER_DRAIN = false; static constexpr int ID = 3;
    bf16_t* O;
    static constexpr bool PRE = false;
    __device__ __forceinline__ void operator()(const f32x4 (&acc)[2][2][4][2], const Unit& u, int wr, int wc, int fr, int fq, const float (&)[8]) const {
        const int row0 = u.pm * BM + wr * 64 + fr, colb = u.pn * BM + wc * 32;
        typedef unsigned u32x2 __attribute__((ext_vector_type(2)));
#pragma unroll
        for (int ai = 0; ai < 2; ++ai)
#pragma unroll
            for (int m = 0; m < 4; ++m) {
                bf16_t* rowp = O + (size_t)(row0 + ai * HALF + m * 16) * 1024 + colb;
#pragma unroll
                for (int bj = 0; bj < 2; ++bj)
#pragma unroll
                    for (int n = 0; n < 2; ++n) { const f32x4 v = acc[ai][bj][m][n]; const int p = (fq >> 1) * 16 + n * 8 + (fq & 1) * 4;
                        u32x2 w; w.x = cvt_pk_bf16(v[0], v[1]); w.y = cvt_pk_bf16(v[2], v[3]); *(u32x2*)(rowp + bj * HALF + p) = w; }
            }
    }
};
template <class Epi, class Sched, bool STAMP = false>
__device__ __forceinline__ void gemm_phase(PG8_LAS unsigned char* lds, const Gemm g, const Sched& S, const Epi& E, unsigned long long* stamps, const int wv_) {
    int tid_; asm volatile("v_mbcnt_lo_u32_b32 %0, -1, 0\n\tv_mbcnt_hi_u32_b32 %0, -1, %0" : "=v"(tid_)); tid_ += wv_ * 64;
    const int tid = tid_, wid = __builtin_amdgcn_readfirstlane(tid >> 6), lane = tid & 63, wr = wid >> 2, wc = wid & 3, fr = lane & 15, fq = lane >> 4;
    const int K = g.K, nt = K / BK;
    int ts_lo = 0, ts_hi = 0, nts = 0; const unsigned long long rt_entry = STAMP ? (unsigned long long)wall_clock64() : 0ull;
#define PG8_STAMP() do { if (STAMP && wid == 0 && nts < 64) { const unsigned long long _c = (unsigned long long)clock64(); \
        ts_lo = (lane == nts) ? (int)(unsigned)_c : ts_lo; ts_hi = (lane == nts) ? (int)(unsigned)(_c >> 32) : ts_hi; ++nts; } } while (0)
    PG8_STAMP();
    unsigned voffA[2], voffB[2];
#pragma unroll
    for (int i = 0; i < 2; ++i) { int R, C; stage_rc(tid * 16 + i * 8192, R, C); const int Rb = Epi::PERM ? ((R & ~31) + perm32(R & 31)) : R;
        voffA[i] = (unsigned)(R * K + C) * 2u; voffB[i] = (unsigned)(Rb * K + C) * 2u; }
    const size_t kstep = (size_t)(BK * 2);
    const size_t hstep = (size_t)HALF * K * 2;
    const size_t tstep = 2 * hstep;
    const unsigned lds_u = (unsigned)(size_t)lds;
    const unsigned ldsw = (unsigned)wid * 1024u;
    const int aoff = lds_byte(wr * 64 + fr, fq * 8), boff = lds_byte(wc * 32 + fr, fq * 8);
#define PG8_SA(b, h) (((b) * 2 + (h)) * HTB)
#define PG8_SB(b, h) ((4 + (b) * 2 + (h)) * HTB)
#define PG8_STAGE(bufoff, gbase, voff) do { _Pragma("unroll") for (int _i = 0; _i < 2; ++_i) { unsigned _keep; \
        asm volatile("s_mov_b32 %0, m0\n\ts_mov_b32 m0, %3\n\ts_nop 0\n\tglobal_load_lds_dwordx4 %1, %2\n\ts_mov_b32 m0, %0" : "=&s"(_keep) : "v"((voff)[_i]), "s"((const void*)(gbase)), "s"((unsigned)(lds_u + (unsigned)(bufoff) + ldsw + _i * 8192)) : "memory"); } } while (0)
#define PG8_LDA(dst, b, h) do { _Pragma("unroll") for (int m = 0; m < 4; ++m) _Pragma("unroll") for (int k = 0; k < 2; ++k) dst[m][k] = *(const PG8_LAS bf16x8*)(lds + PG8_SA(b, h) + aoff + m * 2048 + k * 1024); } while (0)
#define PG8_LDB(dst, b, h) do { _Pragma("unroll") for (int n = 0; n < 2; ++n) _Pragma("unroll") for (int k = 0; k < 2; ++k) dst[n][k] = *(const PG8_LAS bf16x8*)(lds + PG8_SB(b, h) + boff + n * 2048 + k * 1024); } while (0)
#define PG8_MMA(ai, bj, At, Bt) do { __builtin_amdgcn_s_setprio(1); _Pragma("unroll") for (int m = 0; m < 4; ++m) _Pragma("unroll") for (int n = 0; n < 2; ++n) _Pragma("unroll") for (int k = 0; k < 2; ++k) \
        acc[ai][bj][m][n] = __builtin_amdgcn_mfma_f32_16x16x32_bf16(Bt[n][k], At[m][k], acc[ai][bj][m][n], 0, 0, 0); __builtin_amdgcn_s_setprio(0); } while (0)
#define PG8_WAIT_V(n) asm volatile("s_waitcnt vmcnt(" #n ")" ::: "memory")
#define PG8_WAIT_L(n) asm volatile("s_waitcnt lgkmcnt(" #n ")" ::: "memory")
#define PG8_BAR __builtin_amdgcn_s_barrier()
#define PG8_SCHED __builtin_amdgcn_sched_barrier(0)
#ifdef GPROBE
#define GP_BEGIN(k) unsigned long long gp_t0_##k = 0; if (GPROBE == (k) && Epi::ID == GPROBE_ID) gp_t0_##k = __builtin_amdgcn_s_memrealtime();
#define GP_END(k) do { if (GPROBE == (k) && Epi::ID == GPROBE_ID && wid == 0) { const unsigned long long d_ = __builtin_amdgcn_s_memrealtime() - gp_t0_##k; if (lane == 0) *(volatile PG8_LAS unsigned long long*)(lds + 163840 - 32) += d_; } } while (0)
#else
#define GP_BEGIN(k)
#define GP_END(k) do { } while (0)
#endif
    Unit cur, nxt; int ui = 0;
    if (!S.next(0, cur)) return;
    f32x4 acc[2][2][4][2];
#pragma unroll
    for (int a = 0; a < 2; ++a)
#pragma unroll
        for (int b = 0; b < 2; ++b)
#pragma unroll
            for (int m = 0; m < 4; ++m)
#pragma unroll
                for (int n = 0; n < 2; ++n) acc[a][b][m][n] = (f32x4){0.f, 0.f, 0.f, 0.f};
    bf16x8 At[4][2], B0[2][2], B1[2][2];
    float pre[8];
#pragma unroll
    for (int i = 0; i < 8; ++i) pre[i] = 0.f;
    const char* cA = (const char*)g.A + (size_t)cur.pm * tstep; const char* cB = (const char*)g.Bt + (size_t)cur.pn * tstep;
    S.a_ready(cur);
    PG8_STAGE(PG8_SB(0, 0), cB, voffB); PG8_STAGE(PG8_SA(0, 0), cA, voffA); PG8_STAGE(PG8_SB(0, 1), cB + hstep, voffB); PG8_STAGE(PG8_SA(0, 1), cA + hstep, voffA);
    if (wr == 1) PG8_BAR;
    PG8_WAIT_V(4); PG8_BAR;
    PG8_STAGE(PG8_SB(1, 0), cB + kstep, voffB); PG8_STAGE(PG8_SA(1, 0), cA + kstep, voffA); PG8_STAGE(PG8_SB(1, 1), cB + hstep + kstep, voffB);
    PG8_WAIT_V(6); PG8_BAR;
    PG8_STAMP();
    for (;;) {
        const bool has_next = S.next(ui + 1, nxt);
        const char* nA = has_next ? (const char*)g.A + (size_t)nxt.pm * tstep : cA; const char* nB = has_next ? (const char*)g.Bt + (size_t)nxt.pn * tstep : cB;
        GP_BEGIN(4)
        for (int t = 0; t < nt; t += 2) {
            const bool last = (t == nt - 2);
            GP_BEGIN(2) GP_BEGIN(3)
            const char* a1 = cA + (size_t)(t + 1) * kstep;
            const char* a2 = last ? nA : cA + (size_t)(t + 2) * kstep; const char* b2 = last ? nB : cB + (size_t)(t + 2) * kstep;
            const char* a3 = a2 + kstep; const char* b3 = b2 + kstep;
            if (last && has_next) S.a_ready(nxt);
            if constexpr (Epi::PRE) { if (last) { const float* ps = E.pre_src(cur, wr);
#pragma unroll
                for (int _i = 0; _i < 2; ++_i) { unsigned _keep;
                    asm volatile("s_mov_b32 %0, m0\n\ts_mov_b32 m0, %3\n\ts_nop 0\n\tglobal_load_lds_dword %1, %2\n\ts_mov_b32 m0, %0" : "=&s"(_keep) : "v"((unsigned)(lane * 4)), "s"((const void*)(ps + _i * HALF)), "s"((unsigned)(lds_u + 8u * HTB + (unsigned)wid * 512u + _i * 256u)) : "memory"); } } }
            PG8_LDB(B0, 0, 0); PG8_SCHED; PG8_LDA(At, 0, 0); PG8_STAGE(PG8_SA(1, 1), a1 + hstep, voffA);
            PG8_WAIT_L(8); PG8_BAR; PG8_WAIT_L(0); PG8_MMA(0, 0, At, B0); PG8_BAR; PG8_SCHED;
            PG8_LDB(B1, 0, 1); PG8_STAGE(PG8_SB(0, 0), b2, voffB);
            PG8_BAR; PG8_WAIT_L(0); PG8_MMA(0, 1, At, B1); PG8_BAR;
            PG8_LDA(At, 0, 1); PG8_STAGE(PG8_SA(0, 0), a2, voffA);
            PG8_BAR; PG8_WAIT_L(0); PG8_MMA(1, 0, At, B0); PG8_BAR; PG8_SCHED;
            PG8_STAGE(PG8_SB(0, 1), b2 + hstep, voffB);
            PG8_WAIT_V(6); PG8_BAR; PG8_MMA(1, 1, At, B1); PG8_BAR;
            PG8_LDB(B0, 1, 0); PG8_SCHED; PG8_LDA(At, 1, 0); PG8_STAGE(PG8_SA(0, 1), a2 + hstep, voffA);
            PG8_WAIT_L(8); PG8_BAR; PG8_WAIT_L(0); PG8_MMA(0, 0, At, B0); PG8_BAR; PG8_SCHED;
            PG8_LDB(B1, 1, 1); PG8_STAGE(PG8_SB(1, 0), b3, voffB);
            PG8_BAR; PG8_WAIT_L(0); PG8_MMA(0, 1, At, B1); PG8_BAR;
            PG8_LDA(At, 1, 1); PG8_STAGE(PG8_SA(1, 0), a3, voffA);
            PG8_BAR; PG8_WAIT_L(0); PG8_MMA(1, 0, At, B0); PG8_BAR; PG8_SCHED;
            PG8_STAGE(PG8_SB(1, 1), b3 + hstep, voffB);
            PG8_WAIT_V(6); PG8_BAR; PG8_MMA(1, 1, At, B1); PG8_BAR;
            if (t == 0 && ui > 0) GP_END(2); if (t == 4 && ui > 0) GP_END(3);
        }
        GP_END(4);
        PG8_STAMP();
        GP_BEGIN(1)
        if constexpr (!Epi::AFTER_DRAIN) { if constexpr (Epi::PRE) {
#pragma unroll
                for (int i = 0; i < 8; ++i) pre[i] = *(const PG8_LAS float*)(lds + 8 * HTB + wid * 512 + (i >> 2) * 256 + ((i & 3) * 16 + fr) * 4); }
            E(acc, cur, wr, wc, fr, fq, pre); S.done(cur); }
        GP_END(1);
#ifdef GPROBE
        { GP_BEGIN(5) if (GPROBE == 5 && Epi::ID == GPROBE_ID) PG8_WAIT_V(0); GP_END(5); }
#endif
        PG8_STAMP();
        if (!has_next) break;
#pragma unroll
        for (int a = 0; a < 2; ++a)
#pragma unroll
            for (int b = 0; b < 2; ++b)
#pragma unroll
                for (int m = 0; m < 4; ++m)
#pragma unroll
                    for (int n = 0; n < 2; ++n) acc[a][b][m][n] = (f32x4){0.f, 0.f, 0.f, 0.f};
        cur = nxt; cA = nA; cB = nB; ++ui;
    }
    PG8_WAIT_V(0);
    if (wr == 0) PG8_BAR;
    PG8_BAR;
    if constexpr (Epi::AFTER_DRAIN) { E.fused(acc, cur, wr, wc, fr, fq, lds, wid, lane); S.done(cur); }
    PG8_STAMP();
    if (STAMP && wid == 0) { stamps[lane] = lane < nts ? (((unsigned long long)(unsigned)ts_hi << 32) | (unsigned)ts_lo) : 0ull;
        if (lane == 62) stamps[62] = rt_entry; if (lane == 63) stamps[63] = (unsigned long long)wall_clock64(); }
#undef PG8_STAMP
#undef PG8_SA
#undef PG8_SB
#undef PG8_STAGE
#undef PG8_LDA
#undef PG8_LDB
#undef PG8_MMA
#undef PG8_WAIT_V
#undef PG8_WAIT_L
#undef PG8_BAR
#undef PG8_SCHED
}
}
namespace fk {
using pg8::bf16_t;
typedef float f32x4 __attribute__((ext_vector_type(4)));
typedef unsigned u32x4 __attribute__((ext_vector_type(4)));
typedef unsigned u32x2 __attribute__((ext_vector_type(2)));
typedef short bf16x8 __attribute__((ext_vector_type(8)));
#ifndef FK_MR
#define FK_MR 32768
#endif
constexpr int D = 1024, S = 8192, MR = FK_MR, NBT = MR / S, NPROJ = 4608, NPAD = 4864, MIXW = 1536, MEMT = 256, INC = 4632;
#ifndef FK_REVQ
#define FK_REVQ 0
#endif
constexpr int NTHR = 512, LDS_BYTES = 163840, LDS_BAR = LDS_BYTES - 16, LDS_TP = LDS_BYTES - 32;

constexpr size_t OFF_CTL = 0, OFF_SSQ = 65536, SSQ_BYTES = (size_t)32768 * 4, ZERO_BYTES = OFF_SSQ + 5 * SSQ_BYTES;
constexpr size_t OFF_LB = ZERO_BYTES, OFF_WIN = OFF_LB + 4096, SZ_WIN = (size_t)NPAD * D * 2, OFF_WOUT = OFF_WIN + 2 * SZ_WIN, SZ_WOUT = (size_t)D * MIXW * 2;
constexpr size_t SZ_SQ = (size_t)D * D * 2, OFF_WQ = OFF_WOUT + 2 * SZ_WOUT, OFF_WO = OFF_WQ + 2 * SZ_SQ, OFF_WK = OFF_WO + 2 * SZ_SQ, OFF_WV = OFF_WK + 2 * SZ_SQ;
constexpr size_t OFF_MEMN = OFF_WV + 2 * SZ_SQ, OFF_KM = OFF_MEMN + 2 * SZ_SQ, OFF_VT = OFF_KM + 2 * SZ_SQ;
constexpr size_t OFF_XB = OFF_VT + 2 * SZ_SQ, SZ_XB = (size_t)MR * D * 2, OFF_PROJ = OFF_XB + SZ_XB, SZ_PROJ = (size_t)MR * NPROJ * 2;
constexpr size_t OFF_EXT = OFF_PROJ + SZ_PROJ, SZ_EXT = (size_t)MR * 32 * 4, OFF_MIX = OFF_EXT + SZ_EXT, SZ_MIX = (size_t)MR * MIXW * 2, WS_END = OFF_MIX + SZ_MIX;
constexpr size_t OFF_Q = OFF_PROJ, OFF_O = OFF_PROJ + SZ_XB;
static_assert(WS_END <= (size_t)536870912, "workspace");
static_assert(2 * SZ_XB <= SZ_PROJ, "q/o overlay");

#define XB_TMO      128
#define XB_XCNT(j)  (256  + 64 * (j))
#define XB_XSUB(j)  (1280 + 64 * (j))
#define XB_XGEN(j)  (2304 + 64 * (j))
#define XB_TOP      3328
#define XB_TOPGEN   3392
#define XCD_BAR_WORDS 3456
#define XB_SPIN_CAP (1u << 18)
#define LAS __attribute__((address_space(3)))

__device__ __forceinline__ unsigned xb_ld(unsigned* p)              { return __hip_atomic_load(p, __ATOMIC_RELAXED, __HIP_MEMORY_SCOPE_AGENT); }
__device__ __forceinline__ unsigned xb_add(unsigned* p, unsigned v) { return __hip_atomic_fetch_add(p, v, __ATOMIC_RELAXED, __HIP_MEMORY_SCOPE_AGENT); }
__device__ __forceinline__ unsigned xb_xcc_id() { return (unsigned)__builtin_amdgcn_s_getreg((3 << 11) | 20) & 0xFu; }
#define XB_SPIN(cond, bar) do { unsigned _sp = 0; while (cond) { __builtin_amdgcn_s_sleep(1); \
    if ((++_sp & 255u) == 0u) { if (xb_ld(&(bar)[XB_TMO])) break; if (_sp > XB_SPIN_CAP) { atomicAdd(&(bar)[XB_TMO], 1u); break; } } } } while (0)

__device__ __forceinline__ int xb_lane() { int l_; asm volatile("v_mbcnt_lo_u32_b32 %0, -1, 0\n\tv_mbcnt_hi_u32_b32 %0, -1, %0" : "=v"(l_)); return l_; }
struct XcdBarrier {
    unsigned* bar; unsigned x;
    volatile LAS unsigned* st;
};

__device__ __forceinline__ XcdBarrier xcd_barrier_post(unsigned* bar, volatile LAS unsigned* st, int wv) {
    XcdBarrier b; b.bar = bar; b.x = xb_xcc_id(); b.st = st;
    if (wv == 0 && xb_lane() == 0) (void)xb_add(&bar[XB_XCNT(b.x)], 1u);
    return b;
}
__device__ __forceinline__ void xcd_barrier_complete(unsigned* bar, unsigned x, unsigned& nloc, unsigned& nx) {
    const unsigned G = gridDim.x * gridDim.y * gridDim.z;
    unsigned sum, cnt, mine, sp = 0u;
    for (;;) {
        sum = 0u; cnt = 0u; mine = 0u;
#pragma unroll
        for (unsigned j = 0; j < 16; ++j) { const unsigned c = xb_ld(&bar[XB_XCNT(j)]); sum += c; cnt += (c > 0u) ? 1u : 0u; mine = (j == x) ? c : mine; }
        if (sum == G) break;
        __builtin_amdgcn_s_sleep(1);
        if ((++sp & 255u) == 0u) { if (xb_ld(&bar[XB_TMO])) break; if (sp > XB_SPIN_CAP) { atomicAdd(&bar[XB_TMO], 1u); break; } }
    }
    nloc = mine > 0u ? mine : 1u; nx = cnt > 0u ? cnt : 1u;
}

__device__ __forceinline__ void xcd_barrier(const XcdBarrier& b, int wv) {
    asm volatile("s_waitcnt vmcnt(0)" ::: "memory");
    __syncthreads();
    if (wv == 0 && xb_lane() == 0) {
        unsigned* bar = b.bar;
        __builtin_amdgcn_s_waitcnt(0);
        unsigned nloc = b.st[0], nx = b.st[1];
        if (nloc == 0u) { xcd_barrier_complete(bar, b.x, nloc, nx); b.st[0] = nloc; b.st[1] = nx; }
        const unsigned old = xb_add(&bar[XB_XSUB(b.x)], 1u);
        const unsigned gen = old / nloc;
        if (old + 1u == (gen + 1u) * nloc) {
            __builtin_amdgcn_fence(__ATOMIC_RELEASE, "agent");
            asm volatile("s_waitcnt vmcnt(0)" ::: "memory");
            const unsigned og = xb_add(&bar[XB_TOP], 1u);
            const unsigned tg = og / nx;
            if (og + 1u == (tg + 1u) * nx) xb_add(&bar[XB_TOPGEN], 1u);
            else XB_SPIN(xb_ld(&bar[XB_TOPGEN]) == tg, bar);
            __builtin_amdgcn_fence(__ATOMIC_ACQUIRE, "agent");
            xb_add(&bar[XB_XGEN(b.x)], 1u);
            asm volatile("s_waitcnt vmcnt(0)" ::: "memory");
        } else {
            XB_SPIN(xb_ld(&bar[XB_XGEN(b.x)]) == gen, bar);
            __builtin_amdgcn_fence(__ATOMIC_ACQUIRE, "agent");
            asm volatile("s_waitcnt vmcnt(0)" ::: "memory");
        }
    }
    __syncthreads();
}

#define GB_CNT(g)  (4096 + 64 * (g))
#define GB_MASK(g) (4608 + 64 * (g))
__device__ __forceinline__ void grp_census_post(const XcdBarrier& b, int g, int wv) { if (wv == 0 && xb_lane() == 0) (void)__hip_atomic_fetch_or(&b.bar[GB_MASK(g)], 1u << b.x, __ATOMIC_RELAXED, __HIP_MEMORY_SCOPE_AGENT); }
__device__ __forceinline__ void grp_census_read(const XcdBarrier& b, int g, int wv) {
    if (wv == 0 && xb_lane() == 0) { const unsigned m = xb_ld(&b.bar[GB_MASK(g)]); b.st[2] = (m != 0u && (m & (m - 1u)) == 0u) ? 1u : 0u; } }
__device__ __forceinline__ void grp_barrier(const XcdBarrier& b, int g, unsigned ng, int wv) {
    asm volatile("s_waitcnt vmcnt(0)" ::: "memory");
    __syncthreads();
    if (wv == 0 && xb_lane() == 0) {
        unsigned* bar = b.bar;
        __builtin_amdgcn_s_waitcnt(0);
        if (b.st[2] == 0u) { __builtin_amdgcn_fence(__ATOMIC_RELEASE, "agent"); asm volatile("s_waitcnt vmcnt(0)" ::: "memory"); }
        const unsigned old = xb_add(&bar[GB_CNT(g)], 1u);
        const unsigned tgt = (old / ng + 1u) * ng;
        XB_SPIN(xb_ld(&bar[GB_CNT(g)]) < tgt, bar);
        __builtin_amdgcn_fence(__ATOMIC_ACQUIRE, "agent");
        asm volatile("s_waitcnt vmcnt(0)" ::: "memory");
    }
    __syncthreads();
}
__device__ __forceinline__ int fk_lane() { int l_; asm volatile("v_mbcnt_lo_u32_b32 %0, -1, 0\n\tv_mbcnt_hi_u32_b32 %0, -1, %0" : "=v"(l_)); return l_; }

struct Args { const float* in[26]; float* out; unsigned char* ws; int ph_lo, ph_hi; };

__device__ __forceinline__ unsigned short bf16r(float f) { unsigned u = __float_as_uint(f); u += 0x7fffu + ((u >> 16) & 1u); return (unsigned short)(u >> 16); }
__device__ __forceinline__ float bf2f(unsigned short b) { return __uint_as_float(((unsigned)b) << 16); }
__device__ __forceinline__ float wsum(float v, int lane) {
#pragma unroll
    for (int o = 32; o >= 1; o >>= 1) v += __builtin_bit_cast(float, __builtin_amdgcn_ds_bpermute((lane ^ o) << 2, __builtin_bit_cast(int, v)));
    return v; }

__device__ __forceinline__ int win_src(int np) { return np < 3072 ? np : np < 4608 ? np + 16 : np < 4624 ? np - 4608 + 3072 : np < 4632 ? np : -1; }
__device__ __forceinline__ void p0_transpose(LAS float* tile, const float* W, int K, int N, bf16_t* WT, int NT, int mode, const float* gain, float scale, int& tbase, int wg, int nwg, int wv) {
    const int tk = K / 128, ntile = tk * (NT / 64);
    float vn[16];
    auto load_tile = [&](int t) { const int tl = wv * 64 + fk_lane(); const int c = tl & 63, k0 = (t % tk) * 128, n0 = (t / tk) * 64, np = n0 + c, src = mode ? win_src(np) : (np < N ? np : -1);
#pragma unroll
        for (int i = 0; i < 16; ++i) { const int r = (tl >> 6) + 8 * i; vn[i] = (src >= 0) ? W[(size_t)(k0 + r) * N + src] * (gain ? gain[k0 + r] : 1.0f) * scale : 0.f; } };
    const int tfirst = ((wg - tbase) % nwg + nwg) % nwg;
    if (tfirst < ntile) load_tile(tfirst);
    for (int t = tfirst; t < ntile; t += nwg) {
        const int tl = wv * 64 + fk_lane();
        const int c = tl & 63, k0 = (t % tk) * 128, n0 = (t / tk) * 64;
        asm volatile("s_waitcnt lgkmcnt(0)" ::: "memory"); __builtin_amdgcn_s_barrier(); asm volatile("" ::: "memory");
#pragma unroll
        for (int i = 0; i < 16; ++i) tile[((tl >> 6) + 8 * i) * 65 + c] = vn[i];
        if (t + nwg < ntile) load_tile(t + nwg);
        asm volatile("s_waitcnt lgkmcnt(0)" ::: "memory"); __builtin_amdgcn_s_barrier(); asm volatile("" ::: "memory");
#pragma unroll
        for (int i = 0; i < 2; ++i) { const int item = tl + i * NTHR, rn = item >> 4, kc = item & 15;
            float v[8];
#pragma unroll
            for (int j = 0; j < 8; ++j) v[j] = tile[(kc * 8 + j) * 65 + rn];
            u32x4 w; w.x = pg8::cvt_pk_bf16(v[0], v[1]); w.y = pg8::cvt_pk_bf16(v[2], v[3]); w.z = pg8::cvt_pk_bf16(v[4], v[5]); w.w = pg8::cvt_pk_bf16(v[6], v[7]);
            *(u32x4*)(WT + (size_t)(n0 + rn) * K + k0 + kc * 8) = w; }
    }
    tbase = (tbase + ntile) % nwg;
}

__device__ __forceinline__ void p0_weights(const Args& a, LAS unsigned char* lds, int l, int sub, int nsub, int wv) {
    unsigned char* ws = a.ws; LAS float* tile = (LAS float*)lds; int tbase = 0;
    p0_transpose(tile, a.in[3] + (size_t)l * D * INC, D, INC, (bf16_t*)(ws + OFF_WIN + l * SZ_WIN), NPAD, 1, a.in[2] + l * D, 1.0f, tbase, sub, nsub, wv);
    p0_transpose(tile, a.in[18] + (size_t)l * MIXW * D, MIXW, D, (bf16_t*)(ws + OFF_WOUT + l * SZ_WOUT), D, 0, nullptr, 1.0f, tbase, sub, nsub, wv);
    p0_transpose(tile, a.in[21] + (size_t)l * D * D, D, D, (bf16_t*)(ws + OFF_WQ + l * SZ_SQ), D, 0, a.in[19] + l * D, 0.0625f * 1.4426950408889634f, tbase, sub, nsub, wv);
    p0_transpose(tile, a.in[22] + (size_t)l * D * D, D, D, (bf16_t*)(ws + OFF_WK + l * SZ_SQ), D, 0, nullptr, 1.0f, tbase, sub, nsub, wv);
    p0_transpose(tile, a.in[23] + (size_t)l * D * D, D, D, (bf16_t*)(ws + OFF_WV + l * SZ_SQ), D, 0, nullptr, 1.0f, tbase, sub, nsub, wv);
    p0_transpose(tile, a.in[24] + (size_t)l * D * D, D, D, (bf16_t*)(ws + OFF_WO + l * SZ_SQ), D, 0, nullptr, 1.0f, tbase, sub, nsub, wv);
    asm volatile("s_waitcnt vmcnt(0) lgkmcnt(0)" ::: "memory"); __builtin_amdgcn_s_barrier(); asm volatile("" ::: "memory");
}

__device__ __forceinline__ void p0_prologue(const Args& a, LAS unsigned char* lds, int wv) {
    int tid_ = wv * 64 + fk_lane(); asm volatile("" : "+v"(tid_)); const int tid = tid_, lane = tid & 63, wave = tid >> 6, wg = blockIdx.x, nwg = gridDim.x;
    unsigned char* ws = a.ws;
    p0_weights(a, lds, 0, wg, nwg, wv);
    { const float* x = a.in[0]; bf16_t* xb = (bf16_t*)(ws + OFF_XB); float* ssq0 = (float*)(ws + OFF_SSQ);
      for (int row = (wg * 8 + wave) * 4; row < MR; row += nwg * 8 * 4) { f32x4 v[4][4];
#pragma unroll
          for (int r = 0; r < 4; ++r)
#pragma unroll
              for (int i = 0; i < 4; ++i) v[r][i] = *(const f32x4*)(x + (size_t)(row + r) * D + i * 256 + lane * 4);
#pragma unroll
          for (int r = 0; r < 4; ++r) { float ss = 0.f;
#pragma unroll
              for (int i = 0; i < 4; ++i) { const f32x4 t = v[r][i]; ss += (t[0] * t[0] + t[1] * t[1]) + (t[2] * t[2] + t[3] * t[3]);
                  u32x2 w; w.x = pg8::cvt_pk_bf16(t[0], t[1]); w.y = pg8::cvt_pk_bf16(t[2], t[3]); *(u32x2*)(xb + (size_t)(row + r) * D + i * 256 + lane * 4) = w; }
              ss = wsum(ss, lane); if (lane == 0) ssq0[row + r] = ss; } } }
    { const float* mem = a.in[1];
      for (int it = wg * 8 + wave; it < 2 * 4 * MEMT; it += nwg * 8) { const int l = it >> 10, row = it & 1023; const float* g = a.in[20] + l * D; bf16_t* o = (bf16_t*)(ws + OFF_MEMN + l * SZ_SQ) + (size_t)row * D;
          f32x4 v[4]; float ss = 0.f;
#pragma unroll
          for (int i = 0; i < 4; ++i) { v[i] = *(const f32x4*)(mem + (size_t)row * D + i * 256 + lane * 4); ss += (v[i][0] * v[i][0] + v[i][1] * v[i][1]) + (v[i][2] * v[i][2] + v[i][3] * v[i][3]); }
          ss = wsum(ss, lane); const float rs = rsqrtf(ss * (1.0f / 1024.0f) + 1e-6f);
#pragma unroll
          for (int i = 0; i < 4; ++i) { const f32x4 gg = *(const f32x4*)(g + i * 256 + lane * 4); const f32x4 y = v[i] * rs * gg;
              u32x2 w; w.x = pg8::cvt_pk_bf16(y[0], y[1]); w.y = pg8::cvt_pk_bf16(y[2], y[3]); *(u32x2*)(o + i * 256 + lane * 4) = w; } } }
    if (wg == 0) { float* lb = (float*)(ws + OFF_LB); const float* lg = a.in[4];
        const float x0 = lg[tid], x1 = lg[512 + tid], mx = fmaxf(x0, x1), e0 = expf(x0 - mx), e1 = expf(x1 - mx); lb[tid] = 0.f; lb[512 + tid] = e1 / (e0 + e1); }
}
typedef float f32x16a __attribute__((ext_vector_type(16)));
__device__ __forceinline__ float bpx(float x, int mask, int lane) { return __builtin_bit_cast(float, __builtin_amdgcn_ds_bpermute((lane ^ mask) << 2, __builtin_bit_cast(int, x))); }
__device__ __forceinline__ void aglds16(const void* gsrc, unsigned lds_dst) { unsigned keep;
    asm volatile("s_mov_b32 %0, m0\n\ts_mov_b32 m0, %2\n\ts_nop 0\n\tglobal_load_lds_dwordx4 %1, off\n\ts_mov_b32 m0, %0" : "=&s"(keep) : "v"(gsrc), "s"(lds_dst) : "memory"); }
__device__ __forceinline__ void attn_dma_k(unsigned slot, const bf16_t* Kbh, int half, int wave, int lane) {
    asm volatile("" : "+v"(lane));
#pragma unroll
    for (int i = 0; i < 8; ++i) { const int p = i * 8 + wave, row = 2 * p + (lane >> 5), lc = (lane & 31) ^ (row & 15);
        aglds16((const void*)(Kbh + (size_t)(half * 128 + row) * 1024 + lc * 8), (unsigned)__builtin_amdgcn_readfirstlane((int)(slot + p * 1024))); } }
__device__ __forceinline__ void attn_dma_v(unsigned slot, const bf16_t* Vbh, int half, int wave, int lane) {
    asm volatile("" : "+v"(lane));
#pragma unroll
    for (int i = 0; i < 8; ++i) { const int p = i * 8 + wave, row = 4 * p + (lane >> 4), lc = (lane & 15) ^ (row & 15);
        aglds16((const void*)(Vbh + (size_t)row * 1024 + half * 128 + lc * 8), (unsigned)__builtin_amdgcn_readfirstlane((int)(slot + p * 1024))); } }
#ifdef ATP
#define AT_BEGIN(k) unsigned long long at_t0_##k = 0; if (ATP == (k)) at_t0_##k = __builtin_amdgcn_s_memrealtime();
#define AT_END(k) do { if (ATP == (k) && wave == 0) { const unsigned long long d_ = __builtin_amdgcn_s_memrealtime() - at_t0_##k; if (lane == 0) *(volatile LAS unsigned long long*)(lds + LDS_TP) += d_; } } while (0)
#else
#define AT_BEGIN(k)
#define AT_END(k) do { } while (0)
#endif
#define ATT_BAR() do { asm volatile("" ::: "memory"); __builtin_amdgcn_s_barrier(); asm volatile("" ::: "memory"); } while (0)
__device__ __forceinline__ void attn_phase(LAS unsigned char* lds, const bf16_t* q, const bf16_t* Km, const bf16_t* Vt, bf16_t* o, const pg8::StaticOrder& So, int wv) {
    int tid_ = wv * 64 + fk_lane(); asm volatile("" : "+v"(tid_));
    const int tid = tid_, lane0 = tid & 63, wave = wv;
    constexpr int RT = S / 256;
    const unsigned slot0 = (unsigned)(size_t)lds, slot1 = slot0 + 65536u;
    LAS unsigned char* ost = lds + 131072 + wave * 2048;
    pg8::Unit cu, nu; int ui = 0;
    bool have = So.next(0, cu);
    if (have) { const int h = cu.pn, b = cu.pm / RT; const bf16_t* Kbh = Km + (size_t)(b * 256) * 1024 + h * 256; attn_dma_k(slot0, Kbh, 0, wave, lane0); attn_dma_k(slot1, Kbh, 1, wave, lane0); }
    bf16x8 qf[16];
    if (have) { const int h = cu.pn; const size_t qrow = (size_t)cu.pm * 256 + wave * 32 + (lane0 & 31);
#pragma unroll
        for (int ks = 0; ks < 16; ++ks) qf[ks] = *(const bf16x8*)(q + qrow * 1024 + h * 256 + ks * 16 + (lane0 >> 5) * 8); }
    for (; have; ++ui) {
        int lane = lane0; asm volatile("" : "+v"(lane)); const int n = lane & 31, hh = lane >> 5;
        const int rt = cu.pm % RT, h = cu.pn, b = cu.pm / RT;
        const bool has_next = So.next(ui + 1, nu);
        const bf16_t* Vbh = Vt + (size_t)(h * 256) * 1024 + b * 256;
        AT_BEGIN(1)
        if (ui != 0) asm volatile("s_waitcnt vmcnt(16) lgkmcnt(0)" ::: "memory"); else asm volatile("s_waitcnt vmcnt(0) lgkmcnt(0)" ::: "memory");
        ATT_BAR();
        AT_END(1);
        AT_BEGIN(2)
        f32x16a sacc[8];
#pragma unroll
        for (int half = 0; half < 2; ++half) {
            LAS unsigned char* ks_ = lds + half * 65536;
#pragma unroll
            for (int kt = 0; kt < 4; ++kt) { f32x16a a;
#pragma unroll
                for (int r = 0; r < 16; ++r) a[r] = 0.f;
                const int key = kt * 32 + n;
#pragma unroll
                for (int k0 = 0; k0 < 16; k0 += 4) { bf16x8 kf[4];
#pragma unroll
                    for (int ks = 0; ks < 4; ++ks) kf[ks] = *(const LAS bf16x8*)(ks_ + key * 512 + (((2 * (k0 + ks) + hh) ^ (key & 15)) * 16));
#pragma unroll
                    for (int ks = 0; ks < 4; ++ks) a = __builtin_amdgcn_mfma_f32_32x32x16_bf16(kf[ks], qf[k0 + ks], a, 0, 0, 0); }
                sacc[half * 4 + kt] = a; }
            asm volatile("s_waitcnt lgkmcnt(0)" ::: "memory"); ATT_BAR();
            attn_dma_v(half ? slot1 : slot0, Vbh, half, wave, lane);
        }
        AT_END(2);
        AT_BEGIN(3)
        float mx = -3.0e38f;
#pragma unroll
        for (int t = 0; t < 8; ++t)
#pragma unroll
            for (int r = 0; r < 16; ++r) mx = fmaxf(mx, sacc[t][r]);
        mx = fmaxf(mx, bpx(mx, 32, lane));
        float sum = 0.f; bf16x8 pf[16];
#pragma unroll
        for (int t = 0; t < 8; ++t) {
#pragma unroll
            for (int r = 0; r < 16; ++r) { const float p = __builtin_amdgcn_exp2f(sacc[t][r] - mx); sacc[t][r] = p; sum += p; }
#pragma unroll
            for (int s = 0; s < 2; ++s) { u32x4 w; w.x = pg8::cvt_pk_bf16(sacc[t][8 * s], sacc[t][8 * s + 1]); w.y = pg8::cvt_pk_bf16(sacc[t][8 * s + 2], sacc[t][8 * s + 3]);
                w.z = pg8::cvt_pk_bf16(sacc[t][8 * s + 4], sacc[t][8 * s + 5]); w.w = pg8::cvt_pk_bf16(sacc[t][8 * s + 6], sacc[t][8 * s + 7]); pf[2 * t + s] = __builtin_bit_cast(bf16x8, w); } }
        sum += bpx(sum, 32, lane);
        const float inv = 1.0f / sum;
        AT_END(3);
        AT_BEGIN(4)
        f32x16a oacc[8];
#pragma unroll
        for (int dt = 0; dt < 8; ++dt)
#pragma unroll
            for (int r = 0; r < 16; ++r) oacc[dt][r] = 0.f;
        if (!has_next) nu = cu;
        const bf16_t* Kn = Km + (size_t)((nu.pm / RT) * 256) * 1024 + nu.pn * 256;
#pragma unroll
        for (int half = 0; half < 2; ++half) {
            if (half == 0 || has_next) asm volatile("s_waitcnt vmcnt(8)" ::: "memory"); else asm volatile("s_waitcnt vmcnt(0)" ::: "memory");
            ATT_BAR();
            LAS unsigned char* vs_ = lds + half * 65536;
#pragma unroll
            for (int dt = 0; dt < 8; ++dt) { const int dv = dt * 32 + n;
#pragma unroll
                for (int s0 = 0; s0 < 8; s0 += 4) { bf16x8 vf[4];
#pragma unroll
                    for (int s8 = 0; s8 < 4; ++s8) vf[s8] = *(const LAS bf16x8*)(vs_ + dv * 256 + (((2 * (s0 + s8) + hh) ^ (dv & 15)) * 16));
#pragma unroll
                    for (int s8 = 0; s8 < 4; ++s8) oacc[dt] = __builtin_amdgcn_mfma_f32_32x32x16_bf16(vf[s8], pf[half * 8 + s0 + s8], oacc[dt], 0, 0, 0); } }
            asm volatile("s_waitcnt lgkmcnt(0)" ::: "memory"); ATT_BAR();
            if (has_next) attn_dma_k(half ? slot1 : slot0, Kn, half, wave, lane);
        }
        { const int hq = nu.pn; const size_t qrow = (size_t)nu.pm * 256 + wave * 32 + n;
#pragma unroll
          for (int ks = 0; ks < 16; ++ks) qf[ks] = *(const bf16x8*)(q + qrow * 1024 + hq * 256 + ks * 16 + hh * 8); }
        AT_END(4);
        AT_BEGIN(5)
        bf16_t* obase = o + ((size_t)b * S + rt * 256 + wave * 32) * 1024 + h * 256;
#pragma unroll
        for (int dt = 0; dt < 8; ++dt) {
#pragma unroll
            for (int rg = 0; rg < 4; ++rg) { const f32x16a& oa = oacc[dt]; u32x2 w; w.x = pg8::cvt_pk_bf16(oa[4 * rg] * inv, oa[4 * rg + 1] * inv); w.y = pg8::cvt_pk_bf16(oa[4 * rg + 2] * inv, oa[4 * rg + 3] * inv);
                *(LAS u32x2*)(ost + n * 64 + (8 * rg + 4 * hh) * 2) = w; }
            asm volatile("s_waitcnt lgkmcnt(0)" ::: "memory");
            { const int row = lane >> 1, hf = lane & 1; const u32x4 t0 = *(const LAS u32x4*)(ost + row * 64 + hf * 32), t1 = *(const LAS u32x4*)(ost + row * 64 + hf * 32 + 16);
              bf16_t* dst = obase + (size_t)row * 1024 + dt * 32 + hf * 16; *(u32x4*)dst = t0; *(u32x4*)(dst + 8) = t1; }
            asm volatile("s_waitcnt lgkmcnt(0)" ::: "memory");
        }
        AT_END(5);
        cu = nu; have = has_next;
    }
    asm volatile("s_waitcnt vmcnt(0) lgkmcnt(0)" ::: "memory"); ATT_BAR();
}
constexpr int SEGC = 8, SEGT = 512, NSEG = S / SEGT, NBH = NBT * 4;
constexpr int P_AQ = 0, P_AF = 512, P_AI = 1024, P_AZ = 1536, P_GQ = 2048, P_GK = 2304, P_GV = 2560, P_GZ = 3072, P_MU = 3584, P_MZ = 4096;
constexpr int USZ = 16384 + 256;
constexpr int L_Q0 = 0, L_KM = 16384, L_QM = 32768, L_RF = 49152, L_ST = 65536, L_V0 = 98304, L_V1 = 114688, L_CV = 132096, L_CST = 148480;
constexpr int C_G = 0, C_SKIP = 512, C_ADEC = 1024, C_NVEC = 1536  , C_DINT = 2560, C_DPART = 2816, C_C1 = 3328, C_W = 3840  , C_HALO = 12544  , C_NINC = 14592  ;
typedef float f32x16 __attribute__((ext_vector_type(16)));
typedef short s16x4 __attribute__((ext_vector_type(4)));

__device__ __forceinline__ unsigned off_b(unsigned row, unsigned ch) { return 256u * row + 16u * (ch ^ (((row & 3u) << 2) | ((row >> 2) & 3u))); }
__device__ __forceinline__ unsigned rr_addr(unsigned lane, unsigned rowbase, unsigned s) { return off_b(rowbase + (lane & 31u), 2u * s + (lane >> 5)); }
__device__ __forceinline__ unsigned tr_addr(unsigned lane, unsigned c, unsigned ks, unsigned t) { const unsigned h = lane >> 5, blk = (lane >> 4) & 1u, q = (lane & 15u) >> 2, p = lane & 3u; return off_b(16u * ks + 8u * h + 4u * t + q, 4u * c + 2u * blk + (p >> 1)) + 8u * (p & 1u); }
__device__ __forceinline__ bf16x8 ld_frag(LAS unsigned char* p) { return *(const LAS bf16x8*)p; }
__device__ __forceinline__ bf16x8 tr_frag(LAS unsigned char* img, unsigned lane, unsigned c, unsigned ks) {
    const s16x4 lo = __builtin_bit_cast(s16x4, __builtin_amdgcn_ds_read_tr16_b64_v4i16((LAS s16x4*)(img + tr_addr(lane, c, ks, 0))));
    const s16x4 hi = __builtin_bit_cast(s16x4, __builtin_amdgcn_ds_read_tr16_b64_v4i16((LAS s16x4*)(img + tr_addr(lane, c, ks, 1))));
    return (bf16x8){lo[0], lo[1], lo[2], lo[3], hi[0], hi[1], hi[2], hi[3]}; }
__device__ __forceinline__ bf16x8 tr_fragb(LAS unsigned char* img, const unsigned (&tb)[2], unsigned ks) {
    const s16x4 lo = __builtin_bit_cast(s16x4, __builtin_amdgcn_ds_read_tr16_b64_v4i16((LAS s16x4*)(img + tb[0] + 4096u * ks)));
    const s16x4 hi = __builtin_bit_cast(s16x4, __builtin_amdgcn_ds_read_tr16_b64_v4i16((LAS s16x4*)(img + tb[1] + 4096u * ks)));
    return (bf16x8){lo[0], lo[1], lo[2], lo[3], hi[0], hi[1], hi[2], hi[3]}; }
__device__ __forceinline__ void glds16(const void* gsrc, unsigned lds_dst) { unsigned keep;
    asm volatile("s_mov_b32 %0, m0\n\ts_mov_b32 m0, %2\n\ts_nop 0\n\tglobal_load_lds_dwordx4 %1, off\n\ts_mov_b32 m0, %0" : "=&s"(keep) : "v"(gsrc), "s"(lds_dst) : "memory"); }
__device__ __forceinline__ void dma_tile(LAS unsigned char* img, const bf16_t* src, size_t pitch, int npieces, int wave, int lane) {
    const unsigned base = (unsigned)(size_t)img; asm volatile("" : "+v"(lane));
    for (int p = wave; p < npieces; p += 8) { const int row = p * 4 + (lane >> 4), lc = (lane & 15) ^ (((row & 3) << 2) | ((row >> 2) & 3));
        glds16((const void*)(src + (ptrdiff_t)row * (ptrdiff_t)pitch + lc * 8), (unsigned)__builtin_amdgcn_readfirstlane((int)(base + p * 1024))); } }
template <int CTRL, int RM> __device__ __forceinline__ float dpp1(float x) { return __builtin_bit_cast(float, __builtin_amdgcn_update_dpp(0x3f800000, __builtin_bit_cast(int, x), CTRL, RM, 0xF, false)); }
template <int CTRL, int RM> __device__ __forceinline__ float dpp0(float x) { return __builtin_bit_cast(float, __builtin_amdgcn_update_dpp(0, __builtin_bit_cast(int, x), CTRL, RM, 0xF, true)); }
__device__ __forceinline__ float wave_scan(float v, int lane) {
    (void)lane;
    v += dpp0<0x111, 0xF>(v); v += dpp0<0x112, 0xF>(v); v += dpp0<0x114, 0xF>(v); v += dpp0<0x118, 0xF>(v);
    v += dpp0<0x142, 0xA>(v); v += dpp0<0x143, 0xC>(v);
    return v; }
__device__ __forceinline__ float shx(float x, int mask, int lane) { return __builtin_bit_cast(float, __builtin_amdgcn_ds_bpermute((lane ^ mask) << 2, __builtin_bit_cast(int, x))); }
__device__ __forceinline__ float sum8(float v) { v += dpp0<0xB1, 0xF>(v); v += dpp0<0x4E, 0xF>(v); v += dpp0<0x141, 0xF>(v); return v; }
__device__ __forceinline__ float rdlane(float x, int l) { return __builtin_bit_cast(float, __builtin_amdgcn_readlane(__builtin_bit_cast(int, x), l)); }
__device__ __forceinline__ float ex2(float x) { return __builtin_amdgcn_exp2f(x); }
__device__ __forceinline__ float h2f(unsigned short h) { return (float)__builtin_bit_cast(_Float16, h); }
__device__ __forceinline__ u32x4 pack8(const float (&v)[8]) { u32x4 w; w.x = pg8::cvt_pk_bf16(v[0], v[1]); w.y = pg8::cvt_pk_bf16(v[2], v[3]); w.z = pg8::cvt_pk_bf16(v[4], v[5]); w.w = pg8::cvt_pk_bf16(v[6], v[7]); return w; }
__device__ __forceinline__ float log2sig(float x) { return (fminf(x, 0.f) - __logf(1.0f + __expf(-fabsf(x)))) * 1.4426950408889634f; }

struct MixArgs {
    const bf16_t* proj; const float* ext; bf16_t* mix; float* U;
    const float *hgrn_norm, *gla_up, *gla_bias, *gla_norm, *conv_w, *conv_b, *wq, *wk, *wv, *ig_bias, *fg_bias, *skip, *mnorm;
};

struct Fac { float E0, Km, a63; };
__device__ __forceinline__ Fac factors(float b, float kboost, int lane) {
    (void)lane; Fac f; f.E0 = ex2(fmaxf(b, -120.f)); f.Km = __builtin_amdgcn_rcpf(f.E0) * ex2(kboost); f.a63 = rdlane(f.E0, 63); return f; }
__device__ __forceinline__ f32x16 mfma32(bf16x8 a, bf16x8 b, f32x16 c) { return __builtin_amdgcn_mfma_f32_32x32x16_bf16(a, b, c, 0, 0, 0); }

#ifdef TPROBE
#ifndef TP_PASS
#define TP_PASS 1
#endif
#define TP_BEGIN(k) unsigned long long tp_t0_##k = 0; if (TPROBE == (k) && PASS == TP_PASS) tp_t0_##k = __builtin_amdgcn_s_memrealtime();
#define TP_END(k) do { if (TPROBE == (k) && PASS == TP_PASS && wave == 0) { const unsigned long long d_ = __builtin_amdgcn_s_memrealtime() - tp_t0_##k; if (lane == 0) *(volatile LAS unsigned long long*)(lds + LDS_TP) += d_; } } while (0)
#else
#define TP_BEGIN(k)
#define TP_END(k) do { } while (0)
#endif
#define FK_BAR() do { asm volatile("" ::: "memory"); __builtin_amdgcn_s_barrier(); asm volatile("" ::: "memory"); } while (0)
template <int MIXER, int PASS>
__device__ __forceinline__ void mix_unit(LAS unsigned char* lds, const MixArgs& A, int bh, int seg, int wv) {
    constexpr int DK = (MIXER == 1) ? 64 : 128, NKS = DK / 16, NG = DK / 64;
    constexpr int NT = (DK == 128) ? 2 : 1;
    constexpr int LEAD = (PASS == 0 && MIXER != 2) ? 2 : 1;
    int tid_ = wv * 64 + fk_lane(); asm volatile("" : "+v"(tid_));
    const int tid = tid_, lane = tid & 63, wave = wv;
    TP_BEGIN(6)
    const int b = bh >> 2, h = bh & 3;
    const size_t row0 = (size_t)b * S + (size_t)seg * SEGT;
    LAS float* cst = (LAS float*)(lds + L_CST);
    LAS float* c_g = cst + C_G / 4; LAS float* c_skip = cst + C_SKIP / 4; LAS float* c_adec = cst + C_ADEC / 4; LAS float* c_c1 = cst + C_C1 / 4; LAS float* c_nbuf = cst + C_NVEC / 4; LAS float* c_w = cst + C_W / 4; LAS float* c_dint = cst + C_DINT / 4; LAS float* c_dpart = cst + C_DPART / 4; LAS float* c_ninc = cst + C_NINC / 4;
    float* slot = A.U + (size_t)((MIXER * NBH + bh) * NSEG + seg) * USZ;
    const int td = (DK == 128) ? (wave >> 1) : (wave >> 2), te0 = (DK == 128) ? (wave & 1) * 2 : (wave & 3);
    const int ti = wave >> 2, te = wave & 3;
    const int cq = MIXER == 0 ? P_AQ + h * 128 : MIXER == 1 ? P_GQ + h * 64 : P_MU + h * 128;
    const int ck = MIXER == 0 ? P_AF + h * 128 : P_GK + h * 64;
    const int cv = MIXER == 0 ? P_AI + h * 128 : P_GV + h * 128;
    const int cz = MIXER == 0 ? P_AZ + h * 128 : MIXER == 1 ? P_GZ + h * 128 : P_MZ + h * 128;
    const bf16_t* pr = A.proj + row0 * NPROJ;
    auto fbuf = [&](int cn) -> LAS unsigned char* { if (PASS == 1) return lds + L_RF; const int r = cn % 3; return lds + (r == 0 ? L_RF : r == 1 ? L_Q0 : L_QM); };
    auto vbuf = [&](int cn) -> LAS unsigned char* { if (MIXER == 2) return lds + L_V0; if (PASS == 1) return lds + ((cn & 1) ? L_V1 : L_V0); const int r = cn % 3; return lds + (r == 0 ? L_V0 : r == 1 ? L_V1 : L_ST); };
    auto ubuf = [&](int cn) -> LAS unsigned char* { return lds + ((cn & 1) ? L_RF : L_V1); };
    auto hbuf = [&](int cn) -> LAS unsigned char* { return lds + L_CST + C_HALO + (cn & 1) * 1024; };
    auto cix = [&](int cn) -> int { return PASS == 0 ? SEGC - 1 - cn : cn; };
    auto issue_dma = [&](int cn) {
        const bf16_t* prn = pr + (size_t)cix(cn) * 64 * NPROJ;
        if (MIXER == 2) { dma_tile(ubuf(cn), prn + cq, NPROJ, 16, wave, lane); dma_tile(hbuf(cn), prn + cq - 4 * (ptrdiff_t)NPROJ, NPROJ, 1, wave, lane); }
        else { if (PASS == 1) dma_tile(lds + L_CV, prn + cq, NPROJ, 16, wave, lane); dma_tile(fbuf(cn), prn + ck, NPROJ, 16, wave, lane); dma_tile(vbuf(cn), prn + cv, NPROJ, 16, wave, lane); } };
    issue_dma(0);
    if (LEAD == 2) issue_dma(1);
    if (tid < 128) { c_g[tid] = MIXER == 0 ? A.hgrn_norm[tid] : MIXER == 1 ? A.gla_norm[tid] : A.mnorm[h * 128 + tid]; c_skip[tid] = MIXER == 2 ? A.skip[h * 128 + tid] : 0.f; c_nbuf[tid] = (MIXER == 2 && PASS == 1) ? slot[16384 + 128 + tid] : 0.f; }
    if (MIXER == 2) { const int i = tid; c_w[i] = A.wq[h * 512 + i]; c_w[512 + i] = A.wk[h * 512 + i]; c_w[1024 + i] = A.wv[h * 512 + i]; c_w[1536 + i] = A.conv_w[(i >> 7) * 512 + h * 128 + (i & 127)]; if (tid < 128) c_w[2048 + tid] = A.conv_b[h * 128 + tid]; }
    if (MIXER == 1) { for (int i = tid; i < 1024; i += NTHR) c_w[i] = A.gla_up[(i >> 6) * 256 + h * 64 + (i & 63)]; if (tid < 64) c_w[1024 + tid] = A.gla_bias[h * 64 + tid]; }
    f32x16 st[NT];
#pragma unroll
    for (int s = 0; s < NT; ++s)
#pragma unroll
        for (int r = 0; r < 16; ++r) st[s][r] = (PASS == 1) ? slot[((wave * NT + s) * 16 + r) * 64 + lane] : 0.f;
    float carry[NG * 8];
#pragma unroll
    for (int i = 0; i < NG * 8; ++i) carry[i] = 0.f;
    float carry_s = 0.f;
    f32x16 nacc;
#pragma unroll
    for (int r = 0; r < 16; ++r) nacc[r] = 0.f;
    u32x4 zraw[2]; f32x4 gv[4], gvn[4]; float emi = 0.f, emf = 0.f;
    zraw[0] = zraw[1] = (u32x4){0u, 0u, 0u, 0u};
#pragma unroll
    for (int i = 0; i < 4; ++i) { gv[i] = (f32x4){0.f, 0.f, 0.f, 0.f}; gvn[i] = gv[i]; }
    auto prefetch = [&](int cn, bool first) {
        const float* er = A.ext + (row0 + (size_t)cix(cn) * 64 + lane) * 32;
        if (MIXER == 1) {
#pragma unroll
            for (int i = 0; i < 4; ++i) { const f32x4 t4 = *(const f32x4*)(er + 4 * i); if (first) gv[i] = t4; else gvn[i] = t4; } }
        if (MIXER == 2) { emi = er[16 + h]; emf = er[20 + h]; } };
    prefetch(0, true);
    if (PASS == 1) {
#pragma unroll
        for (int s = 0; s < NT; ++s) { const int e = 32 * (te0 + s) + (lane & 31);
#pragma unroll
            for (int rg = 0; rg < 4; ++rg) { const int d0 = 32 * td + 8 * rg + 4 * (lane >> 5);
                u32x2 w; w.x = pg8::cvt_pk_bf16(st[s][4 * rg], st[s][4 * rg + 1]); w.y = pg8::cvt_pk_bf16(st[s][4 * rg + 2], st[s][4 * rg + 3]);
                *(LAS u32x2*)(lds + L_ST + off_b(e, d0 >> 3) + (d0 & 7) * 2) = w; } } }

    TP_END(6);
#pragma unroll 1
    for (int c = 0; c < SEGC; ++c) {
        TP_BEGIN(1)
        const int t0 = seg * SEGT + cix(c) * 64;
        LAS unsigned char* Vimg = vbuf(c);
        if (PASS == 1) { if (c > 0) asm volatile("s_waitcnt vmcnt(2) lgkmcnt(0)" ::: "memory"); else asm volatile("s_waitcnt vmcnt(0) lgkmcnt(0)" ::: "memory"); }
        else if (LEAD == 2) { if (c + 1 < SEGC) asm volatile("s_waitcnt vmcnt(4) lgkmcnt(0)" ::: "memory"); else asm volatile("s_waitcnt vmcnt(0) lgkmcnt(0)" ::: "memory"); }
        else asm volatile("s_waitcnt vmcnt(0) lgkmcnt(0)" ::: "memory");
        FK_BAR();
        TP_END(1);
        TP_BEGIN(2)
        if (PASS == 1) { int lz = lane; asm volatile("" : "+v"(lz)); const int tz = wave * 64 + lz; const bf16_t* zp = pr + (size_t)(c * 64 + (tz >> 3)) * NPROJ + cz + (tz & 7) * 16; zraw[0] = *(const u32x4*)zp; zraw[1] = *(const u32x4*)(zp + 8); }
        if (c > 0) {
            if (MIXER == 1) {
#pragma unroll
                for (int i = 0; i < 4; ++i) { gv[i] = gvn[i]; asm volatile("" : "+v"(gv[i])); } } }
        if (MIXER == 2 && c + 1 < SEGC) issue_dma(c + 1);
        Fac fsc; fsc.E0 = fsc.Km = fsc.a63 = 0.f;
        if (MIXER == 2) {
            const float mi = emi + A.ig_bias[h], mf = emf + A.fg_bias[h];
            const float bs = wave_scan(log2sig(mf), lane);
            if (PASS == 0) { const float r63 = rdlane(bs, 63); fsc.E0 = 0.f; fsc.Km = ex2(r63 - bs + carry_s + mi * 1.4426950408889634f); fsc.a63 = 0.f; carry_s += r63; }
            else fsc = factors(bs, mi * 1.4426950408889634f, lane); }
        bf16x8 rawq[NG], rawk[NG];
        if (MIXER != 2) {
#pragma unroll
            for (int g = 0; g < NG; ++g) { rawk[g] = ld_frag(fbuf(c) + off_b(lane, wave + 8 * g)); rawq[g] = rawk[g]; if (PASS == 1) rawq[g] = ld_frag(lds + L_CV + off_b(lane, wave + 8 * g)); }
            asm volatile("s_waitcnt lgkmcnt(0)" ::: "memory"); FK_BAR();
            if (MIXER == 1 && c + 1 < SEGC) prefetch(c + 1, false);
            if (c + LEAD < SEGC) issue_dma(c + LEAD);
        }
#ifndef REP_S0
#define REP_S0 1
#endif
#ifndef REP_S0M
#define REP_S0M 0
#endif
        _Pragma("unroll 1") for (int rep0 = 0; rep0 < ((PASS == 1 && MIXER == REP_S0M) ? REP_S0 : 1); ++rep0)
#pragma unroll
        for (int g = 0; g < NG; ++g) { const int cc = wave + 8 * g; float q8[8], k8[8], gl8[8], v8[8], ca8[8];
            if (MIXER == 0) {
#pragma unroll
                for (int j = 0; j < 8; ++j) { gl8[j] = h2f((unsigned short)rawk[g][j]); q8[j] = bf2f((unsigned short)rawq[g][j]); v8[j] = 0.f; ca8[j] = 0.f; }
#pragma unroll
                for (int j = 0; j < 8; ++j) k8[j] = 1.0f - ex2(gl8[j]);
            } else if (MIXER == 1) {
                f32x4 sg0 = *(const LAS f32x4*)(c_w + 1024 + cc * 8), sg1 = *(const LAS f32x4*)(c_w + 1024 + cc * 8 + 4);
#pragma unroll
                for (int i = 0; i < 16; ++i) { const f32x4 w0 = *(const LAS f32x4*)(c_w + i * 64 + cc * 8), w1 = *(const LAS f32x4*)(c_w + i * 64 + cc * 8 + 4); const float gi = gv[i >> 2][i & 3];
                    sg0 += gi * w0; sg1 += gi * w1; }
#pragma unroll
                for (int j = 0; j < 8; ++j) { const float sj = j < 4 ? sg0[j & 3] : sg1[j & 3]; gl8[j] = log2sig(sj) * 0.0625f; q8[j] = bf2f((unsigned short)rawq[g][j]); k8[j] = bf2f((unsigned short)rawk[g][j]); v8[j] = 0.f; ca8[j] = 0.f; }
            } else {
                f32x4 u4[4][2];
#pragma unroll
                for (int k = 0; k < 4; ++k) { const int rr = lane - k; const bf16x8 ru = ld_frag(rr >= 0 ? ubuf(c) + off_b(rr, cc) : hbuf(c) + off_b(4 + rr, cc));
#pragma unroll
                    for (int j = 0; j < 8; ++j) u4[k][j >> 2][j & 3] = bf2f((unsigned short)ru[j]);
                    if (t0 == 0 && rr < 0) { u4[k][0] = (f32x4){0.f, 0.f, 0.f, 0.f}; u4[k][1] = u4[k][0]; } }
                f32x4 ac0 = *(const LAS f32x4*)(c_w + 2048 + cc * 8), ac1 = *(const LAS f32x4*)(c_w + 2048 + cc * 8 + 4);
#pragma unroll
                for (int tap = 0; tap < 4; ++tap) { const f32x4 w0 = *(const LAS f32x4*)(c_w + 1536 + tap * 128 + cc * 8), w1 = *(const LAS f32x4*)(c_w + 1536 + tap * 128 + cc * 8 + 4);
                    ac0 += u4[3 - tap][0] * w0; ac1 += u4[3 - tap][1] * w1; }
#pragma unroll
                for (int j = 0; j < 8; ++j) { const float aj = j < 4 ? ac0[j & 3] : ac1[j & 3]; ca8[j] = aj * pg8::fsigm(aj); }
                f32x4 qv4[2], kv4[2], vv4[2];
#pragma unroll
                for (int hg = 0; hg < 2; ++hg) { qv4[hg] = (f32x4){0.f, 0.f, 0.f, 0.f}; kv4[hg] = qv4[hg]; vv4[hg] = qv4[hg]; }
#pragma unroll
                for (int i = 0; i < 4; ++i)
#pragma unroll
                    for (int hg = 0; hg < 2; ++hg) { const f32x4 wq4 = *(const LAS f32x4*)(c_w + (cc * 2 + hg) * 16 + i * 4), wk4 = *(const LAS f32x4*)(c_w + 512 + (cc * 2 + hg) * 16 + i * 4), wv4 = *(const LAS f32x4*)(c_w + 1024 + (cc * 2 + hg) * 16 + i * 4);
                        qv4[hg] += ca8[hg * 4 + i] * wq4; kv4[hg] += ca8[hg * 4 + i] * wk4; vv4[hg] += u4[0][hg][i] * wv4; }
#pragma unroll
                for (int j = 0; j < 8; ++j) { q8[j] = qv4[j >> 2][j & 3]; k8[j] = kv4[j >> 2][j & 3] * 0.08838834764831845f; v8[j] = vv4[j >> 2][j & 3]; gl8[j] = 0.f; }
            }
            float E0[8], Km[8], a63[8];
            if (MIXER != 2) {
                float bb[8];
#pragma unroll
                for (int j = 0; j < 8; ++j) bb[j] = gl8[j];
#pragma unroll
                for (int j = 0; j < 8; ++j) bb[j] += dpp0<0x111, 0xF>(bb[j]);
#pragma unroll
                for (int j = 0; j < 8; ++j) bb[j] += dpp0<0x112, 0xF>(bb[j]);
#pragma unroll
                for (int j = 0; j < 8; ++j) bb[j] += dpp0<0x114, 0xF>(bb[j]);
#pragma unroll
                for (int j = 0; j < 8; ++j) bb[j] += dpp0<0x118, 0xF>(bb[j]);
#pragma unroll
                for (int j = 0; j < 8; ++j) bb[j] += dpp0<0x142, 0xA>(bb[j]);
#pragma unroll
                for (int j = 0; j < 8; ++j) bb[j] += dpp0<0x143, 0xC>(bb[j]);
                if (PASS == 0) {
#pragma unroll
                    for (int j = 0; j < 8; ++j) { const float r63 = rdlane(bb[j], 63); Km[j] = ex2(r63 - bb[j] + carry[g * 8 + j]); carry[g * 8 + j] += r63; E0[j] = 0.f; a63[j] = 0.f; }
                } else {
#pragma unroll
                    for (int j = 0; j < 8; ++j) { E0[j] = ex2(fmaxf(bb[j], -120.f)); Km[j] = __builtin_amdgcn_rcpf(E0[j]); }
#pragma unroll
                    for (int j = 0; j < 8; ++j) a63[j] = rdlane(E0[j], 63);
                }
            }
            float o0[8], o2[8];
#pragma unroll
            for (int j = 0; j < 8; ++j) { if (MIXER == 2) { o0[j] = q8[j] * fsc.E0; o2[j] = k8[j] * fsc.Km; }
                else { o0[j] = q8[j] * E0[j]; o2[j] = k8[j] * Km[j]; } }
            if (PASS == 1 && lane == 63) {
                if (MIXER == 2) { const f32x4 a4 = (f32x4){fsc.a63, fsc.a63, fsc.a63, fsc.a63}; *(LAS f32x4*)(c_adec + cc * 8) = a4; *(LAS f32x4*)(c_adec + cc * 8 + 4) = a4; }
                else { *(LAS f32x4*)(c_adec + cc * 8) = (f32x4){a63[0], a63[1], a63[2], a63[3]}; *(LAS f32x4*)(c_adec + cc * 8 + 4) = (f32x4){a63[4], a63[5], a63[6], a63[7]}; } }
            *(LAS u32x4*)(lds + L_KM + off_b(lane, cc)) = pack8(o2);
            if (PASS == 1) *(LAS u32x4*)(lds + L_Q0 + off_b(lane, cc)) = pack8(o0);
            if (MIXER == 2) { *(LAS u32x4*)(lds + L_V0 + off_b(lane, cc)) = pack8(v8); if (PASS == 1) *(LAS u32x4*)(lds + L_CV + off_b(lane, cc)) = pack8(ca8); }
            asm volatile("" ::: "memory");
        }
        asm volatile("s_waitcnt lgkmcnt(0)" ::: "memory"); FK_BAR();
        TP_END(2);
        TP_BEGIN(3)
        if (c + 1 < SEGC && MIXER == 2) prefetch(c + 1, false);
        unsigned rrb[8], trE[2], trD[2], trS[NT][2];
        { int lb = lane; asm volatile("" : "+v"(lb));
#pragma unroll
          for (int s = 0; s < 8; ++s) rrb[s] = rr_addr((unsigned)lb, 0u, (unsigned)s);
#pragma unroll
          for (int t = 0; t < 2; ++t) { trE[t] = tr_addr((unsigned)lb, (unsigned)te, 0u, (unsigned)t); trD[t] = tr_addr((unsigned)lb, (unsigned)td, 0u, (unsigned)t);
#pragma unroll
              for (int s = 0; s < NT; ++s) trS[s][t] = tr_addr((unsigned)lb, (unsigned)(te0 + s), 0u, (unsigned)t); } }
        f32x16 oacc, pacc;
#pragma unroll
        for (int r = 0; r < 16; ++r) { oacc[r] = 0.f; pacc[r] = 0.f; }
        if (PASS == 1) {
            int ln1 = lane; asm volatile("" : "+v"(ln1));
#pragma unroll
            for (int s0 = 0; s0 < NKS; s0 += 4) { bf16x8 fa[4], fb[4];
#pragma unroll
              for (int s = 0; s < 4; ++s) { fa[s] = ld_frag(lds + L_Q0 + 8192 * ti + rrb[s0 + s]); fb[s] = ld_frag(lds + L_ST + 8192 * te + rrb[s0 + s]); }
#pragma unroll
              for (int s = 0; s < 4; ++s) oacc = mfma32(fa[s], fb[s], oacc); }
            if (MIXER == 2) {
                const int tid1 = wave * 64 + ln1, row = tid1 >> 3, sg = tid1 & 7; float dsum = 0.f;
#pragma unroll
                for (int hh = 0; hh < 2; ++hh) { const bf16x8 qf = ld_frag(lds + L_Q0 + off_b(row, 2 * sg + hh));
#pragma unroll
                    for (int j = 0; j < 8; ++j) dsum += bf2f((unsigned short)qf[j]) * c_nbuf[(c & 1) * 128 + sg * 16 + hh * 8 + j]; }
                dsum = sum8(dsum);
                if (sg == 0) c_dint[row] = dsum; }
            const int jb = (wave == 1) ? 1 : 0, ib = (wave == 0) ? 0 : 1;
            if (wave < 3) {
#pragma unroll
                for (int s0 = 0; s0 < NKS; s0 += 4) { bf16x8 fa[4], fb[4];
#pragma unroll
                  for (int s = 0; s < 4; ++s) { fa[s] = ld_frag(lds + L_KM + 8192 * jb + rrb[s0 + s]); fb[s] = ld_frag(lds + L_Q0 + 8192 * ib + rrb[s0 + s]); }
#pragma unroll
                  for (int s = 0; s < 4; ++s) pacc = mfma32(fa[s], fb[s], pacc); }
                if (wave < 2) {
#pragma unroll
                    for (int r = 0; r < 16; ++r) { const int jj = (r & 3) + 8 * (r >> 2) + 4 * (ln1 >> 5); if (jj > (ln1 & 31)) pacc[r] = 0.f; } }
                if (MIXER == 2) { float ps = 0.f;
#pragma unroll
                    for (int r = 0; r < 16; ++r) ps += pacc[r];
                    ps += shx(ps, 32, ln1); if (ln1 < 32) c_dpart[wave * 32 + ln1] = ps; } }
            if (wave < 3) {
                int lnp = lane; asm volatile("" : "+v"(lnp));
#pragma unroll
                for (int rg = 0; rg < 4; ++rg) { u32x2 w; w.x = pg8::cvt_pk_bf16(pacc[4 * rg], pacc[4 * rg + 1]); w.y = pg8::cvt_pk_bf16(pacc[4 * rg + 2], pacc[4 * rg + 3]);
                    *(LAS u32x2*)(lds + L_QM + off_b(32 * ib + (lnp & 31), 4 * jb + rg) + 8 * (lnp >> 5)) = w; } }
            asm volatile("s_waitcnt lgkmcnt(0)" ::: "memory"); FK_BAR();
            TP_END(3);
            int ln2 = lane; asm volatile("" : "+v"(ln2));
            { bf16x8 fa[2], fb[2];
#pragma unroll
              for (int s = 0; s < 2; ++s) { fa[s] = ld_frag(lds + L_QM + 8192 * ti + rrb[s]); fb[s] = tr_fragb(Vimg, trE, s); }
#pragma unroll
              for (int s = 0; s < 2; ++s) oacc = mfma32(fa[s], fb[s], oacc);
              if (ti == 1) {
#pragma unroll
                  for (int s = 0; s < 2; ++s) { fa[s] = ld_frag(lds + L_QM + 8192 + rrb[2 + s]); fb[s] = tr_fragb(Vimg, trE, 2 + s); }
#pragma unroll
                  for (int s = 0; s < 2; ++s) oacc = mfma32(fa[s], fb[s], oacc); } }
        }
        TP_BEGIN(4)
        if (PASS == 0) {
            int ln4 = lane; asm volatile("" : "+v"(ln4));
            const short one_or_zero = ((ln4 & 31) == 0) ? (short)0x3f80 : (short)0;
            const bf16x8 onesB = (bf16x8){one_or_zero, one_or_zero, one_or_zero, one_or_zero, one_or_zero, one_or_zero, one_or_zero, one_or_zero};
#pragma unroll
            for (int h4 = 0; h4 < 4; h4 += 2) { bf16x8 fa[2], fb[NT][2];
#pragma unroll
              for (int s4 = 0; s4 < 2; ++s4) { fa[s4] = tr_fragb(lds + L_KM, trD, h4 + s4);
#pragma unroll
                  for (int s = 0; s < NT; ++s) fb[s][s4] = tr_fragb(Vimg, trS[s], h4 + s4); }
#pragma unroll
              for (int s4 = 0; s4 < 2; ++s4) {
#pragma unroll
                  for (int s = 0; s < NT; ++s) st[s] = mfma32(fa[s4], fb[s][s4], st[s]);
                  if (MIXER == 2 && te0 == 0) nacc = mfma32(fa[s4], onesB, nacc); } }
        } else if (c + 1 < SEGC) {
            int ln4 = lane; asm volatile("" : "+v"(ln4));
            f32x16 tmp[NT];
#pragma unroll
            for (int s = 0; s < NT; ++s)
#pragma unroll
                for (int r = 0; r < 16; ++r) tmp[s][r] = 0.f;
#pragma unroll
            for (int h4 = 0; h4 < 4; h4 += 2) { bf16x8 fa[2], fb[NT][2];
#pragma unroll
              for (int s4 = 0; s4 < 2; ++s4) { fa[s4] = tr_fragb(lds + L_KM, trD, h4 + s4);
#pragma unroll
                  for (int s = 0; s < NT; ++s) fb[s][s4] = tr_fragb(Vimg, trS[s], h4 + s4); }
#pragma unroll
              for (int s4 = 0; s4 < 2; ++s4)
#pragma unroll
                  for (int s = 0; s < NT; ++s) tmp[s] = mfma32(fa[s4], fb[s][s4], tmp[s]); }
#pragma unroll
            for (int rg = 0; rg < 4; ++rg) { const f32x4 av = *(const LAS f32x4*)(c_adec + 32 * td + 8 * rg + 4 * (ln4 >> 5));
#pragma unroll
                for (int s = 0; s < NT; ++s)
#pragma unroll
                    for (int q4 = 0; q4 < 4; ++q4) st[s][4 * rg + q4] = (st[s][4 * rg + q4] + tmp[s][4 * rg + q4]) * av[q4]; }
            if (MIXER == 2 && te0 == 0) {
                f32x16 nt;
#pragma unroll
                for (int r = 0; r < 16; ++r) nt[r] = 0.f;
                const short one_or_zero = ((ln4 & 31) == 0) ? (short)0x3f80 : (short)0;
                const bf16x8 onesB = (bf16x8){one_or_zero, one_or_zero, one_or_zero, one_or_zero, one_or_zero, one_or_zero, one_or_zero, one_or_zero};
#pragma unroll
                for (int s4 = 0; s4 < 4; ++s4) nt = mfma32(tr_fragb(lds + L_KM, trD, s4), onesB, nt);
                if ((ln4 & 31) == 0) {
#pragma unroll
                    for (int rg = 0; rg < 4; ++rg) *(LAS f32x4*)(c_ninc + 32 * td + 8 * rg + 4 * (ln4 >> 5)) = (f32x4){nt[4 * rg], nt[4 * rg + 1], nt[4 * rg + 2], nt[4 * rg + 3]}; } }
#pragma unroll
            for (int s = 0; s < NT; ++s) { const int e = 32 * (te0 + s) + (ln4 & 31);
#pragma unroll
                for (int rg = 0; rg < 4; ++rg) { const int d0 = 32 * td + 8 * rg + 4 * (ln4 >> 5);
                    u32x2 w; w.x = pg8::cvt_pk_bf16(st[s][4 * rg], st[s][4 * rg + 1]); w.y = pg8::cvt_pk_bf16(st[s][4 * rg + 2], st[s][4 * rg + 3]);
                    *(LAS u32x2*)(lds + L_ST + off_b(e, d0 >> 3) + (d0 & 7) * 2) = w; } }
        }
        TP_END(4);
        TP_BEGIN(5)
        if (PASS == 1) {
            int ln5 = lane; asm volatile("" : "+v"(ln5));
            asm volatile("s_waitcnt lgkmcnt(0)" ::: "memory"); FK_BAR();
            if (MIXER == 2 && c + 1 < SEGC) { const int t5 = wave * 64 + ln5; if (t5 < 128) c_nbuf[((c + 1) & 1) * 128 + t5] = c_adec[t5] * (c_nbuf[(c & 1) * 128 + t5] + c_ninc[t5]); }
            LAS unsigned char* ob = lds + L_Q0;
#pragma unroll
            for (int r = 0; r < 16; ++r) { const int i = 32 * ti + (r & 3) + 8 * (r >> 2) + 4 * (ln5 >> 5); *(LAS float*)(ob + i * 512 + (32 * te + (ln5 & 31)) * 4) = oacc[r]; }
            asm volatile("s_waitcnt lgkmcnt(0)" ::: "memory"); FK_BAR();
            const int tid5 = wave * 64 + ln5, row = tid5 >> 3, sg = tid5 & 7, e0 = sg * 16; float ov[16], zv[16];
#pragma unroll
            for (int q4 = 0; q4 < 4; ++q4) { const f32x4 t4 = *(const LAS f32x4*)(ob + row * 512 + (e0 + 4 * q4) * 4);
#pragma unroll
                for (int j = 0; j < 4; ++j) ov[4 * q4 + j] = t4[j]; }
#pragma unroll
            for (int hh = 0; hh < 2; ++hh) { const unsigned zz[4] = {zraw[hh].x, zraw[hh].y, zraw[hh].z, zraw[hh].w};
#pragma unroll
                for (int j = 0; j < 4; ++j) { zv[hh * 8 + 2 * j] = __uint_as_float(zz[j] << 16); zv[hh * 8 + 2 * j + 1] = __uint_as_float(zz[j] & 0xffff0000u); } }
            float y[16];
            if (MIXER == 2) {
                const float den = c_dint[row] + (row < 32 ? c_dpart[row] : c_dpart[32 + (row - 32)] + c_dpart[64 + (row - 32)]);
                const float idn = 1.0f / fmaxf(fabsf(den), 1.0f); float sm = 0.f;
#pragma unroll
                for (int j = 0; j < 16; ++j) { ov[j] *= idn; sm += ov[j]; }
                sm = sum8(sm);
                const float mu = sm * (1.0f / 128.0f); float sq = 0.f;
#pragma unroll
                for (int j = 0; j < 16; ++j) { ov[j] -= mu; sq += ov[j] * ov[j]; }
                sq = sum8(sq);
                const float rs = rsqrtf(sq * (1.0f / 128.0f) + 1e-6f);
#pragma unroll
                for (int hh = 0; hh < 2; ++hh) { const bf16x8 cvf = ld_frag(lds + L_CV + off_b(row, 2 * sg + hh));
#pragma unroll
                    for (int j = 0; j < 8; ++j) { const int e = e0 + hh * 8 + j; y[hh * 8 + j] = (ov[hh * 8 + j] * rs * c_g[e] + c_skip[e] * bf2f((unsigned short)cvf[j])) * zv[hh * 8 + j]; } }
            } else {
                float sq = 0.f;
#pragma unroll
                for (int j = 0; j < 16; ++j) sq += ov[j] * ov[j];
                sq = sum8(sq);
                const float rs = rsqrtf(sq * (1.0f / 128.0f) + 1e-6f);
#pragma unroll
                for (int j = 0; j < 16; ++j) y[j] = ov[j] * rs * c_g[e0 + j] * zv[j];
            }
            bf16_t* mo = A.mix + (row0 + (size_t)c * 64 + row) * MIXW + MIXER * 512 + h * 128 + e0;
            u32x4 w0, w1; w0.x = pg8::cvt_pk_bf16(y[0], y[1]); w0.y = pg8::cvt_pk_bf16(y[2], y[3]); w0.z = pg8::cvt_pk_bf16(y[4], y[5]); w0.w = pg8::cvt_pk_bf16(y[6], y[7]);
            w1.x = pg8::cvt_pk_bf16(y[8], y[9]); w1.y = pg8::cvt_pk_bf16(y[10], y[11]); w1.z = pg8::cvt_pk_bf16(y[12], y[13]); w1.w = pg8::cvt_pk_bf16(y[14], y[15]);
            *(u32x4*)mo = w0; *(u32x4*)(mo + 8) = w1;
        }
        TP_END(5);
    }
    if (PASS == 0) {
#pragma unroll
        for (int s = 0; s < NT; ++s)
#pragma unroll
            for (int r = 0; r < 16; ++r) slot[((wave * NT + s) * 16 + r) * 64 + lane] = st[s][r];
        if (lane == 0) {
#pragma unroll
            for (int i = 0; i < NG * 8; ++i) { const int d = (wave + 8 * (i >> 3)) * 8 + (i & 7); slot[16384 + d] = ex2(MIXER == 2 ? carry_s : carry[i]); } }
        if (MIXER == 2 && te0 == 0 && (lane & 31) == 0) {
#pragma unroll
            for (int r = 0; r < 16; ++r) slot[16384 + 128 + 32 * td + (r & 3) + 8 * (r >> 2) + 4 * (lane >> 5)] = nacc[r]; }
    }
    asm volatile("s_waitcnt vmcnt(0) lgkmcnt(0)" ::: "memory"); FK_BAR();
}

__device__ __forceinline__ void mix_combine(float* U, int G, int wg, int wv) {
    int tid_ = wv * 64 + fk_lane(); asm volatile("" : "+v"(tid_)); const int tid = tid_;
    const int nslab = 3 * NBH * 16384, nvec = NBH * 128;
    for (int idx = wg * NTHR + tid; idx < nslab + nvec; idx += G * NTHR) {
        int mixer, bh, e, d; bool isn = false;
        if (idx < nslab) { mixer = idx / (NBH * 16384); const int rem = idx - mixer * (NBH * 16384); bh = rem >> 14; e = rem & 16383;
            if (mixer == 1 && e >= 8192) continue;
            const int ts = e >> 10, r = (e >> 6) & 15, ln = e & 63; const int wv = (mixer == 1) ? ts : (ts >> 1); const int tdd = (mixer == 1) ? (wv >> 2) : (wv >> 1);
            d = 32 * tdd + (r & 3) + 8 * (r >> 2) + 4 * (ln >> 5); }
        else { const int k = idx - nslab; mixer = 2; bh = k >> 7; d = k & 127; e = 16384 + 128 + d; isn = true; }
        (void)isn;
        float* base = U + (size_t)((mixer * NBH + bh) * NSEG) * USZ; float uu[NSEG], aa[NSEG];
#pragma unroll
        for (int sgm = 0; sgm < NSEG; ++sgm) { uu[sgm] = base[(size_t)sgm * USZ + e]; aa[sgm] = base[(size_t)sgm * USZ + 16384 + d]; }
        float carry = 0.f;
#pragma unroll
        for (int sgm = 0; sgm < NSEG; ++sgm) { base[(size_t)sgm * USZ + e] = carry; carry = aa[sgm] * carry + uu[sgm]; }
    }
}
#ifndef REP_INP
#define REP_INP 1
#endif
#ifndef REP_A
#define REP_A 1
#endif
#ifndef REP_B
#define REP_B 1
#endif
#ifndef REP_B0
#define REP_B0 1
#endif
#ifndef REP_B1
#define REP_B1 1
#endif
#ifndef REP_B2
#define REP_B2 1
#endif
#ifndef REP_Q
#define REP_Q 1
#endif
#ifndef REP_ATT
#define REP_ATT 1
#endif
template <class T> __device__ __forceinline__ T* opq(T* p) { auto g = (__attribute__((address_space(1))) T*)p; asm volatile("" : "+s"(g)); return (T*)g; }
__global__ void __launch_bounds__(NTHR, 2) fwd(Args a) {
    extern __shared__ __attribute__((aligned(16))) unsigned char lds_raw[];
    LAS unsigned char* lds = (LAS unsigned char*)lds_raw;
    unsigned char* ws = a.ws;
    const int wv = __builtin_amdgcn_readfirstlane((int)threadIdx.x >> 6);
    if (wv == 0) { const int l0 = fk_lane(); if (l0 < 8) ((LAS unsigned*)(lds + LDS_TP))[l0] = 0u; }
    __syncthreads();
    XcdBarrier bar = xcd_barrier_post((unsigned*)(ws + OFF_CTL), (volatile LAS unsigned*)(lds + LDS_BAR), wv);
    const int lo = a.ph_lo, hi = a.ph_hi, G = gridDim.x, wg = blockIdx.x; (void)lo; (void)hi;
    grp_census_post(bar, wg & 7, wv);
#ifdef FK_PHASE_RANGE
#define IN(k) (lo <= (k) && (k) < hi)
#else
#define IN(k) true
#endif
#ifdef PHPROBE
#define PH_BEGIN(k) unsigned long long ph_t0_##k = 0; if (PHPROBE == (k)) ph_t0_##k = __builtin_amdgcn_s_memrealtime();
#define PH_END(k) do { if (PHPROBE == (k) && wv == 0) { const unsigned long long d_ = __builtin_amdgcn_s_memrealtime() - ph_t0_##k; if (fk_lane() == 0) *(volatile LAS unsigned long long*)(lds + LDS_TP) += d_; } } while (0)
#else
#define PH_BEGIN(k)
#define PH_END(k) do { } while (0)
#endif
#define SEAM(k) do { if (IN(k) && IN((k) + 1)) { PH_BEGIN(100) xcd_barrier(bar, wv); PH_END(100); } } while (0)
#define GSEAM(k) do { if (IN(k) && IN((k) + 1)) { PH_BEGIN(100) if (G == 256) grp_barrier(bar, wg & 7, 32u, wv); else xcd_barrier(bar, wv); PH_END(100); } } while (0)
    float* ssq = (float*)(ws + OFF_SSQ);
    const size_t qoff = (G == 256) ? (size_t)(wg & 7) * ((size_t)4096 * NPROJ * 2 - (size_t)4096 * 2048) : (size_t)0, ooff = (G == 256) ? qoff + (size_t)4096 * 2048 : SZ_XB;
    bf16_t* xb = (bf16_t*)(ws + OFF_XB);

    { PH_BEGIN(0) if (IN(0)) p0_prologue(a, lds, wv); PH_END(0); }
    SEAM(0);
    grp_census_read(bar, wg & 7, wv);
    if (IN(2)) { const int c = wg; int sub = -1, nsub = 96;
        if (G == 256) { if (c >= 144 && !(c >= 160 && c < 176)) sub = c < 160 ? c - 144 : 16 + (c - 176); } else { sub = c; nsub = G; }
        if (sub >= 0) p0_weights(a, lds, 1, sub, nsub, wv); }
#pragma unroll 1
    for (int l = 0; l < 2; ++l) {
        const int pb = 2 + 8 * l;
        if (IN(pb)) {
            { pg8::Gemm g{(const bf16_t*)(opq(ws) + OFF_MEMN + l * SZ_SQ), (const bf16_t*)(opq(ws) + OFF_WK + l * SZ_SQ), 1024, 1024, 1024}; pg8::StaticOrder So; So.init(1024, 1024, G, (wg + G - G / 2) % G);
              pg8::EpiBf16S E{(bf16_t*)(opq(ws) + OFF_KM + l * SZ_SQ), 1024, nullptr}; pg8::gemm_phase<pg8::EpiBf16S, pg8::StaticOrder>(lds, g, So, E, nullptr, wv); }
            { pg8::Gemm g{(const bf16_t*)(opq(ws) + OFF_WV + l * SZ_SQ), (const bf16_t*)(opq(ws) + OFF_MEMN + l * SZ_SQ), 1024, 1024, 1024}; pg8::StaticOrder So; So.init(1024, 1024, G, (wg + G - G / 2 - 32) % G);
              pg8::EpiVt E{(bf16_t*)(opq(ws) + OFF_VT + l * SZ_SQ)}; pg8::gemm_phase<pg8::EpiVt, pg8::StaticOrder>(lds, g, So, E, nullptr, wv); }
        }
#ifdef FK_STAGGER
        if ((wg >> 3) & 1) { for (int i = 0; i < FK_STAGGER; ++i) __builtin_amdgcn_s_sleep(127); }
#endif
        PH_BEGIN(1)
        for (int rep = 0; rep < REP_INP; ++rep) if (IN(pb)) {
            pg8::Gemm g{opq(xb), (const bf16_t*)(opq(ws) + OFF_WIN + l * SZ_WIN), MR, NPAD, D}; pg8::StaticOrder So; So.init(MR, NPAD, G, wg);
            pg8::EpiInProj E{(bf16_t*)(opq(ws) + OFF_PROJ), (float*)(opq(ws) + OFF_EXT), opq(ssq) + (size_t)(2 * l) * 32768, (const float*)(opq(ws) + OFF_LB) + l * 512};
            pg8::gemm_phase<pg8::EpiInProj, pg8::StaticOrder>(lds, g, So, E, nullptr, wv);
        }
        PH_END(1);
        SEAM(pb);
        MixArgs MA{(const bf16_t*)(opq(ws) + OFF_PROJ), (const float*)(opq(ws) + OFF_EXT), (bf16_t*)(opq(ws) + OFF_MIX), opq(a.out)  ,
                   a.in[5] + l * 128, a.in[6] + l * 16 * 256, a.in[7] + l * 256, a.in[8] + l * 128, a.in[9] + l * 4 * 512, a.in[10] + l * 512, a.in[11] + l * 128 * 16, a.in[12] + l * 128 * 16, a.in[13] + l * 128 * 16,
                   a.in[14] + l * 4, a.in[15] + l * 4, a.in[16] + l * 512, a.in[17] + l * 512};
#define MIX_BH(u)  (G == 256 ? ((u) & 7) / 2 * 4 + ((u) >> 6) : (u) / NSEG)
#define MIX_SEG(u) (G == 256 ? ((u) & 1) * 8 + (((u) >> 3) & 7) : (u) % NSEG)
        for (int rep = 0; rep < REP_A; ++rep) {
        PH_BEGIN(2)
        if (IN(pb + 1)) {
            for (int u = wg; u < NBH * NSEG; u += G) mix_unit<0, 0>(lds, MA, MIX_BH(u), MIX_SEG(u), wv);
            for (int u = wg; u < NBH * NSEG; u += G) mix_unit<1, 0>(lds, MA, MIX_BH(u), MIX_SEG(u), wv);
            for (int u = wg; u < NBH * NSEG; u += G) mix_unit<2, 0>(lds, MA, MIX_BH(u), MIX_SEG(u), wv);
        }
        PH_END(2);
        SEAM(pb + 1);
        PH_BEGIN(3)
        if (IN(pb + 2)) mix_combine(MA.U, G, wg, wv);
        PH_END(3);
        SEAM(pb + 2);
        }
        PH_BEGIN(4)
        for (int rep = 0; rep < REP_B; ++rep) if (IN(pb + 3)) {
            for (int r0 = 0; r0 < REP_B0; ++r0) for (int u = wg; u < NBH * NSEG; u += G) mix_unit<0, 1>(lds, MA, MIX_BH(u), MIX_SEG(u), wv);
            for (int r1 = 0; r1 < REP_B1; ++r1) for (int u = wg; u < NBH * NSEG; u += G) mix_unit<1, 1>(lds, MA, MIX_BH(u), MIX_SEG(u), wv);
            for (int r2 = 0; r2 < REP_B2; ++r2) for (int u = wg; u < NBH * NSEG; u += G) mix_unit<2, 1>(lds, MA, MIX_BH(u), MIX_SEG(u), wv);
        }
        PH_END(4);
        GSEAM(pb + 3);
        PH_BEGIN(5)
        if (IN(pb + 4)) {
            pg8::Gemm g{(const bf16_t*)(opq(ws) + OFF_MIX), (const bf16_t*)(opq(ws) + OFF_WOUT + l * SZ_WOUT), MR, D, MIXW}; pg8::StaticOrder So; So.init(MR, D, G, wg);
            pg8::EpiResid E{l == 0 ? opq(a.in[0]) : (const float*)nullptr, opq(xb), opq(ssq) + (size_t)(2 * l + 1) * 32768};
            pg8::gemm_phase<pg8::EpiResid, pg8::StaticOrder>(lds, g, So, E, nullptr, wv);
        }
        PH_END(5);
        GSEAM(pb + 4);
        PH_BEGIN(6)
        for (int rep = 0; rep < REP_Q; ++rep) if (IN(pb + 5)) {
            pg8::Gemm g{opq(xb), (const bf16_t*)(opq(ws) + OFF_WQ + l * SZ_SQ), MR, D, D}; pg8::StaticOrder So; So.init(MR, D, G, wg);
            pg8::EpiBf16S E{(bf16_t*)(opq(ws) + OFF_PROJ + qoff), D, opq(ssq) + (size_t)(2 * l + 1) * 32768};
            pg8::gemm_phase<pg8::EpiBf16S, pg8::StaticOrder>(lds, g, So, E, nullptr, wv);
        }
        PH_END(6);
        PH_BEGIN(7)
        for (int rep = 0; rep < REP_ATT; ++rep) if (IN(pb + 6)) { pg8::StaticOrder So; So.init(MR, D, G, wg);
            attn_phase(lds, (const bf16_t*)(opq(ws) + OFF_PROJ + qoff), (const bf16_t*)(opq(ws) + OFF_KM + l * SZ_SQ), (const bf16_t*)(opq(ws) + OFF_VT + l * SZ_SQ), (bf16_t*)(opq(ws) + OFF_PROJ + ooff), So, wv); }
        PH_END(7);
        GSEAM(pb + 6);
        PH_BEGIN(8)
        if (IN(pb + 7)) {
            pg8::Gemm g{(const bf16_t*)(opq(ws) + OFF_PROJ + ooff), (const bf16_t*)(opq(ws) + OFF_WO + l * SZ_SQ), MR, D, D}; pg8::StaticOrder So; So.init(MR, D, G, wg);
            pg8::EpiResid E{(const float*)nullptr, opq(xb), opq(ssq) + (size_t)(2 * l + 2) * 32768};
            pg8::gemm_phase<pg8::EpiResid, pg8::StaticOrder>(lds, g, So, E, nullptr, wv);
        }
        PH_END(8);
        if (l == 0) { GSEAM(pb + 7);
            if (G == 256 && !(wg & 1)) { if (wv == 0 && fk_lane() == 0) { unsigned* cb = (unsigned*)(ws + OFF_CTL); XB_SPIN(xb_ld(&cb[GB_CNT((wg & 7) + 1)]) < 32u, cb); } __syncthreads(); } }
        else { GSEAM(pb + 7);
            if (G == 256) { if (wv == 0 && fk_lane() < 8) { unsigned* cb = (unsigned*)(ws + OFF_CTL); XB_SPIN(xb_ld(&cb[GB_CNT(fk_lane())]) < 160u, cb); } __syncthreads(); } }
    }
    PH_BEGIN(18)
    if (IN(18)) { const int lane = fk_lane(), wave = wv; const float* gf = a.in[25]; const float* sq = ssq + (size_t)4 * 32768;
        for (int it = 0; it < MR / (G * 8); ++it) { const int row = (G == 256) ? (wg & 7) * 4096 + it * 256 + (wg >> 3) * 8 + wave : (it * G + wg) * 8 + wave;
            const float rs = rsqrtf(sq[row] * (1.0f / 1024.0f) + 1e-6f);
#pragma unroll
            for (int i = 0; i < 2; ++i) { const int c0 = i * 512 + lane * 8; const u32x4 o = *(const u32x4*)(xb + (size_t)row * D + c0); const f32x4 g0 = *(const f32x4*)(gf + c0), g1 = *(const f32x4*)(gf + c0 + 4);
                const f32x4 x0 = (f32x4){__uint_as_float(o.x << 16), __uint_as_float(o.x & 0xffff0000u), __uint_as_float(o.y << 16), __uint_as_float(o.y & 0xffff0000u)};
                const f32x4 x1 = (f32x4){__uint_as_float(o.z << 16), __uint_as_float(o.z & 0xffff0000u), __uint_as_float(o.w << 16), __uint_as_float(o.w & 0xffff0000u)};
                float* p = a.out + (size_t)row * D + c0; *(f32x4*)p = x0 * rs * g0; *(f32x4*)(p + 4) = x1 * rs * g1; } } }
    PH_END(18);
#undef IN
#undef SEAM
#ifdef PHMIN
    { if (wv == 0 && fk_lane() == 0) { const unsigned long long acc = *(volatile LAS unsigned long long*)(lds + LDS_TP); atomicMax((unsigned*)(ws + OFF_CTL) + 16000, 0x80000000u - (unsigned)acc); }
      xcd_barrier(bar, wv);
      if (wv == 0 && fk_lane() == 0) { const unsigned m = __hip_atomic_load((unsigned*)(ws + OFF_CTL) + 16000, __ATOMIC_RELAXED, __HIP_MEMORY_SCOPE_AGENT); *(volatile LAS unsigned long long*)(lds + LDS_TP) = (unsigned long long)(0x80000000u - m); }
      __syncthreads(); }
#endif
#if defined(TPROBE) || defined(PHPROBE) || defined(ATP) || defined(GPROBE)
    if (wv == 0) { asm volatile("s_waitcnt vmcnt(0) lgkmcnt(0)" ::: "memory"); const unsigned long long acc = *(volatile LAS unsigned long long*)(lds + LDS_TP), t0 = __builtin_amdgcn_s_memrealtime(); while (__builtin_amdgcn_s_memrealtime() - t0 < acc) __builtin_amdgcn_s_sleep(8); }
#endif
}
}
static int fk_launch(void* const* d_in, void* d_out, void* d_ws, int lo, int hi, hipStream_t stream) {
    static int grid = 0;
    if (grid == 0) {
        int dev = 0, cus = 0, per_cu = 0;
        if (hipGetDevice(&dev) != hipSuccess || hipDeviceGetAttribute(&cus, hipDeviceAttributeMultiprocessorCount, dev) != hipSuccess) { grid = -1; return -1; }
        if (hipFuncSetAttribute((const void*)fk::fwd, hipFuncAttributeMaxDynamicSharedMemorySize, fk::LDS_BYTES) != hipSuccess) { fprintf(stderr, "hipFuncSetAttribute failed\n"); grid = -1; return -1; }
        if (hipOccupancyMaxActiveBlocksPerMultiprocessor(&per_cu, (const void*)fk::fwd, fk::NTHR, fk::LDS_BYTES) != hipSuccess || per_cu < 1) { fprintf(stderr, "occupancy query: %d\n", per_cu); (void)hipGetLastError(); grid = -1; return -1; }
        grid = cus;
    }
    if (grid < 0) return -1;
    (void)hipMemsetAsync(d_ws, 0, fk::ZERO_BYTES, stream);
    fk::Args a{};
    for (int i = 0; i < 26; ++i) a.in[i] = (const float*)d_in[i];
    a.out = (float*)d_out; a.ws = (unsigned char*)d_ws; a.ph_lo = lo; a.ph_hi = hi;
    hipLaunchKernelGGL(fk::fwd, dim3(grid), dim3(fk::NTHR), fk::LDS_BYTES, stream, a);
    return 0;
}
extern "C" void kernel_launch(void* const* d_in, const int* in_sizes, int n_in, void* d_out, int out_size, void* d_ws, size_t ws_size, hipStream_t stream) {
    if (n_in != 26 || ws_size < fk::WS_END || out_size != fk::MR * fk::D) { fprintf(stderr, "kernel_launch: unexpected shapes (n_in %d, ws %zu, out %d)\n", n_in, ws_size, out_size); return; }
    fk_launch(d_in, d_out, d_ws, 0, 19, stream);
}
```

```cpp
#include <hip/hip_runtime.h>
#include <cstdio>
namespace pg8 {
#define PG8_LAS __attribute__((address_space(3)))
typedef unsigned short bf16_t;
typedef short bf16x8 __attribute__((ext_vector_type(8)));
typedef float f32x4 __attribute__((ext_vector_type(4)));
typedef unsigned u32x4 __attribute__((ext_vector_type(4)));
constexpr int BM = 256, BK = 64, HALF = 128, HTB = HALF * BK * 2  , STAGE_BYTES = 8 * HTB, NXCD = 8, WGM = 8;

__host__ __device__ __forceinline__ int lds_byte(int r, int c) { const int st = (r >> 4) * 2 + (c >> 5), rr = r & 15, cc = c & 31, ob = rr * 64 + cc * 2; return st * 1024 + (ob ^ (((ob >> 9) & 1) << 5)); }
__host__ __device__ __forceinline__ void stage_rc(int b, int& R, int& C) { const int st = b / 1024, sb = b % 1024, swz = sb ^ (((sb >> 9) & 1) << 5); R = (st >> 1) * 16 + swz / 64; C = (st & 1) * 32 + (swz % 64) / 2; }
__host__ __device__ __forceinline__ int perm32(int rho) { const int n = rho >> 4, i = rho & 15; return 8 * (i >> 2) + 4 * n + (i & 3); }

struct Unit { int pm, pn; };
struct Gemm { const bf16_t* A; const bf16_t* Bt; int M, N, K; };

struct StaticOrder {
    int nM, nN, nwg, G, c, rev;
    __host__ __device__ void init(int M, int N, int G_, int c_, int rev_ = 0) { nM = M / BM; nN = N / BM; nwg = nM * nN; G = G_; c = c_; rev = rev_; }
    __host__ __device__ bool next(int i, Unit& u) const {
        const int nr = c < nwg ? (nwg - c + G - 1) / G : 0;
        if (i >= nr) return false;
        const long L = (long)(rev ? nr - 1 - i : i) * G + c;
        int wgid = (int)L; { const int q = nwg / NXCD, r = nwg % NXCD, xcd = wgid % NXCD, off = wgid / NXCD; wgid = (xcd < r ? xcd * (q + 1) : r * (q + 1) + (xcd - r) * q) + off; }
        const int nig = WGM * nN, gid = wgid / nig, fm = gid * WGM, gsz = (nM - fm) < WGM ? (nM - fm) : WGM;
        u.pm = fm + ((wgid % nig) % gsz); u.pn = (wgid % nig) / gsz; return true;
    }
    __device__ __forceinline__ void a_ready(const Unit&) const {}
    __device__ __forceinline__ void done(const Unit&) const {}
};
__device__ __forceinline__ unsigned cvt_pk_bf16(float lo, float hi) { unsigned r; asm volatile("v_cvt_pk_bf16_f32 %0, %1, %2" : "=v"(r) : "v"(lo), "v"(hi)); return r; }
typedef float f32x2e __attribute__((ext_vector_type(2)));
__device__ __forceinline__ float fsigm(float v) { return __builtin_amdgcn_rcpf(1.0f + __expf(-v)); }
__device__ __forceinline__ unsigned pk_h2(float a, float b) { const _Float16 ha = (_Float16)a, hb = (_Float16)b; return (unsigned)__builtin_bit_cast(unsigned short, ha) | ((unsigned)__builtin_bit_cast(unsigned short, hb) << 16); }
__device__ __forceinline__ float log2_1mk(float k) { const float ser = -(k + k * k * (0.5f + k * (0.33333334f + 0.25f * k))) * 1.4426950408889634f; return k < 0.03f ? ser : __log2f(1.0f - k); }

struct EpiInProj {
    static constexpr bool PERM = true, AFTER_DRAIN = false; static constexpr int ID = 0;
    bf16_t* proj; float* ext; const float* ssq; const float* lb;
    static constexpr bool PRE = true;
    __device__ __forceinline__ const float* pre_src(const Unit& u, int wr) const { return ssq + u.pm * BM + wr * 64; }
    __device__ __forceinline__ void operator()(const f32x4 (&acc)[2][2][4][2], const Unit& u, int wr, int wc, int fr, int fq, const float (&pre)[8]) const {
        const int row0 = u.pm * BM + wr * 64 + fr, pn = u.pn;
        const int kind = (pn == 18) ? 4 : (pn == 2 || pn == 3) ? 2 : (pn == 8) ? 3 : (pn == 0 || pn == 1 || pn == 6 || pn == 7 || pn == 12 || pn == 13 || pn == 16 || pn == 17) ? 1 : 0;
        const int col0 = pn * BM + wc * 32 + 8 * fq;
        if (kind == 4) {
#pragma unroll
            for (int ai = 0; ai < 2; ++ai)
#pragma unroll
                for (int m = 0; m < 4; ++m) { const int r = row0 + ai * HALF + m * 16; const float rs = rsqrtf(pre[ai * 4 + m] * (1.0f / 1024.0f) + 1e-6f);
                    if (wc == 0) { float* e = ext + (size_t)r * 32 + 8 * fq; *(f32x4*)e = acc[ai][0][m][0] * rs; *(f32x4*)(e + 4) = acc[ai][0][m][1] * rs; } }
            return;
        }
        float rsv[2][4];
#pragma unroll
        for (int ai = 0; ai < 2; ++ai)
#pragma unroll
            for (int m = 0; m < 4; ++m) rsv[ai][m] = rsqrtf(pre[ai * 4 + m] * (1.0f / 1024.0f) + 1e-6f);
#pragma unroll
        for (int bj = 0; bj < 2; ++bj) {
            float lbv[8];
#pragma unroll
            for (int j = 0; j < 8; ++j) lbv[j] = (kind == 2) ? lb[(pn - 2) * BM + bj * HALF + wc * 32 + 8 * fq + j] : 0.f;
#pragma unroll
            for (int ai = 0; ai < 2; ++ai)
#pragma unroll
                for (int m = 0; m < 4; ++m) {
                    const int r = row0 + ai * HALF + m * 16; const float rs = rsv[ai][m];
                    bf16_t* rowp = proj + (size_t)r * 4608 + col0;
                    float v[8];
#pragma unroll
                    for (int j = 0; j < 4; ++j) { v[j] = acc[ai][bj][m][0][j] * rs; v[4 + j] = acc[ai][bj][m][1][j] * rs; }
                    u32x4 w;
                    if (kind == 2) {
#pragma unroll
                        for (int j = 0; j < 8; ++j) { const float k = (1.0f - lbv[j]) * fsigm(-v[j]); v[j] = log2_1mk(k); }
                        w.x = pk_h2(v[0], v[1]); w.y = pk_h2(v[2], v[3]); w.z = pk_h2(v[4], v[5]); w.w = pk_h2(v[6], v[7]);
                    } else {
                        if (kind == 1) {
#pragma unroll
                            for (int j = 0; j < 8; ++j) v[j] = v[j] * fsigm(v[j]);
                        } else if (kind == 3) {
#pragma unroll
                            for (int j = 0; j < 8; ++j) v[j] *= 0.125f;
                        }
                        w.x = cvt_pk_bf16(v[0], v[1]); w.y = cvt_pk_bf16(v[2], v[3]); w.z = cvt_pk_bf16(v[4], v[5]); w.w = cvt_pk_bf16(v[6], v[7]);
                    }
                    *(u32x4*)(rowp + bj * HALF) = w;
                }
        }
    }
};

struct EpiResid {
    static constexpr bool PERM = true, AFTER_DRAIN = false; static constexpr int ID = 1;
    const float* x32; bf16_t* xb; float* ssq;
    static constexpr bool PRE = false;
    __device__ __forceinline__ void operator()(const f32x4 (&acc)[2][2][4][2], const Unit& u, int wr, int wc, int fr, int fq, const float (&)[8]) const {
        const int row0 = u.pm * BM + wr * 64 + fr, col0 = u.pn * BM + wc * 32 + 8 * fq;
        const int ln = fq * 16 + fr;
#pragma unroll
        for (int ai = 0; ai < 2; ++ai) {
            f32x4 xo[4][2][2];
            if (x32) {
#pragma unroll
                for (int m = 0; m < 4; ++m)
#pragma unroll
                    for (int bj = 0; bj < 2; ++bj) { const size_t off = (size_t)(row0 + ai * HALF + m * 16) * 1024 + col0 + bj * HALF; xo[m][bj][0] = *(const f32x4*)(x32 + off); xo[m][bj][1] = *(const f32x4*)(x32 + off + 4); }
            } else {
                u32x4 ob[4][2];
#pragma unroll
                for (int m = 0; m < 4; ++m)
#pragma unroll
                    for (int bj = 0; bj < 2; ++bj) ob[m][bj] = *(const u32x4*)(xb + (size_t)(row0 + ai * HALF + m * 16) * 1024 + col0 + bj * HALF);
#pragma unroll
                for (int m = 0; m < 4; ++m)
#pragma unroll
                    for (int bj = 0; bj < 2; ++bj) { const u32x4 o = ob[m][bj];
                        xo[m][bj][0] = (f32x4){__uint_as_float(o.x << 16), __uint_as_float(o.x & 0xffff0000u), __uint_as_float(o.y << 16), __uint_as_float(o.y & 0xffff0000u)};
                        xo[m][bj][1] = (f32x4){__uint_as_float(o.z << 16), __uint_as_float(o.z & 0xffff0000u), __uint_as_float(o.w << 16), __uint_as_float(o.w & 0xffff0000u)}; }
            }
#pragma unroll
            for (int m = 0; m < 4; ++m) {
                const int r = row0 + ai * HALF + m * 16; const size_t off = (size_t)r * 1024 + col0; float ss = 0.f;
#pragma unroll
                for (int bj = 0; bj < 2; ++bj) {
                    const f32x4 x0 = xo[m][bj][0] + acc[ai][bj][m][0], x1 = xo[m][bj][1] + acc[ai][bj][m][1];
                    u32x4 w; w.x = cvt_pk_bf16(x0[0], x0[1]); w.y = cvt_pk_bf16(x0[2], x0[3]); w.z = cvt_pk_bf16(x1[0], x1[1]); w.w = cvt_pk_bf16(x1[2], x1[3]);
                    *(u32x4*)(xb + off + bj * HALF) = w;
                    ss += (x0[0] * x0[0] + x0[1] * x0[1]) + (x0[2] * x0[2] + x0[3] * x0[3]) + (x1[0] * x1[0] + x1[1] * x1[1]) + (x1[2] * x1[2] + x1[3] * x1[3]);
                }
                ss += __builtin_bit_cast(float, __builtin_amdgcn_ds_bpermute((ln ^ 16) << 2, __builtin_bit_cast(int, ss))); ss += __builtin_bit_cast(float, __builtin_amdgcn_ds_bpermute((ln ^ 32) << 2, __builtin_bit_cast(int, ss)));
                if (fq == 0) unsafeAtomicAdd(ssq + r, ss);
            }
            asm volatile("" ::: "memory");
        }
    }
};

struct EpiBf16S {
    static constexpr bool PERM = true, AFTER_DRAIN = false; static constexpr int ID = 2;
    bf16_t* O; int ldc; const float* ssq;
    static constexpr bool PRE = true;
    __device__ __forceinline__ const float* pre_src(const Unit& u, int wr) const { return ssq ? ssq + u.pm * BM + wr * 64 : (const float*)O; }
    __device__ __forceinline__ void operator()(const f32x4 (&acc)[2][2][4][2], const Unit& u, int wr, int wc, int fr, int fq, const float (&pre)[8]) const {
        const int row0 = u.pm * BM + wr * 64 + fr, col0 = u.pn * BM + wc * 32 + 8 * fq;
#pragma unroll
        for (int ai = 0; ai < 2; ++ai)
#pragma unroll
            for (int m = 0; m < 4; ++m) {
                const int r = row0 + ai * HALF + m * 16; const float rs = ssq ? rsqrtf(pre[ai * 4 + m] * (1.0f / 1024.0f) + 1e-6f) : 1.0f;
                bf16_t* rowp = O + (size_t)r * ldc + col0;
#pragma unroll
                for (int bj = 0; bj < 2; ++bj) { const f32x4 v0 = acc[ai][bj][m][0] * rs, v1 = acc[ai][bj][m][1] * rs;
                    u32x4 w; w.x = cvt_pk_bf16(v0[0], v0[1]); w.y = cvt_pk_bf16(v0[2], v0[3]); w.z = cvt_pk_bf16(v1[0], v1[1]); w.w = cvt_pk_bf16(v1[2], v1[3]);
                    *(u32x4*)(rowp + bj * HALF) = w;
#ifdef EPI_DUP
                    if (ssq) *(u32x4*)(rowp + bj * HALF + (size_t)32768 * 1024) = w;
#endif
                    }
            }
    }
};

struct EpiVt {
    static constexpr bool PERM = true, AFTER_DRAIN = false; static constexpr int ID = 3;
    bf16_t* O;
    static constexpr bool PRE = false;
    __device__ __forceinline__ void operator()(const f32x4 (&acc)[2][2][4][2], const Unit& u, int wr, int wc, int fr, int fq, const float (&)[8]) const {
        const int row0 = u.pm * BM + wr * 64 + fr, colb = u.pn * BM + wc * 32;
        typedef unsigned u32x2 __attribute__((ext_vector_type(2)));
#pragma unroll
        for (int ai = 0; ai < 2; ++ai)
#pragma unroll
            for (int m = 0; m < 4; ++m) {
                bf16_t* rowp = O + (size_t)(row0 + ai * HALF + m * 16) * 1024 + colb;
#pragma unroll
                for (int bj = 0; bj < 2; ++bj)
#pragma unroll
                    for (int n = 0; n < 2; ++n) { const f32x4 v = acc[ai][bj][m][n]; const int p = (fq >> 1) * 16 + n * 8 + (fq & 1) * 4;
                        u32x2 w; w.x = cvt_pk_bf16(v[0], v[1]); w.y = cvt_pk_bf16(v[2], v[3]); *(u32x2*)(rowp + bj * HALF + p) = w; }
            }
    }
};
template <class Epi, class Sched, bool STAMP = false>
__device__ __forceinline__ void gemm_phase(PG8_LAS unsigned char* lds, const Gemm g, const Sched& S, const Epi& E, unsigned long long* stamps, const int wv_) {
    int tid_; asm volatile("v_mbcnt_lo_u32_b32 %0, -1, 0\n\tv_mbcnt_hi_u32_b32 %0, -1, %0" : "=v"(tid_)); tid_ += wv_ * 64;
    const int tid = tid_, wid = __builtin_amdgcn_readfirstlane(tid >> 6), lane = tid & 63, wr = wid >> 2, wc = wid & 3, fr = lane & 15, fq = lane >> 4;
    const int K = g.K, nt = K / BK;
    int ts_lo = 0, ts_hi = 0, nts = 0; const unsigned long long rt_entry = STAMP ? (unsigned long long)wall_clock64() : 0ull;
#define PG8_STAMP() do { if (STAMP && wid == 0 && nts < 64) { const unsigned long long _c = (unsigned long long)clock64(); \
        ts_lo = (lane == nts) ? (int)(unsigned)_c : ts_lo; ts_hi = (lane == nts) ? (int)(unsigned)(_c >> 32) : ts_hi; ++nts; } } while (0)
    PG8_STAMP();
    unsigned voffA[2], voffB[2];
#pragma unroll
    for (int i = 0; i < 2; ++i) { int R, C; stage_rc(tid * 16 + i * 8192, R, C); const int Rb = Epi::PERM ? ((R & ~31) + perm32(R & 31)) : R;
        voffA[i] = (unsigned)(R * K + C) * 2u; voffB[i] = (unsigned)(Rb * K + C) * 2u; }
    const size_t kstep = (size_t)(BK * 2);
    const size_t hstep = (size_t)HALF * K * 2;
    const size_t tstep = 2 * hstep;
    const unsigned lds_u = (unsigned)(size_t)lds;
    const unsigned ldsw = (unsigned)wid * 1024u;
    const int aoff = lds_byte(wr * 64 + fr, fq * 8), boff = lds_byte(wc * 32 + fr, fq * 8);
#define PG8_SA(b, h) (((b) * 2 + (h)) * HTB)
#define PG8_SB(b, h) ((4 + (b) * 2 + (h)) * HTB)
#define PG8_STAGE(bufoff, gbase, voff) do { _Pragma("unroll") for (int _i = 0; _i < 2; ++_i) { unsigned _keep; \
        asm volatile("s_mov_b32 %0, m0\n\ts_mov_b32 m0, %3\n\ts_nop 0\n\tglobal_load_lds_dwordx4 %1, %2\n\ts_mov_b32 m0, %0" : "=&s"(_keep) : "v"((voff)[_i]), "s"((const void*)(gbase)), "s"((unsigned)(lds_u + (unsigned)(bufoff) + ldsw + _i * 8192)) : "memory"); } } while (0)
#define PG8_LDA(dst, b, h) do { _Pragma("unroll") for (int m = 0; m < 4; ++m) _Pragma("unroll") for (int k = 0; k < 2; ++k) dst[m][k] = *(const PG8_LAS bf16x8*)(lds + PG8_SA(b, h) + aoff + m * 2048 + k * 1024); } while (0)
#define PG8_LDB(dst, b, h) do { _Pragma("unroll") for (int n = 0; n < 2; ++n) _Pragma("unroll") for (int k = 0; k < 2; ++k) dst[n][k] = *(const PG8_LAS bf16x8*)(lds + PG8_SB(b, h) + boff + n * 2048 + k * 1024); } while (0)
#define PG8_MMA(ai, bj, At, Bt) do { __builtin_amdgcn_s_setprio(1); _Pragma("unroll") for (int m = 0; m < 4; ++m) _Pragma("unroll") for (int n = 0; n < 2; ++n) _Pragma("unroll") for (int k = 0; k < 2; ++k) \
        acc[ai][bj][m][n] = __builtin_amdgcn_mfma_f32_16x16x32_bf16(Bt[n][k], At[m][k], acc[ai][bj][m][n], 0, 0, 0); __builtin_amdgcn_s_setprio(0); } while (0)
#define PG8_WAIT_V(n) asm volatile("s_waitcnt vmcnt(" #n ")" ::: "memory")
#define PG8_WAIT_L(n) asm volatile("s_waitcnt lgkmcnt(" #n ")" ::: "memory")
#define PG8_BAR __builtin_amdgcn_s_barrier()
#define PG8_SCHED __builtin_amdgcn_sched_barrier(0)
#ifdef GPROBE
#define GP_BEGIN(k) unsigned long long gp_t0_##k = 0; if (GPROBE == (k) && Epi::ID == GPROBE_ID) gp_t0_##k = __builtin_amdgcn_s_memrealtime();
#define GP_END(k) do { if (GPROBE == (k) && Epi::ID == GPROBE_ID && wid == 0) { const unsigned long long d_ = __builtin_amdgcn_s_memrealtime() - gp_t0_##k; if (lane == 0) *(volatile PG8_LAS unsigned long long*)(lds + 163840 - 32) += d_; } } while (0)
#else
#define GP_BEGIN(k)
#define GP_END(k) do { } while (0)
#endif
    Unit cur, nxt; int ui = 0;
    if (!S.next(0, cur)) return;
    f32x4 acc[2][2][4][2];
#pragma unroll
    for (int a = 0; a < 2; ++a)
#pragma unroll
        for (int b = 0; b < 2; ++b)
#pragma unroll
            for (int m = 0; m < 4; ++m)
#pragma unroll
                for (int n = 0; n < 2; ++n) acc[a][b][m][n] = (f32x4){0.f, 0.f, 0.f, 0.f};
    bf16x8 At[4][2], B0[2][2], B1[2][2];
    float pre[8];
#pragma unroll
    for (int i = 0; i < 8; ++i) pre[i] = 0.f;
    const char* cA = (const char*)g.A + (size_t)cur.pm * tstep; const char* cB = (const char*)g.Bt + (size_t)cur.pn * tstep;
    S.a_ready(cur);
    PG8_STAGE(PG8_SB(0, 0), cB, voffB); PG8_STAGE(PG8_SA(0, 0), cA, voffA); PG8_STAGE(PG8_SB(0, 1), cB + hstep, voffB); PG8_STAGE(PG8_SA(0, 1), cA + hstep, voffA);
    if (wr == 1) PG8_BAR;
    PG8_WAIT_V(4); PG8_BAR;
    PG8_STAGE(PG8_SB(1, 0), cB + kstep, voffB); PG8_STAGE(PG8_SA(1, 0), cA + kstep, voffA); PG8_STAGE(PG8_SB(1, 1), cB + hstep + kstep, voffB);
    PG8_WAIT_V(6); PG8_BAR;
    PG8_STAMP();
    for (;;) {
        const bool has_next = S.next(ui + 1, nxt);
        const char* nA = has_next ? (const char*)g.A + (size_t)nxt.pm * tstep : cA; const char* nB = has_next ? (const char*)g.Bt + (size_t)nxt.pn * tstep : cB;
        GP_BEGIN(4)
        for (int t = 0; t < nt; t += 2) {
            const bool last = (t == nt - 2);
            GP_BEGIN(2) GP_BEGIN(3)
            const char* a1 = cA + (size_t)(t + 1) * kstep;
            const char* a2 = last ? nA : cA + (size_t)(t + 2) * kstep; const char* b2 = last ? nB : cB + (size_t)(t + 2) * kstep;
            const char* a3 = a2 + kstep; const char* b3 = b2 + kstep;
            if (last && has_next) S.a_ready(nxt);
            if constexpr (Epi::PRE) { if (last) { const float* ps = E.pre_src(cur, wr);
#pragma unroll
                for (int _i = 0; _i < 2; ++_i) { unsigned _keep;
                    asm volatile("s_mov_b32 %0, m0\n\ts_mov_b32 m0, %3\n\ts_nop 0\n\tglobal_load_lds_dword %1, %2\n\ts_mov_b32 m0, %0" : "=&s"(_keep) : "v"((unsigned)(lane * 4)), "s"((const void*)(ps + _i * HALF)), "s"((unsigned)(lds_u + 8u * HTB + (unsigned)wid * 512u + _i * 256u)) : "memory"); } } }
            PG8_LDB(B0, 0, 0); PG8_SCHED; PG8_LDA(At, 0, 0); PG8_STAGE(PG8_SA(1, 1), a1 + hstep, voffA);
            PG8_WAIT_L(8); PG8_BAR; PG8_WAIT_L(0); PG8_MMA(0, 0, At, B0); PG8_BAR; PG8_SCHED;
            PG8_LDB(B1, 0, 1); PG8_STAGE(PG8_SB(0, 0), b2, voffB);
            PG8_BAR; PG8_WAIT_L(0); PG8_MMA(0, 1, At, B1); PG8_BAR;
            PG8_LDA(At, 0, 1); PG8_STAGE(PG8_SA(0, 0), a2, voffA);
            PG8_BAR; PG8_WAIT_L(0); PG8_MMA(1, 0, At, B0); PG8_BAR; PG8_SCHED;
            PG8_STAGE(PG8_SB(0, 1), b2 + hstep, voffB);
            PG8_WAIT_V(6); PG8_BAR; PG8_MMA(1, 1, At, B1); PG8_BAR;
            PG8_LDB(B0, 1, 0); PG8_SCHED; PG8_LDA(At, 1, 0); PG8_STAGE(PG8_SA(0, 1), a2 + hstep, voffA);
            PG8_WAIT_L(8); PG8_BAR; PG8_WAIT_L(0); PG8_MMA(0, 0, At, B0); PG8_BAR; PG8_SCHED;
            PG8_LDB(B1, 1, 1); PG8_STAGE(PG8_SB(1, 0), b3, voffB);
            PG8_BAR; PG8_WAIT_L(0); PG8_MMA(0, 1, At, B1); PG8_BAR;
            PG8_LDA(At, 1, 1); PG8_STAGE(PG8_SA(1, 0), a3, voffA);
            PG8_BAR; PG8_WAIT_L(0); PG8_MMA(1, 0, At, B0); PG8_BAR; PG8_SCHED;
            PG8_STAGE(PG8_SB(1, 1), b3 + hstep, voffB);
            PG8_WAIT_V(6); PG8_BAR; PG8_MMA(1, 1, At, B1); PG8_BAR;
            if (t == 0 && ui > 0) GP_END(2); if (t == 4 && ui > 0) GP_END(3);
        }
        GP_END(4);
        PG8_STAMP();
        GP_BEGIN(1)
        if constexpr (!Epi::AFTER_DRAIN) { if constexpr (Epi::PRE) {
#pragma unroll
                for (int i = 0; i < 8; ++i) pre[i] = *(const PG8_LAS float*)(lds + 8 * HTB + wid * 512 + (i >> 2) * 256 + ((i & 3) * 16 + fr) * 4); }
            E(acc, cur, wr, wc, fr, fq, pre); S.done(cur); }
        GP_END(1);
#ifdef GPROBE
        { GP_BEGIN(5) if (GPROBE == 5 && Epi::ID == GPROBE_ID) PG8_WAIT_V(0); GP_END(5); }
#endif
        PG8_STAMP();
        if (!has_next) break;
#pragma unroll
        for (int a = 0; a < 2; ++a)
#pragma unroll
            for (int b = 0; b < 2; ++b)
#pragma unroll
                for (int m = 0; m < 4; ++m)
#pragma unroll
                    for (int n = 0; n < 2; ++n) acc[a][b][m][n] = (f32x4){0.f, 0.f, 0.f, 0.f};
        cur = nxt; cA = nA; cB = nB; ++ui;
    }
    PG8_WAIT_V(0);
    if (wr == 0) PG8_BAR;
    PG8_BAR;
    if constexpr (Epi::AFTER_DRAIN) { E.fused(acc, cur, wr, wc, fr, fq, lds, wid, lane); S.done(cur); }
    PG8_STAMP();
    if (STAMP && wid == 0) { stamps[lane] = lane < nts ? (((unsigned long long)(unsigned)ts_hi << 32) | (unsigned)ts_lo) : 0ull;
        if (lane == 62) stamps[62] = rt_entry; if (lane == 63) stamps[63] = (unsigned long long)wall_clock64(); }
#undef PG8_STAMP
#undef PG8_SA
#undef PG8_SB
#undef PG8_STAGE
#undef PG8_LDA
#undef PG8_LDB
#undef PG8_MMA
#undef PG8_WAIT_V
#undef PG8_WAIT_L
#undef PG8_BAR
#undef PG8_SCHED
}
}
namespace fk {
using pg8::bf16_t;
typedef float f32x4 __attribute__((ext_vector_type(4)));
typedef unsigned u32x4 __attribute__((ext_vector_type(4)));
typedef unsigned u32x2 __attribute__((ext_vector_type(2)));
typedef short bf16x8 __attribute__((ext_vector_type(8)));
#ifndef FK_MR
#define FK_MR 32768
#endif
constexpr int D = 1024, S = 8192, MR = FK_MR, NBT = MR / S, NPROJ = 4608, NPAD = 4864, MIXW = 1536, MEMT = 256, INC = 4632;
#ifndef FK_REVQ
#define FK_REVQ 0
#endif
constexpr int NTHR = 512, LDS_BYTES = 163840, LDS_BAR = LDS_BYTES - 16, LDS_TP = LDS_BYTES - 32;

constexpr size_t OFF_CTL = 0, OFF_SSQ = 65536, SSQ_BYTES = (size_t)32768 * 4, ZERO_BYTES = OFF_SSQ + 5 * SSQ_BYTES;
constexpr size_t OFF_LB = ZERO_BYTES, OFF_WIN = OFF_LB + 4096, SZ_WIN = (size_t)NPAD * D * 2, OFF_WOUT = OFF_WIN + 2 * SZ_WIN, SZ_WOUT = (size_t)D * MIXW * 2;
constexpr size_t SZ_SQ = (size_t)D * D * 2, OFF_WQ = OFF_WOUT + 2 * SZ_WOUT, OFF_WO = OFF_WQ + 2 * SZ_SQ, OFF_WK = OFF_WO + 2 * SZ_SQ, OFF_WV = OFF_WK + 2 * SZ_SQ;
constexpr size_t OFF_MEMN = OFF_WV + 2 * SZ_SQ, OFF_KM = OFF_MEMN + 2 * SZ_SQ, OFF_VT = OFF_KM + 2 * SZ_SQ;
constexpr size_t OFF_XB = OFF_VT + 2 * SZ_SQ, SZ_XB = (size_t)MR * D * 2, OFF_PROJ = OFF_XB + SZ_XB, SZ_PROJ = (size_t)MR * NPROJ * 2;
constexpr size_t OFF_EXT = OFF_PROJ + SZ_PROJ, SZ_EXT = (size_t)MR * 32 * 4, OFF_MIX = OFF_EXT + SZ_EXT, SZ_MIX = (size_t)MR * MIXW * 2, WS_END = OFF_MIX + SZ_MIX;
constexpr size_t OFF_Q = OFF_PROJ, OFF_O = OFF_PROJ + SZ_XB;
static_assert(WS_END <= (size_t)536870912, "workspace");
static_assert(2 * SZ_XB <= SZ_PROJ, "q/o overlay");

#define XB_TMO      128
#define XB_XCNT(j)  (256  + 64 * (j))
#define XB_XSUB(j)  (1280 + 64 * (j))
#define XB_XGEN(j)  (2304 + 64 * (j))
#define XB_TOP      3328
#define XB_TOPGEN   3392
#define XCD_BAR_WORDS 3456
#define XB_SPIN_CAP (1u << 18)
#define LAS __attribute__((address_space(3)))

__device__ __forceinline__ unsigned xb_ld(unsigned* p)              { return __hip_atomic_load(p, __ATOMIC_RELAXED, __HIP_MEMORY_SCOPE_AGENT); }
__device__ __forceinline__ unsigned xb_add(unsigned* p, unsigned v) { return __hip_atomic_fetch_add(p, v, __ATOMIC_RELAXED, __HIP_MEMORY_SCOPE_AGENT); }
__device__ __forceinline__ unsigned xb_xcc_id() { return (unsigned)__builtin_amdgcn_s_getreg((3 << 11) | 20) & 0xFu; }
#define XB_SPIN(cond, bar) do { unsigned _sp = 0; while (cond) { __builtin_amdgcn_s_sleep(1); \
    if ((++_sp & 255u) == 0u) { if (xb_ld(&(bar)[XB_TMO])) break; if (_sp > XB_SPIN_CAP) { atomicAdd(&(bar)[XB_TMO], 1u); break; } } } } while (0)

__device__ __forceinline__ int xb_lane() { int l_; asm volatile("v_mbcnt_lo_u32_b32 %0, -1, 0\n\tv_mbcnt_hi_u32_b32 %0, -1, %0" : "=v"(l_)); return l_; }
struct XcdBarrier {
    unsigned* bar; unsigned x;
    volatile LAS unsigned* st;
};

__device__ __forceinline__ XcdBarrier xcd_barrier_post(unsigned* bar, volatile LAS unsigned* st, int wv) {
    XcdBarrier b; b.bar = bar; b.x = xb_xcc_id(); b.st = st;
    if (wv == 0 && xb_lane() == 0) (void)xb_add(&bar[XB_XCNT(b.x)], 1u);
    return b;
}
__device__ __forceinline__ void xcd_barrier_complete(unsigned* bar, unsigned x, unsigned& nloc, unsigned& nx) {
    const unsigned G = gridDim.x * gridDim.y * gridDim.z;
    unsigned sum, cnt, mine, sp = 0u;
    for (;;) {
        sum = 0u; cnt = 0u; mine = 0u;
#pragma unroll
        for (unsigned j = 0; j < 16; ++j) { const unsigned c = xb_ld(&bar[XB_XCNT(j)]); sum += c; cnt += (c > 0u) ? 1u : 0u; mine = (j == x) ? c : mine; }
        if (sum == G) break;
        __builtin_amdgcn_s_sleep(1);
        if ((++sp & 255u) == 0u) { if (xb_ld(&bar[XB_TMO])) break; if (sp > XB_SPIN_CAP) { atomicAdd(&bar[XB_TMO], 1u); break; } }
    }
    nloc = mine > 0u ? mine : 1u; nx = cnt > 0u ? cnt : 1u;
}

__device__ __forceinline__ void xcd_barrier(const XcdBarrier& b, int wv) {
    asm volatile("s_waitcnt vmcnt(0)" ::: "memory");
    __syncthreads();
    if (wv == 0 && xb_lane() == 0) {
        unsigned* bar = b.bar;
        __builtin_amdgcn_s_waitcnt(0);
        unsigned nloc = b.st[0], nx = b.st[1];
        if (nloc == 0u) { xcd_barrier_complete(bar, b.x, nloc, nx); b.st[0] = nloc; b.st[1] = nx; }
        const unsigned old = xb_add(&bar[XB_XSUB(b.x)], 1u);
        const unsigned gen = old / nloc;
        if (old + 1u == (gen + 1u) * nloc) {
            __builtin_amdgcn_fence(__ATOMIC_RELEASE, "agent");
            asm volatile("s_waitcnt vmcnt(0)" ::: "memory");
            const unsigned og = xb_add(&bar[XB_TOP], 1u);
            const unsigned tg = og / nx;
            if (og + 1u == (tg + 1u) * nx) xb_add(&bar[XB_TOPGEN], 1u);
            else XB_SPIN(xb_ld(&bar[XB_TOPGEN]) == tg, bar);
            __builtin_amdgcn_fence(__ATOMIC_ACQUIRE, "agent");
            xb_add(&bar[XB_XGEN(b.x)], 1u);
            asm volatile("s_waitcnt vmcnt(0)" ::: "memory");
        } else {
            XB_SPIN(xb_ld(&bar[XB_XGEN(b.x)]) == gen, bar);
            __builtin_amdgcn_fence(__ATOMIC_ACQUIRE, "agent");
            asm volatile("s_waitcnt vmcnt(0)" ::: "memory");
        }
    }
    __syncthreads();
}

#define GB_CNT(g)  (4096 + 64 * (g))
#define GB_MASK(g) (4608 + 64 * (g))
__device__ __forceinline__ void grp_census_post(const XcdBarrier& b, int g, int wv) { if (wv == 0 && xb_lane() == 0) (void)__hip_atomic_fetch_or(&b.bar[GB_MASK(g)], 1u << b.x, __ATOMIC_RELAXED, __HIP_MEMORY_SCOPE_AGENT); }
__device__ __forceinline__ void grp_census_read(const XcdBarrier& b, int g, int wv) {
    if (wv == 0 && xb_lane() == 0) { const unsigned m = xb_ld(&b.bar[GB_MASK(g)]); b.st[2] = (m != 0u && (m & (m - 1u)) == 0u) ? 1u : 0u;
#ifdef FK_FORCE_NONLOCAL
        b.st[2] = 0u;
#endif
    } }
__device__ __forceinline__ void grp_barrier(const XcdBarrier& b, int g, unsigned ng, int wv) {
    asm volatile("s_waitcnt vmcnt(0)" ::: "memory");
    __syncthreads();
    if (wv == 0 && xb_lane() == 0) {
        unsigned* bar = b.bar;
        __builtin_amdgcn_s_waitcnt(0);
        if (b.st[2] == 0u) { __builtin_amdgcn_fence(__ATOMIC_RELEASE, "agent"); asm volatile("s_waitcnt vmcnt(0)" ::: "memory"); }
        const unsigned old = xb_add(&bar[GB_CNT(g)], 1u);
        const unsigned tgt = (old / ng + 1u) * ng;
        XB_SPIN(xb_ld(&bar[GB_CNT(g)]) < tgt, bar);
        __builtin_amdgcn_fence(__ATOMIC_ACQUIRE, "agent");
        asm volatile("s_waitcnt vmcnt(0)" ::: "memory");
    }
    __syncthreads();
}
__device__ __forceinline__ int fk_lane() { int l_; asm volatile("v_mbcnt_lo_u32_b32 %0, -1, 0\n\tv_mbcnt_hi_u32_b32 %0, -1, %0" : "=v"(l_)); return l_; }

struct Args { const float* in[26]; float* out; unsigned char* ws; int ph_lo, ph_hi; };

__device__ __forceinline__ unsigned short bf16r(float f) { unsigned u = __float_as_uint(f); u += 0x7fffu + ((u >> 16) & 1u); return (unsigned short)(u >> 16); }
__device__ __forceinline__ float bf2f(unsigned short b) { return __uint_as_float(((unsigned)b) << 16); }
__device__ __forceinline__ float wsum(float v, int lane) {
#pragma unroll
    for (int o = 32; o >= 1; o >>= 1) v += __builtin_bit_cast(float, __builtin_amdgcn_ds_bpermute((lane ^ o) << 2, __builtin_bit_cast(int, v)));
    return v; }

__device__ __forceinline__ int win_src(int np) { return np < 3072 ? np : np < 4608 ? np + 16 : np < 4624 ? np - 4608 + 3072 : np < 4632 ? np : -1; }
__device__ __forceinline__ void p0_transpose(LAS float* tile, const float* W, int K, int N, bf16_t* WT, int NT, int mode, const float* gain, float scale, int& tbase, int wg, int nwg, int wv) {
    const int tk = K / 128, ntile = tk * (NT / 64);
    float vn[16];
    auto load_tile = [&](int t) { const int tl = wv * 64 + fk_lane(); const int c = tl & 63, k0 = (t % tk) * 128, n0 = (t / tk) * 64, np = n0 + c, src = mode ? win_src(np) : (np < N ? np : -1);
#pragma unroll
        for (int i = 0; i < 16; ++i) { const int r = (tl >> 6) + 8 * i; vn[i] = (src >= 0) ? W[(size_t)(k0 + r) * N + src] * (gain ? gain[k0 + r] : 1.0f) * scale : 0.f; } };
    const int tfirst = ((wg - tbase) % nwg + nwg) % nwg;
    if (tfirst < ntile) load_tile(tfirst);
    for (int t = tfirst; t < ntile; t += nwg) {
        const int tl = wv * 64 + fk_lane();
        const int c = tl & 63, k0 = (t % tk) * 128, n0 = (t / tk) * 64;
        asm volatile("s_waitcnt lgkmcnt(0)" ::: "memory"); __builtin_amdgcn_s_barrier(); asm volatile("" ::: "memory");
#pragma unroll
        for (int i = 0; i < 16; ++i) tile[((tl >> 6) + 8 * i) * 65 + c] = vn[i];
        if (t + nwg < ntile) load_tile(t + nwg);
        asm volatile("s_waitcnt lgkmcnt(0)" ::: "memory"); __builtin_amdgcn_s_barrier(); asm volatile("" ::: "memory");
#pragma unroll
        for (int i = 0; i < 2; ++i) { const int item = tl + i * NTHR, rn = item >> 4, kc = item & 15;
            float v[8];
#pragma unroll
            for (int j = 0; j < 8; ++j) v[j] = tile[(kc * 8 + j) * 65 + rn];
            u32x4 w; w.x = pg8::cvt_pk_bf16(v[0], v[1]); w.y = pg8::cvt_pk_bf16(v[2], v[3]); w.z = pg8::cvt_pk_bf16(v[4], v[5]); w.w = pg8::cvt_pk_bf16(v[6], v[7]);
            *(u32x4*)(WT + (size_t)(n0 + rn) * K + k0 + kc * 8) = w; }
    }
    tbase = (tbase + ntile) % nwg;
}

__device__ __forceinline__ void p0_weights(const Args& a, LAS unsigned char* lds, int l, int sub, int nsub, int wv) {
    unsigned char* ws = a.ws; LAS float* tile = (LAS float*)lds; int tbase = 0;
    p0_transpose(tile, a.in[3] + (size_t)l * D * INC, D, INC, (bf16_t*)(ws + OFF_WIN + l * SZ_WIN), NPAD, 1, a.in[2] + l * D, 1.0f, tbase, sub, nsub, wv);
    p0_transpose(tile, a.in[18] + (size_t)l * MIXW * D, MIXW, D, (bf16_t*)(ws + OFF_WOUT + l * SZ_WOUT), D, 0, nullptr, 1.0f, tbase, sub, nsub, wv);
    p0_transpose(tile, a.in[21] + (size_t)l * D * D, D, D, (bf16_t*)(ws + OFF_WQ + l * SZ_SQ), D, 0, a.in[19] + l * D, 0.0625f * 1.4426950408889634f, tbase, sub, nsub, wv);
    p0_transpose(tile, a.in[22] + (size_t)l * D * D, D, D, (bf16_t*)(ws + OFF_WK + l * SZ_SQ), D, 0, nullptr, 1.0f, tbase, sub, nsub, wv);
    p0_transpose(tile, a.in[23] + (size_t)l * D * D, D, D, (bf16_t*)(ws + OFF_WV + l * SZ_SQ), D, 0, nullptr, 1.0f, tbase, sub, nsub, wv);
    p0_transpose(tile, a.in[24] + (size_t)l * D * D, D, D, (bf16_t*)(ws + OFF_WO + l * SZ_SQ), D, 0, nullptr, 1.0f, tbase, sub, nsub, wv);
    asm volatile("s_waitcnt vmcnt(0) lgkmcnt(0)" ::: "memory"); __builtin_amdgcn_s_barrier(); asm volatile("" ::: "memory");
}

__device__ __forceinline__ void p0_prologue(const Args& a, LAS unsigned char* lds, int wv) {
    int tid_ = wv * 64 + fk_lane(); asm volatile("" : "+v"(tid_)); const int tid = tid_, lane = tid & 63, wave = tid >> 6, wg = blockIdx.x, nwg = gridDim.x;
    unsigned char* ws = a.ws;
    p0_weights(a, lds, 0, wg, nwg, wv);
    { const float* x = a.in[0]; bf16_t* xb = (bf16_t*)(ws + OFF_XB); float* ssq0 = (float*)(ws + OFF_SSQ);
      for (int row = (wg * 8 + wave) * 4; row < MR; row += nwg * 8 * 4) { f32x4 v[4][4];
#pragma unroll
          for (int r = 0; r < 4; ++r)
#pragma unroll
              for (int i = 0; i < 4; ++i) v[r][i] = *(const f32x4*)(x + (size_t)(row + r) * D + i * 256 + lane * 4);
#pragma unroll
          for (int r = 0; r < 4; ++r) { float ss = 0.f;
#pragma unroll
              for (int i = 0; i < 4; ++i) { const f32x4 t = v[r][i]; ss += (t[0] * t[0] + t[1] * t[1]) + (t[2] * t[2] + t[3] * t[3]);
                  u32x2 w; w.x = pg8::cvt_pk_bf16(t[0], t[1]); w.y = pg8::cvt_pk_bf16(t[2], t[3]); *(u32x2*)(xb + (size_t)(row + r) * D + i * 256 + lane * 4) = w; }
              ss = wsum(ss, lane); if (lane == 0) ssq0[row + r] = ss; } } }
    { const float* mem = a.in[1];
      for (int it = wg * 8 + wave; it < 2 * 4 * MEMT; it += nwg * 8) { const int l = it >> 10, row = it & 1023; const float* g = a.in[20] + l * D; bf16_t* o = (bf16_t*)(ws + OFF_MEMN + l * SZ_SQ) + (size_t)row * D;
          f32x4 v[4]; float ss = 0.f;
#pragma unroll
          for (int i = 0; i < 4; ++i) { v[i] = *(const f32x4*)(mem + (size_t)row * D + i * 256 + lane * 4); ss += (v[i][0] * v[i][0] + v[i][1] * v[i][1]) + (v[i][2] * v[i][2] + v[i][3] * v[i][3]); }
          ss = wsum(ss, lane); const float rs = rsqrtf(ss * (1.0f / 1024.0f) + 1e-6f);
#pragma unroll
          for (int i = 0; i < 4; ++i) { const f32x4 gg = *(const f32x4*)(g + i * 256 + lane * 4); const f32x4 y = v[i] * rs * gg;
              u32x2 w; w.x = pg8::cvt_pk_bf16(y[0], y[1]); w.y = pg8::cvt_pk_bf16(y[2], y[3]); *(u32x2*)(o + i * 256 + lane * 4) = w; } } }
    if (wg == 0) { float* lb = (float*)(ws + OFF_LB); const float* lg = a.in[4];
        const float x0 = lg[tid], x1 = lg[512 + tid], mx = fmaxf(x0, x1), e0 = expf(x0 - mx), e1 = expf(x1 - mx); lb[tid] = 0.f; lb[512 + tid] = e1 / (e0 + e1); }
}
typedef float f32x16a __attribute__((ext_vector_type(16)));
__device__ __forceinline__ float bpx(float x, int mask, int lane) { return __builtin_bit_cast(float, __builtin_amdgcn_ds_bpermute((lane ^ mask) << 2, __builtin_bit_cast(int, x))); }
__device__ __forceinline__ void aglds16(const void* gsrc, unsigned lds_dst) { unsigned keep;
    asm volatile("s_mov_b32 %0, m0\n\ts_mov_b32 m0, %2\n\ts_nop 0\n\tglobal_load_lds_dwordx4 %1, off\n\ts_mov_b32 m0, %0" : "=&s"(keep) : "v"(gsrc), "s"(lds_dst) : "memory"); }
__device__ __forceinline__ void attn_dma_k(unsigned slot, const bf16_t* Kbh, int half, int wave, int lane) {
    asm volatile("" : "+v"(lane));
#pragma unroll
    for (int i = 0; i < 8; ++i) { const int p = i * 8 + wave, row = 2 * p + (lane >> 5), lc = (lane & 31) ^ (row & 15);
        aglds16((const void*)(Kbh + (size_t)(half * 128 + row) * 1024 + lc * 8), (unsigned)__builtin_amdgcn_readfirstlane((int)(slot + p * 1024))); } }
__device__ __forceinline__ void attn_dma_v(unsigned slot, const bf16_t* Vbh, int half, int wave, int lane) {
    asm volatile("" : "+v"(lane));
#pragma unroll
    for (int i = 0; i < 8; ++i) { const int p = i * 8 + wave, row = 4 * p + (lane >> 4), lc = (lane & 15) ^ (row & 15);
        aglds16((const void*)(Vbh + (size_t)row * 1024 + half * 128 + lc * 8), (unsigned)__builtin_amdgcn_readfirstlane((int)(slot + p * 1024))); } }
#ifdef ATP
#define AT_BEGIN(k) unsigned long long at_t0_##k = 0; if (ATP == (k)) at_t0_##k = __builtin_amdgcn_s_memrealtime();
#define AT_END(k) do { if (ATP == (k) && wave == 0) { const unsigned long long d_ = __builtin_amdgcn_s_memrealtime() - at_t0_##k; if (lane == 0) *(volatile LAS unsigned long long*)(lds + LDS_TP) += d_; } } while (0)
#else
#define AT_BEGIN(k)
#define AT_END(k) do { } while (0)
#endif
#define ATT_BAR() do { asm volatile("" ::: "memory"); __builtin_amdgcn_s_barrier(); asm volatile("" ::: "memory"); } while (0)
__device__ __forceinline__ void attn_phase(LAS unsigned char* lds, const bf16_t* q, const bf16_t* Km, const bf16_t* Vt, bf16_t* o, const pg8::StaticOrder& So, int wv) {
    int tid_ = wv * 64 + fk_lane(); asm volatile("" : "+v"(tid_));
    const int tid = tid_, lane0 = tid & 63, wave = wv;
    constexpr int RT = S / 256;
    const unsigned slot0 = (unsigned)(size_t)lds, slot1 = slot0 + 65536u;
    LAS unsigned char* ost = lds + 131072 + wave * 2048;
    pg8::Unit cu, nu; int ui = 0;
    bool have = So.next(0, cu);
    if (have) { const int h = cu.pn, b = cu.pm / RT; const bf16_t* Kbh = Km + (size_t)(b * 256) * 1024 + h * 256; attn_dma_k(slot0, Kbh, 0, wave, lane0); attn_dma_k(slot1, Kbh, 1, wave, lane0); }
    bf16x8 qf[16];
    if (have) { const int h = cu.pn; const size_t qrow = (size_t)cu.pm * 256 + wave * 32 + (lane0 & 31);
#pragma unroll
        for (int ks = 0; ks < 16; ++ks) qf[ks] = *(const bf16x8*)(q + qrow * 1024 + h * 256 + ks * 16 + (lane0 >> 5) * 8); }
    for (; have; ++ui) {
        int lane = lane0; asm volatile("" : "+v"(lane)); const int n = lane & 31, hh = lane >> 5;
        const int rt = cu.pm % RT, h = cu.pn, b = cu.pm / RT;
        const bool has_next = So.next(ui + 1, nu);
        const bf16_t* Vbh = Vt + (size_t)(h * 256) * 1024 + b * 256;
        AT_BEGIN(1)
        if (ui != 0) asm volatile("s_waitcnt vmcnt(16) lgkmcnt(0)" ::: "memory"); else asm volatile("s_waitcnt vmcnt(0) lgkmcnt(0)" ::: "memory");
        ATT_BAR();
        AT_END(1);
        AT_BEGIN(2)
        f32x16a sacc[8];
#pragma unroll
        for (int half = 0; half < 2; ++half) {
            LAS unsigned char* ks_ = lds + half * 65536;
#pragma unroll
            for (int kt = 0; kt < 4; ++kt) { f32x16a a;
#pragma unroll
                for (int r = 0; r < 16; ++r) a[r] = 0.f;
                const int key = kt * 32 + n;
#pragma unroll
                for (int k0 = 0; k0 < 16; k0 += 4) { bf16x8 kf[4];
#pragma unroll
                    for (int ks = 0; ks < 4; ++ks) kf[ks] = *(const LAS bf16x8*)(ks_ + key * 512 + (((2 * (k0 + ks) + hh) ^ (key & 15)) * 16));
#pragma unroll
                    for (int ks = 0; ks < 4; ++ks) a = __builtin_amdgcn_mfma_f32_32x32x16_bf16(kf[ks], qf[k0 + ks], a, 0, 0, 0); }
                sacc[half * 4 + kt] = a; }
            asm volatile("s_waitcnt lgkmcnt(0)" ::: "memory"); ATT_BAR();
            attn_dma_v(half ? slot1 : slot0, Vbh, half, wave, lane);
        }
        AT_END(2);
        AT_BEGIN(3)
        float mx = -3.0e38f;
#pragma unroll
        for (int t = 0; t < 8; ++t)
#pragma unroll
            for (int r = 0; r < 16; ++r) mx = fmaxf(mx, sacc[t][r]);
        mx = fmaxf(mx, bpx(mx, 32, lane));
        float sum = 0.f; bf16x8 pf[16];
#pragma unroll
        for (int t = 0; t < 8; ++t) {
#pragma unroll
            for (int r = 0; r < 16; ++r) { const float p = __builtin_amdgcn_exp2f(sacc[t][r] - mx); sacc[t][r] = p; sum += p; }
#pragma unroll
            for (int s = 0; s < 2; ++s) { u32x4 w; w.x = pg8::cvt_pk_bf16(sacc[t][8 * s], sacc[t][8 * s + 1]); w.y = pg8::cvt_pk_bf16(sacc[t][8 * s + 2], sacc[t][8 * s + 3]);
                w.z = pg8::cvt_pk_bf16(sacc[t][8 * s + 4], sacc[t][8 * s + 5]); w.w = pg8::cvt_pk_bf16(sacc[t][8 * s + 6], sacc[t][8 * s + 7]); pf[2 * t + s] = __builtin_bit_cast(bf16x8, w); } }
        sum += bpx(sum, 32, lane);
        const float inv = 1.0f / sum;
        AT_END(3);
        AT_BEGIN(4)
        f32x16a oacc[8];
#pragma unroll
        for (int dt = 0; dt < 8; ++dt)
#pragma unroll
            for (int r = 0; r < 16; ++r) oacc[dt][r] = 0.f;
        if (!has_next) nu = cu;
        const bf16_t* Kn = Km + (size_t)((nu.pm / RT) * 256) * 1024 + nu.pn * 256;
#pragma unroll
        for (int half = 0; half < 2; ++half) {
            if (half == 0 || has_next) asm volatile("s_waitcnt vmcnt(8)" ::: "memory"); else asm volatile("s_waitcnt vmcnt(0)" ::: "memory");
            ATT_BAR();
            LAS unsigned char* vs_ = lds + half * 65536;
#pragma unroll
            for (int dt = 0; dt < 8; ++dt) { const int dv = dt * 32 + n;
#pragma unroll
                for (int s0 = 0; s0 < 8; s0 += 4) { bf16x8 vf[4];
#pragma unroll
                    for (int s8 = 0; s8 < 4; ++s8) vf[s8] = *(const LAS bf16x8*)(vs_ + dv * 256 + (((2 * (s0 + s8) + hh) ^ (dv & 15)) * 16));
#pragma unroll
                    for (int s8 = 0; s8 < 4; ++s8) oacc[dt] = __builtin_amdgcn_mfma_f32_32x32x16_bf16(vf[s8], pf[half * 8 + s0 + s8], oacc[dt], 0, 0, 0); } }
            asm volatile("s_waitcnt lgkmcnt(0)" ::: "memory"); ATT_BAR();
            if (has_next) attn_dma_k(half ? slot1 : slot0, Kn, half, wave, lane);
        }
        { const int hq = nu.pn; const size_t qrow = (size_t)nu.pm * 256 + wave * 32 + n;
#pragma unroll
          for (int ks = 0; ks < 16; ++ks) qf[ks] = *(const bf16x8*)(q + qrow * 1024 + hq * 256 + ks * 16 + hh * 8); }
        AT_END(4);
        AT_BEGIN(5)
        bf16_t* obase = o + ((size_t)b * S + rt * 256 + wave * 32) * 1024 + h * 256;
#pragma unroll
        for (int dt = 0; dt < 8; ++dt) {
#pragma unroll
            for (int rg = 0; rg < 4; ++rg) { const f32x16a& oa = oacc[dt]; u32x2 w; w.x = pg8::cvt_pk_bf16(oa[4 * rg] * inv, oa[4 * rg + 1] * inv); w.y = pg8::cvt_pk_bf16(oa[4 * rg + 2] * inv, oa[4 * rg + 3] * inv);
                *(LAS u32x2*)(ost + n * 64 + (8 * rg + 4 * hh) * 2) = w; }
            asm volatile("s_waitcnt lgkmcnt(0)" ::: "memory");
            { const int row = lane >> 1, hf = lane & 1; const u32x4 t0 = *(const LAS u32x4*)(ost + row * 64 + hf * 32), t1 = *(const LAS u32x4*)(ost + row * 64 + hf * 32 + 16);
              bf16_t* dst = obase + (size_t)row * 1024 + dt * 32 + hf * 16; *(u32x4*)dst = t0; *(u32x4*)(dst + 8) = t1; }
            asm volatile("s_waitcnt lgkmcnt(0)" ::: "memory");
        }
        AT_END(5);
        cu = nu; have = has_next;
    }
    asm volatile("s_waitcnt vmcnt(0) lgkmcnt(0)" ::: "memory"); ATT_BAR();
}
constexpr int SEGC = 8, SEGT = 512, NSEG = S / SEGT, NBH = NBT * 4;
constexpr int P_AQ = 0, P_AF = 512, P_AI = 1024, P_AZ = 1536, P_GQ = 2048, P_GK = 2304, P_GV = 2560, P_GZ = 3072, P_MU = 3584, P_MZ = 4096;
constexpr int USZ = 16384 + 256;
constexpr int L_Q0 = 0, L_KM = 16384, L_QM = 32768, L_RF = 49152, L_ST = 65536, L_V0 = 98304, L_V1 = 114688, L_CV = 132096, L_CST = 148480;
constexpr int C_G = 0, C_SKIP = 512, C_ADEC = 1024, C_NVEC = 1536  , C_DINT = 2560, C_DPART = 2816, C_C1 = 3328, C_W = 3840  , C_HALO = 12544  , C_NINC = 14592  ;
typedef float f32x16 __attribute__((ext_vector_type(16)));
typedef short s16x4 __attribute__((ext_vector_type(4)));

__device__ __forceinline__ unsigned off_b(unsigned row, unsigned ch) { return 256u * row + 16u * (ch ^ (((row & 3u) << 2) | ((row >> 2) & 3u))); }
__device__ __forceinline__ unsigned rr_addr(unsigned lane, unsigned rowbase, unsigned s) { return off_b(rowbase + (lane & 31u), 2u * s + (lane >> 5)); }
__device__ __forceinline__ unsigned tr_addr(unsigned lane, unsigned c, unsigned ks, unsigned t) { const unsigned h = lane >> 5, blk = (lane >> 4) & 1u, q = (lane & 15u) >> 2, p = lane & 3u; return off_b(16u * ks + 8u * h + 4u * t + q, 4u * c + 2u * blk + (p >> 1)) + 8u * (p & 1u); }
__device__ __forceinline__ bf16x8 ld_frag(LAS unsigned char* p) { return *(const LAS bf16x8*)p; }
__device__ __forceinline__ bf16x8 tr_frag(LAS unsigned char* img, unsigned lane, unsigned c, unsigned ks) {
    const s16x4 lo = __builtin_bit_cast(s16x4, __builtin_amdgcn_ds_read_tr16_b64_v4i16((LAS s16x4*)(img + tr_addr(lane, c, ks, 0))));
    const s16x4 hi = __builtin_bit_cast(s16x4, __builtin_amdgcn_ds_read_tr16_b64_v4i16((LAS s16x4*)(img + tr_addr(lane, c, ks, 1))));
    return (bf16x8){lo[0], lo[1], lo[2], lo[3], hi[0], hi[1], hi[2], hi[3]}; }
__device__ __forceinline__ bf16x8 tr_fragb(LAS unsigned char* img, const unsigned (&tb)[2], unsigned ks) {
    const s16x4 lo = __builtin_bit_cast(s16x4, __builtin_amdgcn_ds_read_tr16_b64_v4i16((LAS s16x4*)(img + tb[0] + 4096u * ks)));
    const s16x4 hi = __builtin_bit_cast(s16x4, __builtin_amdgcn_ds_read_tr16_b64_v4i16((LAS s16x4*)(img + tb[1] + 4096u * ks)));
    return (bf16x8){lo[0], lo[1], lo[2], lo[3], hi[0], hi[1], hi[2], hi[3]}; }
__device__ __forceinline__ void glds16(const void* gsrc, unsigned lds_dst) { unsigned keep;
    asm volatile("s_mov_b32 %0, m0\n\ts_mov_b32 m0, %2\n\ts_nop 0\n\tglobal_load_lds_dwordx4 %1, off\n\ts_mov_b32 m0, %0" : "=&s"(keep) : "v"(gsrc), "s"(lds_dst) : "memory"); }
__device__ __forceinline__ void dma_tile(LAS unsigned char* img, const bf16_t* src, size_t pitch, int npieces, int wave, int lane) {
    const unsigned base = (unsigned)(size_t)img; asm volatile("" : "+v"(lane));
    for (int p = wave; p < npieces; p += 8) { const int row = p * 4 + (lane >> 4), lc = (lane & 15) ^ (((row & 3) << 2) | ((row >> 2) & 3));
        glds16((const void*)(src + (ptrdiff_t)row * (ptrdiff_t)pitch + lc * 8), (unsigned)__builtin_amdgcn_readfirstlane((int)(base + p * 1024))); } }
template <int CTRL, int RM> __device__ __forceinline__ float dpp1(float x) { return __builtin_bit_cast(float, __builtin_amdgcn_update_dpp(0x3f800000, __builtin_bit_cast(int, x), CTRL, RM, 0xF, false)); }
template <int CTRL, int RM> __device__ __forceinline__ float dpp0(float x) { return __builtin_bit_cast(float, __builtin_amdgcn_update_dpp(0, __builtin_bit_cast(int, x), CTRL, RM, 0xF, true)); }
__device__ __forceinline__ float wave_scan(float v, int lane) {
    (void)lane;
    v += dpp0<0x111, 0xF>(v); v += dpp0<0x112, 0xF>(v); v += dpp0<0x114, 0xF>(v); v += dpp0<0x118, 0xF>(v);
    v += dpp0<0x142, 0xA>(v); v += dpp0<0x143, 0xC>(v);
    return v; }
__device__ __forceinline__ float shx(float x, int mask, int lane) { return __builtin_bit_cast(float, __builtin_amdgcn_ds_bpermute((lane ^ mask) << 2, __builtin_bit_cast(int, x))); }
__device__ __forceinline__ float sum8(float v) { v += dpp0<0xB1, 0xF>(v); v += dpp0<0x4E, 0xF>(v); v += dpp0<0x141, 0xF>(v); return v; }
__device__ __forceinline__ float rdlane(float x, int l) { return __builtin_bit_cast(float, __builtin_amdgcn_readlane(__builtin_bit_cast(int, x), l)); }
__device__ __forceinline__ float ex2(float x) { return __builtin_amdgcn_exp2f(x); }
__device__ __forceinline__ float h2f(unsigned short h) { return (float)__builtin_bit_cast(_Float16, h); }
__device__ __forceinline__ u32x4 pack8(const float (&v)[8]) { u32x4 w; w.x = pg8::cvt_pk_bf16(v[0], v[1]); w.y = pg8::cvt_pk_bf16(v[2], v[3]); w.z = pg8::cvt_pk_bf16(v[4], v[5]); w.w = pg8::cvt_pk_bf16(v[6], v[7]); return w; }
__device__ __forceinline__ float log2sig(float x) { return (fminf(x, 0.f) - __logf(1.0f + __expf(-fabsf(x)))) * 1.4426950408889634f; }

struct MixArgs {
    const bf16_t* proj; const float* ext; bf16_t* mix; float* U;
    const float *hgrn_norm, *gla_up, *gla_bias, *gla_norm, *conv_w, *conv_b, *wq, *wk, *wv, *ig_bias, *fg_bias, *skip, *mnorm;
};

struct Fac { float E0, Km, a63; };
__device__ __forceinline__ Fac factors(float b, float kboost, int lane) {
    (void)lane; Fac f; f.E0 = ex2(fmaxf(b, -120.f)); f.Km = __builtin_amdgcn_rcpf(f.E0) * ex2(kboost); f.a63 = rdlane(f.E0, 63); return f; }
__device__ __forceinline__ f32x16 mfma32(bf16x8 a, bf16x8 b, f32x16 c) { return __builtin_amdgcn_mfma_f32_32x32x16_bf16(a, b, c, 0, 0, 0); }

#ifdef TPROBE
#ifndef TP_PASS
#define TP_PASS 1
#endif
#define TP_BEGIN(k) unsigned long long tp_t0_##k = 0; if (TPROBE == (k) && PASS == TP_PASS) tp_t0_##k = __builtin_amdgcn_s_memrealtime();
#define TP_END(k) do { if (TPROBE == (k) && PASS == TP_PASS && wave == 0) { const unsigned long long d_ = __builtin_amdgcn_s_memrealtime() - tp_t0_##k; if (lane == 0) *(volatile LAS unsigned long long*)(lds + LDS_TP) += d_; } } while (0)
#else
#define TP_BEGIN(k)
#define TP_END(k) do { } while (0)
#endif
#define FK_BAR() do { asm volatile("" ::: "memory"); __builtin_amdgcn_s_barrier(); asm volatile("" ::: "memory"); } while (0)
template <int MIXER, int PASS>
__device__ __forceinline__ void mix_unit(LAS unsigned char* lds, const MixArgs& A, int bh, int seg, int wv) {
    constexpr int DK = (MIXER == 1) ? 64 : 128, NKS = DK / 16, NG = DK / 64;
    constexpr int NT = (DK == 128) ? 2 : 1;
    constexpr int LEAD = (PASS == 0 && MIXER != 2) ? 2 : 1;
    int tid_ = wv * 64 + fk_lane(); asm volatile("" : "+v"(tid_));
    const int tid = tid_, lane = tid & 63, wave = wv;
    TP_BEGIN(6)
    const int b = bh >> 2, h = bh & 3;
    const size_t row0 = (size_t)b * S + (size_t)seg * SEGT;
    LAS float* cst = (LAS float*)(lds + L_CST);
    LAS float* c_g = cst + C_G / 4; LAS float* c_skip = cst + C_SKIP / 4; LAS float* c_adec = cst + C_ADEC / 4; LAS float* c_c1 = cst + C_C1 / 4; LAS float* c_nbuf = cst + C_NVEC / 4; LAS float* c_w = cst + C_W / 4; LAS float* c_dint = cst + C_DINT / 4; LAS float* c_dpart = cst + C_DPART / 4; LAS float* c_ninc = cst + C_NINC / 4;
    float* slot = A.U + (size_t)((MIXER * NBH + bh) * NSEG + seg) * USZ;
    const int td = (DK == 128) ? (wave >> 1) : (wave >> 2), te0 = (DK == 128) ? (wave & 1) * 2 : (wave & 3);
    const int ti = wave >> 2, te = wave & 3;
    const int cq = MIXER == 0 ? P_AQ + h * 128 : MIXER == 1 ? P_GQ + h * 64 : P_MU + h * 128;
    const int ck = MIXER == 0 ? P_AF + h * 128 : P_GK + h * 64;
    const int cv = MIXER == 0 ? P_AI + h * 128 : P_GV + h * 128;
    const int cz = MIXER == 0 ? P_AZ + h * 128 : MIXER == 1 ? P_GZ + h * 128 : P_MZ + h * 128;
    const bf16_t* pr = A.proj + row0 * NPROJ;
    auto fbuf = [&](int cn) -> LAS unsigned char* { if (PASS == 1) return lds + L_RF; const int r = cn % 3; return lds + (r == 0 ? L_RF : r == 1 ? L_Q0 : L_QM); };
    auto vbuf = [&](int cn) -> LAS unsigned char* { if (MIXER == 2) return lds + L_V0; if (PASS == 1) return lds + ((cn & 1) ? L_V1 : L_V0); const int r = cn % 3; return lds + (r == 0 ? L_V0 : r == 1 ? L_V1 : L_ST); };
    auto ubuf = [&](int cn) -> LAS unsigned char* { return lds + ((cn & 1) ? L_RF : L_V1); };
    auto hbuf = [&](int cn) -> LAS unsigned char* { return lds + L_CST + C_HALO + (cn & 1) * 1024; };
    auto cix = [&](int cn) -> int { return PASS == 0 ? SEGC - 1 - cn : cn; };
    auto issue_dma = [&](int cn) {
        const bf16_t* prn = pr + (size_t)cix(cn) * 64 * NPROJ;
        if (MIXER == 2) { dma_tile(ubuf(cn), prn + cq, NPROJ, 16, wave, lane); dma_tile(hbuf(cn), prn + cq - 4 * (ptrdiff_t)NPROJ, NPROJ, 1, wave, lane); }
        else { if (PASS == 1) dma_tile(lds + L_CV, prn + cq, NPROJ, 16, wave, lane); dma_tile(fbuf(cn), prn + ck, NPROJ, 16, wave, lane); dma_tile(vbuf(cn), prn + cv, NPROJ, 16, wave, lane); } };
    issue_dma(0);
    if (LEAD == 2) issue_dma(1);
    if (tid < 128) { c_g[tid] = MIXER == 0 ? A.hgrn_norm[tid] : MIXER == 1 ? A.gla_norm[tid] : A.mnorm[h * 128 + tid]; c_skip[tid] = MIXER == 2 ? A.skip[h * 128 + tid] : 0.f; c_nbuf[tid] = (MIXER == 2 && PASS == 1) ? slot[16384 + 128 + tid] : 0.f; }
    if (MIXER == 2) { const int i = tid; c_w[i] = A.wq[h * 512 + i]; c_w[512 + i] = A.wk[h * 512 + i]; c_w[1024 + i] = A.wv[h * 512 + i]; c_w[1536 + i] = A.conv_w[(i >> 7) * 512 + h * 128 + (i & 127)]; if (tid < 128) c_w[2048 + tid] = A.conv_b[h * 128 + tid]; }
    if (MIXER == 1) { for (int i = tid; i < 1024; i += NTHR) c_w[i] = A.gla_up[(i >> 6) * 256 + h * 64 + (i & 63)]; if (tid < 64) c_w[1024 + tid] = A.gla_bias[h * 64 + tid]; }
    f32x16 st[NT];
#pragma unroll
    for (int s = 0; s < NT; ++s)
#pragma unroll
        for (int r = 0; r < 16; ++r) st[s][r] = (PASS == 1) ? slot[((wave * NT + s) * 16 + r) * 64 + lane] : 0.f;
    float carry[NG * 8];
#pragma unroll
    for (int i = 0; i < NG * 8; ++i) carry[i] = 0.f;
    float carry_s = 0.f;
    f32x16 nacc;
#pragma unroll
    for (int r = 0; r < 16; ++r) nacc[r] = 0.f;
    u32x4 zraw[2]; f32x4 gv[4], gvn[4]; float emi = 0.f, emf = 0.f;
    zraw[0] = zraw[1] = (u32x4){0u, 0u, 0u, 0u};
#pragma unroll
    for (int i = 0; i < 4; ++i) { gv[i] = (f32x4){0.f, 0.f, 0.f, 0.f}; gvn[i] = gv[i]; }
    auto prefetch = [&](int cn, bool first) {
        const float* er = A.ext + (row0 + (size_t)cix(cn) * 64 + lane) * 32;
        if (MIXER == 1) {
#pragma unroll
            for (int i = 0; i < 4; ++i) { const f32x4 t4 = *(const f32x4*)(er + 4 * i); if (first) gv[i] = t4; else gvn[i] = t4; } }
        if (MIXER == 2) { emi = er[16 + h]; emf = er[20 + h]; } };
    prefetch(0, true);
    if (PASS == 1) {
#pragma unroll
        for (int s = 0; s < NT; ++s) { const int e = 32 * (te0 + s) + (lane & 31);
#pragma unroll
            for (int rg = 0; rg < 4; ++rg) { const int d0 = 32 * td + 8 * rg + 4 * (lane >> 5);
                u32x2 w; w.x = pg8::cvt_pk_bf16(st[s][4 * rg], st[s][4 * rg + 1]); w.y = pg8::cvt_pk_bf16(st[s][4 * rg + 2], st[s][4 * rg + 3]);
                *(LAS u32x2*)(lds + L_ST + off_b(e, d0 >> 3) + (d0 & 7) * 2) = w; } } }

    TP_END(6);
#pragma unroll 1
    for (int c = 0; c < SEGC; ++c) {
        TP_BEGIN(1)
        const int t0 = seg * SEGT + cix(c) * 64;
        LAS unsigned char* Vimg = vbuf(c);
        if (PASS == 1) { if (c > 0) asm volatile("s_waitcnt vmcnt(2) lgkmcnt(0)" ::: "memory"); else asm volatile("s_waitcnt vmcnt(0) lgkmcnt(0)" ::: "memory"); }
        else if (LEAD == 2) { if (c + 1 < SEGC) asm volatile("s_waitcnt vmcnt(4) lgkmcnt(0)" ::: "memory"); else asm volatile("s_waitcnt vmcnt(0) lgkmcnt(0)" ::: "memory"); }
        else asm volatile("s_waitcnt vmcnt(0) lgkmcnt(0)" ::: "memory");
        FK_BAR();
        TP_END(1);
        TP_BEGIN(2)
        if (PASS == 1) { int lz = lane; asm volatile("" : "+v"(lz)); const int tz = wave * 64 + lz; const bf16_t* zp = pr + (size_t)(c * 64 + (tz >> 3)) * NPROJ + cz + (tz & 7) * 16; zraw[0] = *(const u32x4*)zp; zraw[1] = *(const u32x4*)(zp + 8); }
        if (c > 0) {
            if (MIXER == 1) {
#pragma unroll
                for (int i = 0; i < 4; ++i) { gv[i] = gvn[i]; asm volatile("" : "+v"(gv[i])); } } }
        if (MIXER == 2 && c + 1 < SEGC) issue_dma(c + 1);
        Fac fsc; fsc.E0 = fsc.Km = fsc.a63 = 0.f;
        if (MIXER == 2) {
            const float mi = emi + A.ig_bias[h], mf = emf + A.fg_bias[h];
            const float bs = wave_scan(log2sig(mf), lane);
            if (PASS == 0) { const float r63 = rdlane(bs, 63); fsc.E0 = 0.f; fsc.Km = ex2(r63 - bs + carry_s + mi * 1.4426950408889634f); fsc.a63 = 0.f; carry_s += r63; }
            else fsc = factors(bs, mi * 1.4426950408889634f, lane); }
        bf16x8 rawq[NG], rawk[NG];
        if (MIXER != 2) {
            if (PASS == 0) { if (MIXER == 1 && c + 1 < SEGC) prefetch(c + 1, false); if (c + LEAD < SEGC) issue_dma(c + LEAD); }
#pragma unroll
            for (int g = 0; g < NG; ++g) { rawk[g] = ld_frag(fbuf(c) + off_b(lane, wave + 8 * g)); rawq[g] = rawk[g]; if (PASS == 1) rawq[g] = ld_frag(lds + L_CV + off_b(lane, wave + 8 * g)); }
            if (PASS == 1) {
                asm volatile("s_waitcnt lgkmcnt(0)" ::: "memory"); FK_BAR();
                if (MIXER == 1 && c + 1 < SEGC) prefetch(c + 1, false);
                if (c + LEAD < SEGC) issue_dma(c + LEAD); }
        }
#ifndef REP_S0
#define REP_S0 1
#endif
#ifndef REP_S0M
#define REP_S0M 0
#endif
        _Pragma("unroll 1") for (int rep0 = 0; rep0 < ((PASS == 1 && MIXER == REP_S0M) ? REP_S0 : 1); ++rep0)
#pragma unroll
        for (int g = 0; g < NG; ++g) { const int cc = wave + 8 * g; float q8[8], k8[8], gl8[8], v8[8], ca8[8];
            if (MIXER == 0) {
#pragma unroll
                for (int j = 0; j < 8; ++j) { gl8[j] = h2f((unsigned short)rawk[g][j]); q8[j] = bf2f((unsigned short)rawq[g][j]); v8[j] = 0.f; ca8[j] = 0.f; }
#pragma unroll
                for (int j = 0; j < 8; ++j) k8[j] = 1.0f - ex2(gl8[j]);
            } else if (MIXER == 1) {
                f32x4 sg0 = *(const LAS f32x4*)(c_w + 1024 + cc * 8), sg1 = *(const LAS f32x4*)(c_w + 1024 + cc * 8 + 4);
#pragma unroll
                for (int i = 0; i < 16; ++i) { const f32x4 w0 = *(const LAS f32x4*)(c_w + i * 64 + cc * 8), w1 = *(const LAS f32x4*)(c_w + i * 64 + cc * 8 + 4); const float gi = gv[i >> 2][i & 3];
                    sg0 += gi * w0; sg1 += gi * w1; }
#pragma unroll
                for (int j = 0; j < 8; ++j) { const float sj = j < 4 ? sg0[j & 3] : sg1[j & 3]; gl8[j] = log2sig(sj) * 0.0625f; q8[j] = bf2f((unsigned short)rawq[g][j]); k8[j] = bf2f((unsigned short)rawk[g][j]); v8[j] = 0.f; ca8[j] = 0.f; }
            } else {
                f32x4 u4[4][2];
#pragma unroll
                for (int k = 0; k < 4; ++k) { const int rr = lane - k; const bf16x8 ru = ld_frag(rr >= 0 ? ubuf(c) + off_b(rr, cc) : hbuf(c) + off_b(4 + rr, cc));
#pragma unroll
                    for (int j = 0; j < 8; ++j) u4[k][j >> 2][j & 3] = bf2f((unsigned short)ru[j]);
                    if (t0 == 0 && rr < 0) { u4[k][0] = (f32x4){0.f, 0.f, 0.f, 0.f}; u4[k][1] = u4[k][0]; } }
                f32x4 ac0 = *(const LAS f32x4*)(c_w + 2048 + cc * 8), ac1 = *(const LAS f32x4*)(c_w + 2048 + cc * 8 + 4);
#pragma unroll
                for (int tap = 0; tap < 4; ++tap) { const f32x4 w0 = *(const LAS f32x4*)(c_w + 1536 + tap * 128 + cc * 8), w1 = *(const LAS f32x4*)(c_w + 1536 + tap * 128 + cc * 8 + 4);
                    ac0 += u4[3 - tap][0] * w0; ac1 += u4[3 - tap][1] * w1; }
#pragma unroll
                for (int j = 0; j < 8; ++j) { const float aj = j < 4 ? ac0[j & 3] : ac1[j & 3]; ca8[j] = aj * pg8::fsigm(aj); }
                f32x4 qv4[2], kv4[2], vv4[2];
#pragma unroll
                for (int hg = 0; hg < 2; ++hg) { qv4[hg] = (f32x4){0.f, 0.f, 0.f, 0.f}; kv4[hg] = qv4[hg]; vv4[hg] = qv4[hg]; }
#pragma unroll
                for (int i = 0; i < 4; ++i)
#pragma unroll
                    for (int hg = 0; hg < 2; ++hg) { const f32x4 wq4 = *(const LAS f32x4*)(c_w + (cc * 2 + hg) * 16 + i * 4), wk4 = *(const LAS f32x4*)(c_w + 512 + (cc * 2 + hg) * 16 + i * 4), wv4 = *(const LAS f32x4*)(c_w + 1024 + (cc * 2 + hg) * 16 + i * 4);
                        qv4[hg] += ca8[hg * 4 + i] * wq4; kv4[hg] += ca8[hg * 4 + i] * wk4; vv4[hg] += u4[0][hg][i] * wv4; }
#pragma unroll
                for (int j = 0; j < 8; ++j) { q8[j] = qv4[j >> 2][j & 3]; k8[j] = kv4[j >> 2][j & 3] * 0.08838834764831845f; v8[j] = vv4[j >> 2][j & 3]; gl8[j] = 0.f; }
            }
            float E0[8], Km[8], a63[8];
            if (MIXER != 2) {
                float bb[8];
#pragma unroll
                for (int j = 0; j < 8; ++j) bb[j] = gl8[j];
#pragma unroll
                for (int j = 0; j < 8; ++j) bb[j] += dpp0<0x111, 0xF>(bb[j]);
#pragma unroll
                for (int j = 0; j < 8; ++j) bb[j] += dpp0<0x112, 0xF>(bb[j]);
#pragma unroll
                for (int j = 0; j < 8; ++j) bb[j] += dpp0<0x114, 0xF>(bb[j]);
#pragma unroll
                for (int j = 0; j < 8; ++j) bb[j] += dpp0<0x118, 0xF>(bb[j]);
#pragma unroll
                for (int j = 0; j < 8; ++j) bb[j] += dpp0<0x142, 0xA>(bb[j]);
#pragma unroll
                for (int j = 0; j < 8; ++j) bb[j] += dpp0<0x143, 0xC>(bb[j]);
                if (PASS == 0) {
#pragma unroll
                    for (int j = 0; j < 8; ++j) { const float r63 = rdlane(bb[j], 63); Km[j] = ex2(r63 - bb[j] + carry[g * 8 + j]); carry[g * 8 + j] += r63; E0[j] = 0.f; a63[j] = 0.f; }
                } else {
#pragma unroll
                    for (int j = 0; j < 8; ++j) { E0[j] = ex2(fmaxf(bb[j], -120.f)); Km[j] = __builtin_amdgcn_rcpf(E0[j]); }
#pragma unroll
                    for (int j = 0; j < 8; ++j) a63[j] = rdlane(E0[j], 63);
                }
            }
            float o0[8], o2[8];
#pragma unroll
            for (int j = 0; j < 8; ++j) { if (MIXER == 2) { o0[j] = q8[j] * fsc.E0; o2[j] = k8[j] * fsc.Km; }
                else { o0[j] = q8[j] * E0[j]; o2[j] = k8[j] * Km[j]; } }
            if (PASS == 1 && lane == 63) {
                if (MIXER == 2) { const f32x4 a4 = (f32x4){fsc.a63, fsc.a63, fsc.a63, fsc.a63}; *(LAS f32x4*)(c_adec + cc * 8) = a4; *(LAS f32x4*)(c_adec + cc * 8 + 4) = a4; }
                else { *(LAS f32x4*)(c_adec + cc * 8) = (f32x4){a63[0], a63[1], a63[2], a63[3]}; *(LAS f32x4*)(c_adec + cc * 8 + 4) = (f32x4){a63[4], a63[5], a63[6], a63[7]}; } }
            *(LAS u32x4*)(lds + L_KM + off_b(lane, cc)) = pack8(o2);
            if (PASS == 1) *(LAS u32x4*)(lds + L_Q0 + off_b(lane, cc)) = pack8(o0);
            if (MIXER == 2) { *(LAS u32x4*)(lds + L_V0 + off_b(lane, cc)) = pack8(v8); if (PASS == 1) *(LAS u32x4*)(lds + L_CV + off_b(lane, cc)) = pack8(ca8); }
            asm volatile("" ::: "memory");
        }
        asm volatile("s_waitcnt lgkmcnt(0)" ::: "memory"); FK_BAR();
        TP_END(2);
        TP_BEGIN(3)
        if (c + 1 < SEGC && MIXER == 2) prefetch(c + 1, false);
        unsigned rrb[8], trE[2], trD[2], trS[NT][2];
        { int lb = lane; asm volatile("" : "+v"(lb));
#pragma unroll
          for (int s = 0; s < 8; ++s) rrb[s] = rr_addr((unsigned)lb, 0u, (unsigned)s);
#pragma unroll
          for (int t = 0; t < 2; ++t) { trE[t] = tr_addr((unsigned)lb, (unsigned)te, 0u, (unsigned)t); trD[t] = tr_addr((unsigned)lb, (unsigned)td, 0u, (unsigned)t);
#pragma unroll
              for (int s = 0; s < NT; ++s) trS[s][t] = tr_addr((unsigned)lb, (unsigned)(te0 + s), 0u, (unsigned)t); } }
        f32x16 oacc, pacc;
#pragma unroll
        for (int r = 0; r < 16; ++r) { oacc[r] = 0.f; pacc[r] = 0.f; }
        if (PASS == 1) {
            int ln1 = lane; asm volatile("" : "+v"(ln1));
#pragma unroll
            for (int s0 = 0; s0 < NKS; s0 += 4) { bf16x8 fa[4], fb[4];
#pragma unroll
              for (int s = 0; s < 4; ++s) { fa[s] = ld_frag(lds + L_Q0 + 8192 * ti + rrb[s0 + s]); fb[s] = ld_frag(lds + L_ST + 8192 * te + rrb[s0 + s]); }
#pragma unroll
              for (int s = 0; s < 4; ++s) oacc = mfma32(fa[s], fb[s], oacc); }
            if (MIXER == 2) {
                const int tid1 = wave * 64 + ln1, row = tid1 >> 3, sg = tid1 & 7; float dsum = 0.f;
#pragma unroll
                for (int hh = 0; hh < 2; ++hh) { const bf16x8 qf = ld_frag(lds + L_Q0 + off_b(row, 2 * sg + hh));
#pragma unroll
                    for (int j = 0; j < 8; ++j) dsum += bf2f((unsigned short)qf[j]) * c_nbuf[(c & 1) * 128 + sg * 16 + hh * 8 + j]; }
                dsum = sum8(dsum);
                if (sg == 0) c_dint[row] = dsum; }
            const int jb = (wave == 1) ? 1 : 0, ib = (wave == 0) ? 0 : 1;
            if (wave < 3) {
#pragma unroll
                for (int s0 = 0; s0 < NKS; s0 += 4) { bf16x8 fa[4], fb[4];
#pragma unroll
                  for (int s = 0; s < 4; ++s) { fa[s] = ld_frag(lds + L_KM + 8192 * jb + rrb[s0 + s]); fb[s] = ld_frag(lds + L_Q0 + 8192 * ib + rrb[s0 + s]); }
#pragma unroll
                  for (int s = 0; s < 4; ++s) pacc = mfma32(fa[s], fb[s], pacc); }
                if (wave < 2) {
#pragma unroll
                    for (int r = 0; r < 16; ++r) { const int jj = (r & 3) + 8 * (r >> 2) + 4 * (ln1 >> 5); if (jj > (ln1 & 31)) pacc[r] = 0.f; } }
                if (MIXER == 2) { float ps = 0.f;
#pragma unroll
                    for (int r = 0; r < 16; ++r) ps += pacc[r];
                    ps += shx(ps, 32, ln1); if (ln1 < 32) c_dpart[wave * 32 + ln1] = ps; } }
            if (wave < 3) {
                int lnp = lane; asm volatile("" : "+v"(lnp));
#pragma unroll
                for (int rg = 0; rg < 4; ++rg) { u32x2 w; w.x = pg8::cvt_pk_bf16(pacc[4 * rg], pacc[4 * rg + 1]); w.y = pg8::cvt_pk_bf16(pacc[4 * rg + 2], pacc[4 * rg + 3]);
                    *(LAS u32x2*)(lds + L_QM + off_b(32 * ib + (lnp & 31), 4 * jb + rg) + 8 * (lnp >> 5)) = w; } }
            asm volatile("s_waitcnt lgkmcnt(0)" ::: "memory"); FK_BAR();
            TP_END(3);
            int ln2 = lane; asm volatile("" : "+v"(ln2));
            { bf16x8 fa[2], fb[2];
#pragma unroll
              for (int s = 0; s < 2; ++s) { fa[s] = ld_frag(lds + L_QM + 8192 * ti + rrb[s]); fb[s] = tr_fragb(Vimg, trE, s); }
#pragma unroll
              for (int s = 0; s < 2; ++s) oacc = mfma32(fa[s], fb[s], oacc);
              if (ti == 1) {
#pragma unroll
                  for (int s = 0; s < 2; ++s) { fa[s] = ld_frag(lds + L_QM + 8192 + rrb[2 + s]); fb[s] = tr_fragb(Vimg, trE, 2 + s); }
#pragma unroll
                  for (int s = 0; s < 2; ++s) oacc = mfma32(fa[s], fb[s], oacc); } }
        }
        TP_BEGIN(4)
        if (PASS == 0) {
            int ln4 = lane; asm volatile("" : "+v"(ln4));
            const short one_or_zero = ((ln4 & 31) == 0) ? (short)0x3f80 : (short)0;
            const bf16x8 onesB = (bf16x8){one_or_zero, one_or_zero, one_or_zero, one_or_zero, one_or_zero, one_or_zero, one_or_zero, one_or_zero};
#pragma unroll
            for (int h4 = 0; h4 < 4; h4 += 2) { bf16x8 fa[2], fb[NT][2];
#pragma unroll
              for (int s4 = 0; s4 < 2; ++s4) { fa[s4] = tr_fragb(lds + L_KM, trD, h4 + s4);
#pragma unroll
                  for (int s = 0; s < NT; ++s) fb[s][s4] = tr_fragb(Vimg, trS[s], h4 + s4); }
#pragma unroll
              for (int s4 = 0; s4 < 2; ++s4) {
#pragma unroll
                  for (int s = 0; s < NT; ++s) st[s] = mfma32(fa[s4], fb[s][s4], st[s]);
                  if (MIXER == 2 && te0 == 0) nacc = mfma32(fa[s4], onesB, nacc); } }
        } else if (c + 1 < SEGC) {
            int ln4 = lane; asm volatile("" : "+v"(ln4));
            f32x16 tmp[NT];
#pragma unroll
            for (int s = 0; s < NT; ++s)
#pragma unroll
                for (int r = 0; r < 16; ++r) tmp[s][r] = 0.f;
#pragma unroll
            for (int h4 = 0; h4 < 4; h4 += 2) { bf16x8 fa[2], fb[NT][2];
#pragma unroll
              for (int s4 = 0; s4 < 2; ++s4) { fa[s4] = tr_fragb(lds + L_KM, trD, h4 + s4);
#pragma unroll
                  for (int s = 0; s < NT; ++s) fb[s][s4] = tr_fragb(Vimg, trS[s], h4 + s4); }
#pragma unroll
              for (int s4 = 0; s4 < 2; ++s4)
#pragma unroll
                  for (int s = 0; s < NT; ++s) tmp[s] = mfma32(fa[s4], fb[s][s4], tmp[s]); }
#pragma unroll
            for (int rg = 0; rg < 4; ++rg) { const f32x4 av = *(const LAS f32x4*)(c_adec + 32 * td + 8 * rg + 4 * (ln4 >> 5));
#pragma unroll
                for (int s = 0; s < NT; ++s)
#pragma unroll
                    for (int q4 = 0; q4 < 4; ++q4) st[s][4 * rg + q4] = (st[s][4 * rg + q4] + tmp[s][4 * rg + q4]) * av[q4]; }
            if (MIXER == 2 && te0 == 0) {
                f32x16 nt;
#pragma unroll
                for (int r = 0; r < 16; ++r) nt[r] = 0.f;
                const short one_or_zero = ((ln4 & 31) == 0) ? (short)0x3f80 : (short)0;
                const bf16x8 onesB = (bf16x8){one_or_zero, one_or_zero, one_or_zero, one_or_zero, one_or_zero, one_or_zero, one_or_zero, one_or_zero};
#pragma unroll
                for (int s4 = 0; s4 < 4; ++s4) nt = mfma32(tr_fragb(lds + L_KM, trD, s4), onesB, nt);
                if ((ln4 & 31) == 0) {
#pragma unroll
                    for (int rg = 0; rg < 4; ++rg) *(LAS f32x4*)(c_ninc + 32 * td + 8 * rg + 4 * (ln4 >> 5)) = (f32x4){nt[4 * rg], nt[4 * rg + 1], nt[4 * rg + 2], nt[4 * rg + 3]}; } }
#pragma unroll
            for (int s = 0; s < NT; ++s) { const int e = 32 * (te0 + s) + (ln4 & 31);
#pragma unroll
                for (int rg = 0; rg < 4; ++rg) { const int d0 = 32 * td + 8 * rg + 4 * (ln4 >> 5);
                    u32x2 w; w.x = pg8::cvt_pk_bf16(st[s][4 * rg], st[s][4 * rg + 1]); w.y = pg8::cvt_pk_bf16(st[s][4 * rg + 2], st[s][4 * rg + 3]);
                    *(LAS u32x2*)(lds + L_ST + off_b(e, d0 >> 3) + (d0 & 7) * 2) = w; } }
        }
        TP_END(4);
        TP_BEGIN(5)
        if (PASS == 1) {
            int ln5 = lane; asm volatile("" : "+v"(ln5));
            asm volatile("s_waitcnt lgkmcnt(0)" ::: "memory"); FK_BAR();
            if (MIXER == 2 && c + 1 < SEGC) { const int t5 = wave * 64 + ln5; if (t5 < 128) c_nbuf[((c + 1) & 1) * 128 + t5] = c_adec[t5] * (c_nbuf[(c & 1) * 128 + t5] + c_ninc[t5]); }
            LAS unsigned char* ob = lds + L_Q0;
#pragma unroll
            for (int r = 0; r < 16; ++r) { const int i = 32 * ti + (r & 3) + 8 * (r >> 2) + 4 * (ln5 >> 5); *(LAS float*)(ob + i * 512 + (32 * te + (ln5 & 31)) * 4) = oacc[r]; }
            asm volatile("s_waitcnt lgkmcnt(0)" ::: "memory"); FK_BAR();
            const int tid5 = wave * 64 + ln5, row = tid5 >> 3, sg = tid5 & 7, e0 = sg * 16; float ov[16], zv[16];
#pragma unroll
            for (int q4 = 0; q4 < 4; ++q4) { const f32x4 t4 = *(const LAS f32x4*)(ob + row * 512 + (e0 + 4 * q4) * 4);
#pragma unroll
                for (int j = 0; j < 4; ++j) ov[4 * q4 + j] = t4[j]; }
#pragma unroll
            for (int hh = 0; hh < 2; ++hh) { const unsigned zz[4] = {zraw[hh].x, zraw[hh].y, zraw[hh].z, zraw[hh].w};
#pragma unroll
                for (int j = 0; j < 4; ++j) { zv[hh * 8 + 2 * j] = __uint_as_float(zz[j] << 16); zv[hh * 8 + 2 * j + 1] = __uint_as_float(zz[j] & 0xffff0000u); } }
            float y[16];
            if (MIXER == 2) {
                const float den = c_dint[row] + (row < 32 ? c_dpart[row] : c_dpart[32 + (row - 32)] + c_dpart[64 + (row - 32)]);
                const float idn = 1.0f / fmaxf(fabsf(den), 1.0f); float sm = 0.f;
#pragma unroll
                for (int j = 0; j < 16; ++j) { ov[j] *= idn; sm += ov[j]; }
                sm = sum8(sm);
                const float mu = sm * (1.0f / 128.0f); float sq = 0.f;
#pragma unroll
                for (int j = 0; j < 16; ++j) { ov[j] -= mu; sq += ov[j] * ov[j]; }
                sq = sum8(sq);
                const float rs = rsqrtf(sq * (1.0f / 128.0f) + 1e-6f);
#pragma unroll
                for (int hh = 0; hh < 2; ++hh) { const bf16x8 cvf = ld_frag(lds + L_CV + off_b(row, 2 * sg + hh));
#pragma unroll
                    for (int j = 0; j < 8; ++j) { const int e = e0 + hh * 8 + j; y[hh * 8 + j] = (ov[hh * 8 + j] * rs * c_g[e] + c_skip[e] * bf2f((unsigned short)cvf[j])) * zv[hh * 8 + j]; } }
            } else {
                float sq = 0.f;
#pragma unroll
                for (int j = 0; j < 16; ++j) sq += ov[j] * ov[j];
                sq = sum8(sq);
                const float rs = rsqrtf(sq * (1.0f / 128.0f) + 1e-6f);
#pragma unroll
                for (int j = 0; j < 16; ++j) y[j] = ov[j] * rs * c_g[e0 + j] * zv[j];
            }
            bf16_t* mo = A.mix + (row0 + (size_t)c * 64 + row) * MIXW + MIXER * 512 + h * 128 + e0;
            u32x4 w0, w1; w0.x = pg8::cvt_pk_bf16(y[0], y[1]); w0.y = pg8::cvt_pk_bf16(y[2], y[3]); w0.z = pg8::cvt_pk_bf16(y[4], y[5]); w0.w = pg8::cvt_pk_bf16(y[6], y[7]);
            w1.x = pg8::cvt_pk_bf16(y[8], y[9]); w1.y = pg8::cvt_pk_bf16(y[10], y[11]); w1.z = pg8::cvt_pk_bf16(y[12], y[13]); w1.w = pg8::cvt_pk_bf16(y[14], y[15]);
            *(u32x4*)mo = w0; *(u32x4*)(mo + 8) = w1;
        }
        TP_END(5);
    }
    if (PASS == 0) {
#pragma unroll
        for (int s = 0; s < NT; ++s)
#pragma unroll
            for (int r = 0; r < 16; ++r) slot[((wave * NT + s) * 16 + r) * 64 + lane] = st[s][r];
        if (lane == 0) {
#pragma unroll
            for (int i = 0; i < NG * 8; ++i) { const int d = (wave + 8 * (i >> 3)) * 8 + (i & 7); slot[16384 + d] = ex2(MIXER == 2 ? carry_s : carry[i]); } }
        if (MIXER == 2 && te0 == 0 && (lane & 31) == 0) {
#pragma unroll
            for (int r = 0; r < 16; ++r) slot[16384 + 128 + 32 * td + (r & 3) + 8 * (r >> 2) + 4 * (lane >> 5)] = nacc[r]; }
    }
    asm volatile("s_waitcnt vmcnt(0) lgkmcnt(0)" ::: "memory"); FK_BAR();
}

__device__ __forceinline__ void mix_combine(float* U, int G, int wg, int wv) {
    int tid_ = wv * 64 + fk_lane(); asm volatile("" : "+v"(tid_)); const int tid = tid_;
    const int nslab = 3 * NBH * 16384, nvec = NBH * 128;
    for (int idx = wg * NTHR + tid; idx < nslab + nvec; idx += G * NTHR) {
        int mixer, bh, e, d; bool isn = false;
        if (idx < nslab) { mixer = idx / (NBH * 16384); const int rem = idx - mixer * (NBH * 16384); bh = rem >> 14; e = rem & 16383;
            if (mixer == 1 && e >= 8192) continue;
            const int ts = e >> 10, r = (e >> 6) & 15, ln = e & 63; const int wv = (mixer == 1) ? ts : (ts >> 1); const int tdd = (mixer == 1) ? (wv >> 2) : (wv >> 1);
            d = 32 * tdd + (r & 3) + 8 * (r >> 2) + 4 * (ln >> 5); }
        else { const int k = idx - nslab; mixer = 2; bh = k >> 7; d = k & 127; e = 16384 + 128 + d; isn = true; }
        (void)isn;
        float* base = U + (size_t)((mixer * NBH + bh) * NSEG) * USZ; float uu[NSEG], aa[NSEG];
#pragma unroll
        for (int sgm = 0; sgm < NSEG; ++sgm) { uu[sgm] = base[(size_t)sgm * USZ + e]; aa[sgm] = base[(size_t)sgm * USZ + 16384 + d]; }
        float carry = 0.f;
#pragma unroll
        for (int sgm = 0; sgm < NSEG; ++sgm) { base[(size_t)sgm * USZ + e] = carry; carry = aa[sgm] * carry + uu[sgm]; }
    }
}
#ifndef REP_INP
#define REP_INP 1
#endif
#ifndef REP_A
#define REP_A 1
#endif
#ifndef REP_B
#define REP_B 1
#endif
#ifndef REP_B0
#define REP_B0 1
#endif
#ifndef REP_B1
#define REP_B1 1
#endif
#ifndef REP_B2
#define REP_B2 1
#endif
#ifndef REP_Q
#define REP_Q 1
#endif
#ifndef REP_ATT
#define REP_ATT 1
#endif
template <class T> __device__ __forceinline__ T* opq(T* p) { auto g = (__attribute__((address_space(1))) T*)p; asm volatile("" : "+s"(g)); return (T*)g; }
__global__ void __launch_bounds__(NTHR, 2) fwd(Args a) {
    extern __shared__ __attribute__((aligned(16))) unsigned char lds_raw[];
    LAS unsigned char* lds = (LAS unsigned char*)lds_raw;
    unsigned char* ws = a.ws;
    const int wv = __builtin_amdgcn_readfirstlane((int)threadIdx.x >> 6);
    if (wv == 0) { const int l0 = fk_lane(); if (l0 < 8) ((LAS unsigned*)(lds + LDS_TP))[l0] = 0u; }
    __syncthreads();
    XcdBarrier bar = xcd_barrier_post((unsigned*)(ws + OFF_CTL), (volatile LAS unsigned*)(lds + LDS_BAR), wv);
    const int lo = a.ph_lo, hi = a.ph_hi, G = gridDim.x, wg = blockIdx.x; (void)lo; (void)hi;
    grp_census_post(bar, wg & 7, wv);
#ifdef FK_PHASE_RANGE
#define IN(k) (lo <= (k) && (k) < hi)
#else
#define IN(k) true
#endif
#ifdef PHPROBE
#define PH_BEGIN(k) unsigned long long ph_t0_##k = 0; if (PHPROBE == (k)) ph_t0_##k = __builtin_amdgcn_s_memrealtime();
#define PH_END(k) do { if (PHPROBE == (k) && wv == 0) { const unsigned long long d_ = __builtin_amdgcn_s_memrealtime() - ph_t0_##k; if (fk_lane() == 0) *(volatile LAS unsigned long long*)(lds + LDS_TP) += d_; } } while (0)
#else
#define PH_BEGIN(k)
#define PH_END(k) do { } while (0)
#endif
#define SEAM(k) do { if (IN(k) && IN((k) + 1)) { PH_BEGIN(100) xcd_barrier(bar, wv); PH_END(100); } } while (0)
#ifdef FK_SKEW_AT
#define SKEW(p) do { if (FK_SKEW_AT == (p) && (((wg & 7) & FK_SKEW_MASK) == FK_SKEW_VAL)) { for (int i_ = 0; i_ < FK_SKEW_N; ++i_) __builtin_amdgcn_s_sleep(127); } } while (0)
#else
#define SKEW(p) do { } while (0)
#endif
#define GSEAM(k) do { if (IN(k) && IN((k) + 1)) { PH_BEGIN(100) if (G == 256) grp_barrier(bar, wg & 7, 32u, wv); else xcd_barrier(bar, wv); PH_END(100); } } while (0)
    float* ssq = (float*)(ws + OFF_SSQ);
    const size_t qoff = (G == 256) ? (size_t)(wg & 7) * ((size_t)4096 * NPROJ * 2 - (size_t)4096 * 2048) : (size_t)0, ooff = (G == 256) ? qoff + (size_t)4096 * 2048 : SZ_XB;
    bf16_t* xb = (bf16_t*)(ws + OFF_XB);

    { PH_BEGIN(0) if (IN(0)) p0_prologue(a, lds, wv); PH_END(0); }
    SEAM(0);
    grp_census_read(bar, wg & 7, wv);
    if (IN(2)) { const int c = wg; int sub = -1, nsub = 96;
        if (G == 256) { if (c >= 144 && !(c >= 160 && c < 176)) sub = c < 160 ? c - 144 : 16 + (c - 176); } else { sub = c; nsub = G; }
        if (sub >= 0) p0_weights(a, lds, 1, sub, nsub, wv); }
#pragma unroll 1
    for (int l = 0; l < 2; ++l) {
        const int pb = 2 + 8 * l;
        if (IN(pb)) {
            { pg8::Gemm g{(const bf16_t*)(opq(ws) + OFF_MEMN + l * SZ_SQ), (const bf16_t*)(opq(ws) + OFF_WK + l * SZ_SQ), 1024, 1024, 1024}; pg8::StaticOrder So; So.init(1024, 1024, G, (wg + G - G / 2) % G);
              pg8::EpiBf16S E{(bf16_t*)(opq(ws) + OFF_KM + l * SZ_SQ), 1024, nullptr}; pg8::gemm_phase<pg8::EpiBf16S, pg8::StaticOrder>(lds, g, So, E, nullptr, wv); }
            { pg8::Gemm g{(const bf16_t*)(opq(ws) + OFF_WV + l * SZ_SQ), (const bf16_t*)(opq(ws) + OFF_MEMN + l * SZ_SQ), 1024, 1024, 1024}; pg8::StaticOrder So; So.init(1024, 1024, G, (wg + G - G / 2 - 32) % G);
              pg8::EpiVt E{(bf16_t*)(opq(ws) + OFF_VT + l * SZ_SQ)}; pg8::gemm_phase<pg8::EpiVt, pg8::StaticOrder>(lds, g, So, E, nullptr, wv); }
        }
        SKEW(5);
#ifdef FK_STAGGER
        if ((wg >> 3) & 1) { for (int i = 0; i < FK_STAGGER; ++i) __builtin_amdgcn_s_sleep(127); }
#endif
        PH_BEGIN(1)
        for (int rep = 0; rep < REP_INP; ++rep) if (IN(pb)) {
            pg8::Gemm g{opq(xb), (const bf16_t*)(opq(ws) + OFF_WIN + l * SZ_WIN), MR, NPAD, D}; pg8::StaticOrder So; So.init(MR, NPAD, G, wg);
            pg8::EpiInProj E{(bf16_t*)(opq(ws) + OFF_PROJ), (float*)(opq(ws) + OFF_EXT), opq(ssq) + (size_t)(2 * l) * 32768, (const float*)(opq(ws) + OFF_LB) + l * 512};
            pg8::gemm_phase<pg8::EpiInProj, pg8::StaticOrder>(lds, g, So, E, nullptr, wv);
        }
        PH_END(1);
        SEAM(pb);
        MixArgs MA{(const bf16_t*)(opq(ws) + OFF_PROJ), (const float*)(opq(ws) + OFF_EXT), (bf16_t*)(opq(ws) + OFF_MIX), opq(a.out)  ,
                   a.in[5] + l * 128, a.in[6] + l * 16 * 256, a.in[7] + l * 256, a.in[8] + l * 128, a.in[9] + l * 4 * 512, a.in[10] + l * 512, a.in[11] + l * 128 * 16, a.in[12] + l * 128 * 16, a.in[13] + l * 128 * 16,
                   a.in[14] + l * 4, a.in[15] + l * 4, a.in[16] + l * 512, a.in[17] + l * 512};
#define MIX_BH(u)  (G == 256 ? ((u) & 7) / 2 * 4 + ((u) >> 6) : (u) / NSEG)
#define MIX_SEG(u) (G == 256 ? ((u) & 1) * 8 + (((u) >> 3) & 7) : (u) % NSEG)
        for (int rep = 0; rep < REP_A; ++rep) {
        PH_BEGIN(2)
        if (IN(pb + 1)) {
            for (int u = wg; u < NBH * NSEG; u += G) mix_unit<0, 0>(lds, MA, MIX_BH(u), MIX_SEG(u), wv);
            for (int u = wg; u < NBH * NSEG; u += G) mix_unit<1, 0>(lds, MA, MIX_BH(u), MIX_SEG(u), wv);
            for (int u = wg; u < NBH * NSEG; u += G) mix_unit<2, 0>(lds, MA, MIX_BH(u), MIX_SEG(u), wv);
        }
        PH_END(2);
        SEAM(pb + 1);
        PH_BEGIN(3)
        if (IN(pb + 2)) mix_combine(MA.U, G, wg, wv);
        PH_END(3);
        SEAM(pb + 2);
        }
        SKEW(1);
        PH_BEGIN(4)
        for (int rep = 0; rep < REP_B; ++rep) if (IN(pb + 3)) {
            for (int r0 = 0; r0 < REP_B0; ++r0) for (int u = wg; u < NBH * NSEG; u += G) mix_unit<0, 1>(lds, MA, MIX_BH(u), MIX_SEG(u), wv);
            for (int r1 = 0; r1 < REP_B1; ++r1) for (int u = wg; u < NBH * NSEG; u += G) mix_unit<1, 1>(lds, MA, MIX_BH(u), MIX_SEG(u), wv);
            for (int r2 = 0; r2 < REP_B2; ++r2) for (int u = wg; u < NBH * NSEG; u += G) mix_unit<2, 1>(lds, MA, MIX_BH(u), MIX_SEG(u), wv);
        }
        PH_END(4);
        GSEAM(pb + 3);
        SKEW(2);
        PH_BEGIN(5)
        if (IN(pb + 4)) {
            pg8::Gemm g{(const bf16_t*)(opq(ws) + OFF_MIX), (const bf16_t*)(opq(ws) + OFF_WOUT + l * SZ_WOUT), MR, D, MIXW}; pg8::StaticOrder So; So.init(MR, D, G, wg);
            pg8::EpiResid E{l == 0 ? opq(a.in[0]) : (const float*)nullptr, opq(xb), opq(ssq) + (size_t)(2 * l + 1) * 32768};
            pg8::gemm_phase<pg8::EpiResid, pg8::StaticOrder>(lds, g, So, E, nullptr, wv);
        }
        PH_END(5);
        GSEAM(pb + 4);
        SKEW(3);
        PH_BEGIN(6)
        for (int rep = 0; rep < REP_Q; ++rep) if (IN(pb + 5)) {
            pg8::Gemm g{opq(xb), (const bf16_t*)(opq(ws) + OFF_WQ + l * SZ_SQ), MR, D, D}; pg8::StaticOrder So; So.init(MR, D, G, wg);
            pg8::EpiBf16S E{(bf16_t*)(opq(ws) + OFF_PROJ + qoff), D, opq(ssq) + (size_t)(2 * l + 1) * 32768};
            pg8::gemm_phase<pg8::EpiBf16S, pg8::StaticOrder>(lds, g, So, E, nullptr, wv);
        }
        PH_END(6);
        PH_BEGIN(7)
        for (int rep = 0; rep < REP_ATT; ++rep) if (IN(pb + 6)) { pg8::StaticOrder So; So.init(MR, D, G, wg);
            attn_phase(lds, (const bf16_t*)(opq(ws) + OFF_PROJ + qoff), (const bf16_t*)(opq(ws) + OFF_KM + l * SZ_SQ), (const bf16_t*)(opq(ws) + OFF_VT + l * SZ_SQ), (bf16_t*)(opq(ws) + OFF_PROJ + ooff), So, wv); }
        PH_END(7);
        GSEAM(pb + 6);
        SKEW(4);
        PH_BEGIN(8)
        if (IN(pb + 7)) {
            pg8::Gemm g{(const bf16_t*)(opq(ws) + OFF_PROJ + ooff), (const bf16_t*)(opq(ws) + OFF_WO + l * SZ_SQ), MR, D, D}; pg8::StaticOrder So; So.init(MR, D, G, wg);
            pg8::EpiResid E{(const float*)nullptr, opq(xb), opq(ssq) + (size_t)(2 * l + 2) * 32768};
            pg8::gemm_phase<pg8::EpiResid, pg8::StaticOrder>(lds, g, So, E, nullptr, wv);
        }
        PH_END(8);
        if (l == 0) { GSEAM(pb + 7);
            if (G == 256 && !(wg & 1)) { if (wv == 0 && fk_lane() == 0) { unsigned* cb = (unsigned*)(ws + OFF_CTL); XB_SPIN(xb_ld(&cb[GB_CNT((wg & 7) + 1)]) < 32u, cb); } __syncthreads(); } }
        else SEAM(pb + 7);
    }
    PH_BEGIN(18)
    if (IN(18)) { const int lane = fk_lane(), wave = wv; const float* gf = a.in[25]; const float* sq = ssq + (size_t)4 * 32768;
        for (int row = wg * 8 + wave; row < MR; row += G * 8) { const float rs = rsqrtf(sq[row] * (1.0f / 1024.0f) + 1e-6f);
#pragma unroll
            for (int i = 0; i < 2; ++i) { const int c0 = i * 512 + lane * 8; const u32x4 o = *(const u32x4*)(xb + (size_t)row * D + c0); const f32x4 g0 = *(const f32x4*)(gf + c0), g1 = *(const f32x4*)(gf + c0 + 4);
                const f32x4 x0 = (f32x4){__uint_as_float(o.x << 16), __uint_as_float(o.x & 0xffff0000u), __uint_as_float(o.y << 16), __uint_as_float(o.y & 0xffff0000u)};
                const f32x4 x1 = (f32x4){__uint_as_float(o.z << 16), __uint_as_float(o.z & 0xffff0000u), __uint_as_float(o.w << 16), __uint_as_float(o.w & 0xffff0000u)};
                float* p = a.out + (size_t)row * D + c0; *(f32x4*)p = x0 * rs * g0; *(f32x4*)(p + 4) = x1 * rs * g1; } } }
    PH_END(18);
#undef IN
#undef SEAM
#ifdef PHMIN
    { if (wv == 0 && fk_lane() == 0) { const unsigned long long acc = *(volatile LAS unsigned long long*)(lds + LDS_TP); atomicMax((unsigned*)(ws + OFF_CTL) + 16000, 0x80000000u - (unsigned)acc); }
      xcd_barrier(bar, wv);
      if (wv == 0 && fk_lane() == 0) { const unsigned m = __hip_atomic_load((unsigned*)(ws + OFF_CTL) + 16000, __ATOMIC_RELAXED, __HIP_MEMORY_SCOPE_AGENT); *(volatile LAS unsigned long long*)(lds + LDS_TP) = (unsigned long long)(0x80000000u - m); }
      __syncthreads(); }
#endif
#if defined(TPROBE) || defined(PHPROBE) || defined(ATP) || defined(GPROBE)
    if (wv == 0) { asm volatile("s_waitcnt vmcnt(0) lgkmcnt(0)" ::: "memory"); const unsigned long long acc = *(volatile LAS unsigned long long*)(lds + LDS_TP), t0 = __builtin_amdgcn_s_memrealtime(); while (__builtin_amdgcn_s_memrealtime() - t0 < acc) __builtin_amdgcn_s_sleep(8); }
#endif
}
}
static int fk_launch(void* const* d_in, void* d_out, void* d_ws, int lo, int hi, hipStream_t stream) {
    static int grid = 0;
    if (grid == 0) {
        int dev = 0, cus = 0, per_cu = 0;
        if (hipGetDevice(&dev) != hipSuccess || hipDeviceGetAttribute(&cus, hipDeviceAttributeMultiprocessorCount, dev) != hipSuccess) { grid = -1; return -1; }
        if (hipFuncSetAttribute((const void*)fk::fwd, hipFuncAttributeMaxDynamicSharedMemorySize, fk::LDS_BYTES) != hipSuccess) { fprintf(stderr, "hipFuncSetAttribute failed\n"); grid = -1; return -1; }
        if (hipOccupancyMaxActiveBlocksPerMultiprocessor(&per_cu, (const void*)fk::fwd, fk::NTHR, fk::LDS_BYTES) != hipSuccess || per_cu < 1) { fprintf(stderr, "occupancy query: %d\n", per_cu); (void)hipGetLastError(); grid = -1; return -1; }
        grid = cus;
    }
    if (grid < 0) return -1;
    (void)hipMemsetAsync(d_ws, 0, fk::ZERO_BYTES, stream);
    fk::Args a{};
    for (int i = 0; i < 26; ++i) a.in[i] = (const float*)d_in[i];
    a.out = (float*)d_out; a.ws = (unsigned char*)d_ws; a.ph_lo = lo; a.ph_hi = hi;
    hipLaunchKernelGGL(fk::fwd, dim3(grid), dim3(fk::NTHR), fk::LDS_BYTES, stream, a);
    return 0;
}
extern "C" void kernel_launch(void* const* d_in, const int* in_sizes, int n_in, void* d_out, int out_size, void* d_ws, size_t ws_size, hipStream_t stream) {
    if (n_in != 26 || ws_size < fk::WS_END || out_size != fk::MR * fk::D) { fprintf(stderr, "kernel_launch: unexpected shapes (n_in %d, ws %zu, out %d)\n", n_in, ws_size, out_size); return; }
    fk_launch(d_in, d_out, d_ws, 0, 19, stream);
}
```

```cpp
#include <hip/hip_runtime.h>
#include <cstdio>
namespace pg8 {
#define PG8_LAS __attribute__((address_space(3)))
typedef unsigned short bf16_t;
typedef short bf16x8 __attribute__((ext_vector_type(8)));
typedef float f32x4 __attribute__((ext_vector_type(4)));
typedef unsigned u32x4 __attribute__((ext_vector_type(4)));
constexpr int BM = 256, BK = 64, HALF = 128, HTB = HALF * BK * 2  , STAGE_BYTES = 8 * HTB, NXCD = 8, WGM = 8;

__host__ __device__ __forceinline__ int lds_byte(int r, int c) { const int st = (r >> 4) * 2 + (c >> 5), rr = r & 15, cc = c & 31, ob = rr * 64 + cc * 2; return st * 1024 + (ob ^ (((ob >> 9) & 1) << 5)); }
__host__ __device__ __forceinline__ void stage_rc(int b, int& R, int& C) { const int st = b / 1024, sb = b % 1024, swz = sb ^ (((sb >> 9) & 1) << 5); R = (st >> 1) * 16 + swz / 64; C = (st & 1) * 32 + (swz % 64) / 2; }
__host__ __device__ __forceinline__ int perm32(int rho) { const int n = rho >> 4, i = rho & 15; return 8 * (i >> 2) + 4 * n + (i & 3); }

struct Unit { int pm, pn; };
struct Gemm { const bf16_t* A; const bf16_t* Bt; int M, N, K; };

struct StaticOrder {
    int nM, nN, nwg, G, c, rev;
    __host__ __device__ void init(int M, int N, int G_, int c_, int rev_ = 0) { nM = M / BM; nN = N / BM; nwg = nM * nN; G = G_; c = c_; rev = rev_; }
    __host__ __device__ bool next(int i, Unit& u) const {
        const int nr = c < nwg ? (nwg - c + G - 1) / G : 0;
        if (i >= nr) return false;
        const long L = (long)(rev ? nr - 1 - i : i) * G + c;
        int wgid = (int)L; { const int q = nwg / NXCD, r = nwg % NXCD, xcd = wgid % NXCD, off = wgid / NXCD; wgid = (xcd < r ? xcd * (q + 1) : r * (q + 1) + (xcd - r) * q) + off; }
        const int nig = WGM * nN, gid = wgid / nig, fm = gid * WGM, gsz = (nM - fm) < WGM ? (nM - fm) : WGM;
        u.pm = fm + ((wgid % nig) % gsz); u.pn = (wgid % nig) / gsz; return true;
    }
    __device__ __forceinline__ void a_ready(const Unit&) const {}
    __device__ __forceinline__ void done(const Unit&) const {}
};
__device__ __forceinline__ unsigned cvt_pk_bf16(float lo, float hi) { unsigned r; asm volatile("v_cvt_pk_bf16_f32 %0, %1, %2" : "=v"(r) : "v"(lo), "v"(hi)); return r; }
typedef float f32x2e __attribute__((ext_vector_type(2)));
__device__ __forceinline__ float fsigm(float v) { return __builtin_amdgcn_rcpf(1.0f + __expf(-v)); }
__device__ __forceinline__ unsigned pk_h2(float a, float b) { const _Float16 ha = (_Float16)a, hb = (_Float16)b; return (unsigned)__builtin_bit_cast(unsigned short, ha) | ((unsigned)__builtin_bit_cast(unsigned short, hb) << 16); }
__device__ __forceinline__ float log2_1mk(float k) { return __log2f(1.0f - k); }

struct EpiInProj {
    static constexpr bool PERM = true, AFTER_DRAIN = false; static constexpr int ID = 0;
    bf16_t* proj; float* ext; const float* ssq; const float* lb;
    static constexpr bool PRE = true;
    __device__ __forceinline__ const float* pre_src(const Unit& u, int wr) const { return ssq + u.pm * BM + wr * 64; }
    __device__ __forceinline__ void operator()(const f32x4 (&acc)[2][2][4][2], const Unit& u, int wr, int wc, int fr, int fq, const float (&pre)[8]) const {
        const int row0 = u.pm * BM + wr * 64 + fr, pn = u.pn;
        const int kind = (pn == 18) ? 4 : (pn == 2 || pn == 3) ? 2 : (pn == 8) ? 3 : (pn == 0 || pn == 1 || pn == 6 || pn == 7 || pn == 12 || pn == 13 || pn == 16 || pn == 17) ? 1 : 0;
        const int col0 = pn * BM + wc * 32 + 8 * fq;
        if (kind == 4) {
#pragma unroll
            for (int ai = 0; ai < 2; ++ai)
#pragma unroll
                for (int m = 0; m < 4; ++m) { const int r = row0 + ai * HALF + m * 16; const float rs = rsqrtf(pre[ai * 4 + m] * (1.0f / 1024.0f) + 1e-6f);
                    if (wc == 0) { float* e = ext + (size_t)r * 32 + 8 * fq; *(f32x4*)e = acc[ai][0][m][0] * rs; *(f32x4*)(e + 4) = acc[ai][0][m][1] * rs; } }
            return;
        }
        float rsv[2][4];
#pragma unroll
        for (int ai = 0; ai < 2; ++ai)
#pragma unroll
            for (int m = 0; m < 4; ++m) rsv[ai][m] = rsqrtf(pre[ai * 4 + m] * (1.0f / 1024.0f) + 1e-6f);
#pragma unroll
        for (int bj = 0; bj < 2; ++bj) {
            float lbv[8];
#pragma unroll
            for (int j = 0; j < 8; ++j) lbv[j] = (kind == 2) ? lb[(pn - 2) * BM + bj * HALF + wc * 32 + 8 * fq + j] : 0.f;
#pragma unroll
            for (int ai = 0; ai < 2; ++ai)
#pragma unroll
                for (int m = 0; m < 4; ++m) {
                    const int r = row0 + ai * HALF + m * 16; const float rs = rsv[ai][m];
                    bf16_t* rowp = proj + (size_t)r * 4608 + col0;
                    float v[8];
#pragma unroll
                    for (int j = 0; j < 4; ++j) { v[j] = acc[ai][bj][m][0][j] * rs; v[4 + j] = acc[ai][bj][m][1][j] * rs; }
                    u32x4 w;
                    if (kind == 2) {
#pragma unroll
                        for (int j = 0; j < 8; ++j) { const float k = (1.0f - lbv[j]) * fsigm(-v[j]); v[j] = log2_1mk(k); }
                        w.x = pk_h2(v[0], v[1]); w.y = pk_h2(v[2], v[3]); w.z = pk_h2(v[4], v[5]); w.w = pk_h2(v[6], v[7]);
                    } else {
                        if (kind == 1) {
#pragma unroll
                            for (int j = 0; j < 8; ++j) v[j] = v[j] * fsigm(v[j]);
                        } else if (kind == 3) {
#pragma unroll
                            for (int j = 0; j < 8; ++j) v[j] *= 0.125f;
                        }
                        w.x = cvt_pk_bf16(v[0], v[1]); w.y = cvt_pk_bf16(v[2], v[3]); w.z = cvt_pk_bf16(v[4], v[5]); w.w = cvt_pk_bf16(v[6], v[7]);
                    }
                    *(u32x4*)(rowp + bj * HALF) = w;
                }
        }
    }
};

struct EpiResid {
    static constexpr bool PERM = true, AFTER_DRAIN = false; static constexpr int ID = 1;
    const float* x32; bf16_t* xb; float* ssq;
    static constexpr bool PRE = false;
    __device__ __forceinline__ void operator()(const f32x4 (&acc)[2][2][4][2], const Unit& u, int wr, int wc, int fr, int fq, const float (&)[8]) const {
        const int row0 = u.pm * BM + wr * 64 + fr, col0 = u.pn * BM + wc * 32 + 8 * fq;
        const int ln = fq * 16 + fr;
#pragma unroll
        for (int ai = 0; ai < 2; ++ai) {
            f32x4 xo[4][2][2];
            if (x32) {
#pragma unroll
                for (int m = 0; m < 4; ++m)
#pragma unroll
                    for (int bj = 0; bj < 2; ++bj) { const size_t off = (size_t)(row0 + ai * HALF + m * 16) * 1024 + col0 + bj * HALF; xo[m][bj][0] = *(const f32x4*)(x32 + off); xo[m][bj][1] = *(const f32x4*)(x32 + off + 4); }
            } else {
                u32x4 ob[4][2];
#pragma unroll
                for (int m = 0; m < 4; ++m)
#pragma unroll
                    for (int bj = 0; bj < 2; ++bj) ob[m][bj] = *(const u32x4*)(xb + (size_t)(row0 + ai * HALF + m * 16) * 1024 + col0 + bj * HALF);
#pragma unroll
                for (int m = 0; m < 4; ++m)
#pragma unroll
                    for (int bj = 0; bj < 2; ++bj) { const u32x4 o = ob[m][bj];
                        xo[m][bj][0] = (f32x4){__uint_as_float(o.x << 16), __uint_as_float(o.x & 0xffff0000u), __uint_as_float(o.y << 16), __uint_as_float(o.y & 0xffff0000u)};
                        xo[m][bj][1] = (f32x4){__uint_as_float(o.z << 16), __uint_as_float(o.z & 0xffff0000u), __uint_as_float(o.w << 16), __uint_as_float(o.w & 0xffff0000u)}; }
            }
#pragma unroll
            for (int m = 0; m < 4; ++m) {
                const int r = row0 + ai * HALF + m * 16; const size_t off = (size_t)r * 1024 + col0; float ss = 0.f;
#pragma unroll
                for (int bj = 0; bj < 2; ++bj) {
                    const f32x4 x0 = xo[m][bj][0] + acc[ai][bj][m][0], x1 = xo[m][bj][1] + acc[ai][bj][m][1];
                    u32x4 w; w.x = cvt_pk_bf16(x0[0], x0[1]); w.y = cvt_pk_bf16(x0[2], x0[3]); w.z = cvt_pk_bf16(x1[0], x1[1]); w.w = cvt_pk_bf16(x1[2], x1[3]);
                    *(u32x4*)(xb + off + bj * HALF) = w;
                    ss += (x0[0] * x0[0] + x0[1] * x0[1]) + (x0[2] * x0[2] + x0[3] * x0[3]) + (x1[0] * x1[0] + x1[1] * x1[1]) + (x1[2] * x1[2] + x1[3] * x1[3]);
                }
                ss += __builtin_bit_cast(float, __builtin_amdgcn_ds_bpermute((ln ^ 16) << 2, __builtin_bit_cast(int, ss))); ss += __builtin_bit_cast(float, __builtin_amdgcn_ds_bpermute((ln ^ 32) << 2, __builtin_bit_cast(int, ss)));
                if (fq == 0) unsafeAtomicAdd(ssq + r, ss);
            }
            asm volatile("" ::: "memory");
        }
    }
};

struct EpiBf16S {
    static constexpr bool PERM = true, AFTER_DRAIN = false; static constexpr int ID = 2;
    bf16_t* O; int ldc; const float* ssq;
    static constexpr bool PRE = true;
    __device__ __forceinline__ const float* pre_src(const Unit& u, int wr) const { return ssq ? ssq + u.pm * BM + wr * 64 : (const float*)O; }
    __device__ __forceinline__ void operator()(const f32x4 (&acc)[2][2][4][2], const Unit& u, int wr, int wc, int fr, int fq, const float (&pre)[8]) const {
        const int row0 = u.pm * BM + wr * 64 + fr, col0 = u.pn * BM + wc * 32 + 8 * fq;
#pragma unroll
        for (int ai = 0; ai < 2; ++ai)
#pragma unroll
            for (int m = 0; m < 4; ++m) {
                const int r = row0 + ai * HALF + m * 16; const float rs = ssq ? rsqrtf(pre[ai * 4 + m] * (1.0f / 1024.0f) + 1e-6f) : 1.0f;
                bf16_t* rowp = O + (size_t)r * ldc + col0;
#pragma unroll
                for (int bj = 0; bj < 2; ++bj) { const f32x4 v0 = acc[ai][bj][m][0] * rs, v1 = acc[ai][bj][m][1] * rs;
                    u32x4 w; w.x = cvt_pk_bf16(v0[0], v0[1]); w.y = cvt_pk_bf16(v0[2], v0[3]); w.z = cvt_pk_bf16(v1[0], v1[1]); w.w = cvt_pk_bf16(v1[2], v1[3]);
                    *(u32x4*)(rowp + bj * HALF) = w;
#ifdef EPI_DUP
                    if (ssq) *(u32x4*)(rowp + bj * HALF + (size_t)32768 * 1024) = w;
#endif
                    }
            }
    }
};

struct EpiVt {
    static constexpr bool PERM = true, AFTER_DRAIN = false; static constexpr int ID = 3;
    bf16_t* O;
    static constexpr bool PRE = false;
    __device__ __forceinline__ void operator()(const f32x4 (&acc)[2][2][4][2], const Unit& u, int wr, int wc, int fr, int fq, const float (&)[8]) const {
        const int row0 = u.pm * BM + wr * 64 + fr, colb = u.pn * BM + wc * 32;
        typedef unsigned u32x2 __attribute__((ext_vector_type(2)));
#pragma unroll
        for (int ai = 0; ai < 2; ++ai)
#pragma unroll
            for (int m = 0; m < 4; ++m) {
                bf16_t* rowp = O + (size_t)(row0 + ai * HALF + m * 16) * 1024 + colb;
#pragma unroll
                for (int bj = 0; bj < 2; ++bj)
#pragma unroll
                    for (int n = 0; n < 2; ++n) { const f32x4 v = acc[ai][bj][m][n]; const int p = (fq >> 1) * 16 + n * 8 + (fq & 1) * 4;
                        u32x2 w; w.x = cvt_pk_bf16(v[0], v[1]); w.y = cvt_pk_bf16(v[2], v[3]); *(u32x2*)(rowp + bj * HALF + p) = w; }
            }
    }
};
#ifndef PG8_SIDE
#define PG8_SIDE 1
#endif
template <class Epi, class Sched, bool STAMP = false>
__device__ __forceinline__ void gemm_phase(PG8_LAS unsigned char* lds, const Gemm g, const Sched& S, const Epi& E, unsigned long long* stamps, const int wv_) {
    int tid_; asm volatile("v_mbcnt_lo_u32_b32 %0, -1, 0\n\tv_mbcnt_hi_u32_b32 %0, -1, %0" : "=v"(tid_)); tid_ += wv_ * 64;
    const int tid = tid_, wid = __builtin_amdgcn_readfirstlane(tid >> 6), lane = tid & 63, wr = wid >> 2, wc = wid & 3, fr = lane & 15, fq = lane >> 4;
    const int K = g.K, nt = K / BK;
    int ts_lo = 0, ts_hi = 0, nts = 0; const unsigned long long rt_entry = STAMP ? (unsigned long long)wall_clock64() : 0ull;
#define PG8_STAMP() do { if (STAMP && wid == 0 && nts < 64) { const unsigned long long _c = (unsigned long long)clock64(); \
        ts_lo = (lane == nts) ? (int)(unsigned)_c : ts_lo; ts_hi = (lane == nts) ? (int)(unsigned)(_c >> 32) : ts_hi; ++nts; } } while (0)
    PG8_STAMP();
    unsigned voffA[2], voffB[2];
#pragma unroll
    for (int i = 0; i < 2; ++i) { int R, C; stage_rc(tid * 16 + i * 8192, R, C); const int Rb = Epi::PERM ? ((R & ~31) + perm32(R & 31)) : R;
        voffA[i] = (unsigned)(R * K + C) * 2u; voffB[i] = (unsigned)(Rb * K + C) * 2u; }
    const size_t kstep = (size_t)(BK * 2);
    const size_t hstep = (size_t)HALF * K * 2;
    const size_t tstep = 2 * hstep;
    const unsigned lds_u = (unsigned)(size_t)lds;
    const unsigned ldsw = (unsigned)wid * 1024u;
    const int aoff = lds_byte(wr * 64 + fr, fq * 8), boff = lds_byte(wc * 32 + fr, fq * 8);
#define PG8_SA(b, h) (((b) * 2 + (h)) * HTB)
#define PG8_SB(b, h) ((4 + (b) * 2 + (h)) * HTB)
#define PG8_STAGE(bufoff, gbase, voff) do { _Pragma("unroll") for (int _i = 0; _i < 2; ++_i) { unsigned _keep; \
        asm volatile("s_mov_b32 %0, m0\n\ts_mov_b32 m0, %3\n\ts_nop 0\n\tglobal_load_lds_dwordx4 %1, %2\n\ts_mov_b32 m0, %0" : "=&s"(_keep) : "v"((voff)[_i]), "s"((const void*)(gbase)), "s"((unsigned)(lds_u + (unsigned)(bufoff) + ldsw + _i * 8192)) : "memory"); } } while (0)
#define PG8_LDA(dst, b, h) do { _Pragma("unroll") for (int m = 0; m < 4; ++m) _Pragma("unroll") for (int k = 0; k < 2; ++k) dst[m][k] = *(const PG8_LAS bf16x8*)(lds + PG8_SA(b, h) + aoff + m * 2048 + k * 1024); } while (0)
#define PG8_LDB(dst, b, h) do { _Pragma("unroll") for (int n = 0; n < 2; ++n) _Pragma("unroll") for (int k = 0; k < 2; ++k) dst[n][k] = *(const PG8_LAS bf16x8*)(lds + PG8_SB(b, h) + boff + n * 2048 + k * 1024); } while (0)
#define PG8_MMA(ai, bj, At, Bt) do { __builtin_amdgcn_s_setprio(1); _Pragma("unroll") for (int m = 0; m < 4; ++m) _Pragma("unroll") for (int n = 0; n < 2; ++n) _Pragma("unroll") for (int k = 0; k < 2; ++k) \
        acc[ai][bj][m][n] = __builtin_amdgcn_mfma_f32_16x16x32_bf16(Bt[n][k], At[m][k], acc[ai][bj][m][n], 0, 0, 0); __builtin_amdgcn_s_setprio(0); } while (0)
#define PG8_WAIT_V(n) asm volatile("s_waitcnt vmcnt(" #n ")" ::: "memory")
#define PG8_WAIT_L(n) asm volatile("s_waitcnt lgkmcnt(" #n ")" ::: "memory")
#define PG8_BAR __builtin_amdgcn_s_barrier()
#define PG8_SCHED __builtin_amdgcn_sched_barrier(0)
#ifdef GPROBE
#define GP_BEGIN(k) unsigned long long gp_t0_##k = 0; if (GPROBE == (k) && Epi::ID == GPROBE_ID) gp_t0_##k = __builtin_amdgcn_s_memrealtime();
#define GP_END(k) do { if (GPROBE == (k) && Epi::ID == GPROBE_ID && wid == 0) { const unsigned long long d_ = __builtin_amdgcn_s_memrealtime() - gp_t0_##k; if (lane == 0) *(volatile PG8_LAS unsigned long long*)(lds + 163840 - 32) += d_; } } while (0)
#else
#define GP_BEGIN(k)
#define GP_END(k) do { } while (0)
#endif
    Unit cur, nxt; int ui = 0;
    if (!S.next(0, cur)) return;
    f32x4 acc[2][2][4][2];
#pragma unroll
    for (int a = 0; a < 2; ++a)
#pragma unroll
        for (int b = 0; b < 2; ++b)
#pragma unroll
            for (int m = 0; m < 4; ++m)
#pragma unroll
                for (int n = 0; n < 2; ++n) acc[a][b][m][n] = (f32x4){0.f, 0.f, 0.f, 0.f};
    bf16x8 At[4][2], B0[2][2], B1[2][2];
    float pre[8];
#pragma unroll
    for (int i = 0; i < 8; ++i) pre[i] = 0.f;
    const char* cA = (const char*)g.A + (size_t)cur.pm * tstep; const char* cB = (const char*)g.Bt + (size_t)cur.pn * tstep;
    S.a_ready(cur);
    PG8_STAGE(PG8_SB(0, 0), cB, voffB); PG8_STAGE(PG8_SA(0, 0), cA, voffA); PG8_STAGE(PG8_SB(0, 1), cB + hstep, voffB); PG8_STAGE(PG8_SA(0, 1), cA + hstep, voffA);
    if (wr == 1) PG8_BAR;
    PG8_WAIT_V(4); PG8_BAR;
    PG8_STAGE(PG8_SB(1, 0), cB + kstep, voffB); PG8_STAGE(PG8_SA(1, 0), cA + kstep, voffA); PG8_STAGE(PG8_SB(1, 1), cB + hstep + kstep, voffB);
    PG8_WAIT_V(6); PG8_BAR;
    PG8_STAMP();
    for (;;) {
        const bool has_next = S.next(ui + 1, nxt);
        const char* nA = has_next ? (const char*)g.A + (size_t)nxt.pm * tstep : cA; const char* nB = has_next ? (const char*)g.Bt + (size_t)nxt.pn * tstep : cB;
        GP_BEGIN(4)
        for (int t = 0; t < nt; t += 2) {
            const bool last = (t == nt - 2);
            GP_BEGIN(2) GP_BEGIN(3)
            const char* a1 = cA + (size_t)(t + 1) * kstep;
            const char* a2 = last ? nA : cA + (size_t)(t + 2) * kstep; const char* b2 = last ? nB : cB + (size_t)(t + 2) * kstep;
            const char* a3 = a2 + kstep; const char* b3 = b2 + kstep;
            if (last && has_next) S.a_ready(nxt);
            if constexpr (Epi::PRE) { if (last) { const float* ps = E.pre_src(cur, wr);
#pragma unroll
                for (int _i = 0; _i < 2; ++_i) { unsigned _keep;
                    asm volatile("s_mov_b32 %0, m0\n\ts_mov_b32 m0, %3\n\ts_nop 0\n\tglobal_load_lds_dword %1, %2\n\ts_mov_b32 m0, %0" : "=&s"(_keep) : "v"((unsigned)(lane * 4)), "s"((const void*)(ps + _i * HALF)), "s"((unsigned)(lds_u + 8u * HTB + (unsigned)wid * 512u + _i * 256u)) : "memory"); } } }
            PG8_LDB(B0, 0, 0); PG8_SCHED; PG8_LDA(At, 0, 0); PG8_STAGE(PG8_SA(1, 1), a1 + hstep, voffA);
            PG8_WAIT_L(8); PG8_BAR; PG8_WAIT_L(0); PG8_MMA(0, 0, At, B0); PG8_BAR; PG8_SCHED;
            PG8_LDB(B1, 0, 1); PG8_STAGE(PG8_SB(0, 0), b2, voffB);
            PG8_BAR; PG8_WAIT_L(0); PG8_MMA(0, 1, At, B1); PG8_BAR;
            PG8_LDA(At, 0, 1); PG8_STAGE(PG8_SA(0, 0), a2, voffA);
            PG8_BAR; PG8_WAIT_L(0); PG8_MMA(1, 0, At, B0); PG8_BAR; PG8_SCHED;
            PG8_STAGE(PG8_SB(0, 1), b2 + hstep, voffB);
            PG8_WAIT_V(6); PG8_BAR; PG8_MMA(1, 1, At, B1); PG8_BAR;
            PG8_LDB(B0, 1, 0); PG8_SCHED; PG8_LDA(At, 1, 0); PG8_STAGE(PG8_SA(0, 1), a2 + hstep, voffA);
            PG8_WAIT_L(8); PG8_BAR; PG8_WAIT_L(0); PG8_MMA(0, 0, At, B0); PG8_BAR; PG8_SCHED;
            PG8_LDB(B1, 1, 1); PG8_STAGE(PG8_SB(1, 0), b3, voffB);
            PG8_BAR; PG8_WAIT_L(0); PG8_MMA(0, 1, At, B1); PG8_BAR;
            PG8_LDA(At, 1, 1); PG8_STAGE(PG8_SA(1, 0), a3, voffA);
            PG8_BAR; PG8_WAIT_L(0); PG8_MMA(1, 0, At, B0); PG8_BAR; PG8_SCHED;
            PG8_STAGE(PG8_SB(1, 1), b3 + hstep, voffB);
            PG8_WAIT_V(6); PG8_BAR; PG8_MMA(1, 1, At, B1); PG8_BAR;
            if (t == 0 && ui > 0) GP_END(2); if (t == 4 && ui > 0) GP_END(3);
        }
        GP_END(4);
        PG8_STAMP();
        if (PG8_SIDE && wr == 0) PG8_BAR;
        GP_BEGIN(1)
        if constexpr (!Epi::AFTER_DRAIN) { if constexpr (Epi::PRE) {
#pragma unroll
                for (int i = 0; i < 8; ++i) pre[i] = *(const PG8_LAS float*)(lds + 8 * HTB + wid * 512 + (i >> 2) * 256 + ((i & 3) * 16 + fr) * 4); }
            E(acc, cur, wr, wc, fr, fq, pre); S.done(cur); }
        GP_END(1);
#ifdef GPROBE
        { GP_BEGIN(5) if (GPROBE == 5 && Epi::ID == GPROBE_ID) PG8_WAIT_V(0); GP_END(5); }
#endif
        PG8_STAMP();
        if (!has_next) break;
        if (PG8_SIDE && wr == 1) PG8_BAR;
#pragma unroll
        for (int a = 0; a < 2; ++a)
#pragma unroll
            for (int b = 0; b < 2; ++b)
#pragma unroll
                for (int m = 0; m < 4; ++m)
#pragma unroll
                    for (int n = 0; n < 2; ++n) acc[a][b][m][n] = (f32x4){0.f, 0.f, 0.f, 0.f};
        cur = nxt; cA = nA; cB = nB; ++ui;
    }
    PG8_WAIT_V(0);
    if (!PG8_SIDE && wr == 0) PG8_BAR;
    PG8_BAR;
    if constexpr (Epi::AFTER_DRAIN) { E.fused(acc, cur, wr, wc, fr, fq, lds, wid, lane); S.done(cur); }
    PG8_STAMP();
    if (STAMP && wid == 0) { stamps[lane] = lane < nts ? (((unsigned long long)(unsigned)ts_hi << 32) | (unsigned)ts_lo) : 0ull;
        if (lane == 62) stamps[62] = rt_entry; if (lane == 63) stamps[63] = (unsigned long long)wall_clock64(); }
#undef PG8_STAMP
#undef PG8_SA
#undef PG8_SB
#undef PG8_STAGE
#undef PG8_LDA
#undef PG8_LDB
#undef PG8_MMA
#undef PG8_WAIT_V
#undef PG8_WAIT_L
#undef PG8_BAR
#undef PG8_SCHED
}
}
namespace fk {
using pg8::bf16_t;
typedef float f32x4 __attribute__((ext_vector_type(4)));
typedef unsigned u32x4 __attribute__((ext_vector_type(4)));
typedef unsigned u32x2 __attribute__((ext_vector_type(2)));
typedef short bf16x8 __attribute__((ext_vector_type(8)));
#ifndef FK_MR
#define FK_MR 32768
#endif
constexpr int D = 1024, S = 8192, MR = FK_MR, NBT = MR / S, NPROJ = 4608, NPAD = 4864, MIXW = 1536, MEMT = 256, INC = 4632;
#ifndef FK_REVQ
#define FK_REVQ 0
#endif
constexpr int NTHR = 512, LDS_BYTES = 163840, LDS_BAR = LDS_BYTES - 16, LDS_TP = LDS_BYTES - 32;

constexpr size_t OFF_CTL = 0, OFF_SSQ = 65536, SSQ_BYTES = (size_t)32768 * 4, ZERO_BYTES = OFF_SSQ + 5 * SSQ_BYTES;
constexpr size_t OFF_LB = ZERO_BYTES, OFF_WIN = OFF_LB + 4096, SZ_WIN = (size_t)NPAD * D * 2, OFF_WOUT = OFF_WIN + 2 * SZ_WIN, SZ_WOUT = (size_t)D * MIXW * 2;
constexpr size_t SZ_SQ = (size_t)D * D * 2, OFF_WQ = OFF_WOUT + 2 * SZ_WOUT, OFF_WO = OFF_WQ + 2 * SZ_SQ, OFF_WK = OFF_WO + 2 * SZ_SQ, OFF_WV = OFF_WK + 2 * SZ_SQ;
constexpr size_t OFF_MEMN = OFF_WV + 2 * SZ_SQ, OFF_KM = OFF_MEMN + 2 * SZ_SQ, OFF_VT = OFF_KM + 2 * SZ_SQ;
constexpr size_t OFF_XB = OFF_VT + 2 * SZ_SQ, SZ_XB = (size_t)MR * D * 2, OFF_PROJ = OFF_XB + SZ_XB, SZ_PROJ = (size_t)MR * NPROJ * 2;
constexpr size_t OFF_EXT = OFF_PROJ + SZ_PROJ, SZ_EXT = (size_t)MR * 32 * 4, OFF_MIX = OFF_EXT + SZ_EXT, SZ_MIX = (size_t)MR * MIXW * 2, WS_END = OFF_MIX + SZ_MIX;
constexpr size_t OFF_Q = OFF_PROJ, OFF_O = OFF_PROJ + SZ_XB;
static_assert(WS_END <= (size_t)536870912, "workspace");
static_assert(2 * SZ_XB <= SZ_PROJ, "q/o overlay");

#define XB_TMO      128
#define XB_XCNT(j)  (256  + 64 * (j))
#define XB_XSUB(j)  (1280 + 64 * (j))
#define XB_XGEN(j)  (2304 + 64 * (j))
#define XB_TOP      3328
#define XB_TOPGEN   3392
#define XCD_BAR_WORDS 3456
#define XB_SPIN_CAP (1u << 18)
#ifndef XB_EARLY_INV
#define XB_EARLY_INV 1
#endif
#define LAS __attribute__((address_space(3)))

__device__ __forceinline__ unsigned xb_ld(unsigned* p)              { return __hip_atomic_load(p, __ATOMIC_RELAXED, __HIP_MEMORY_SCOPE_AGENT); }
__device__ __forceinline__ unsigned xb_add(unsigned* p, unsigned v) { return __hip_atomic_fetch_add(p, v, __ATOMIC_RELAXED, __HIP_MEMORY_SCOPE_AGENT); }
__device__ __forceinline__ unsigned xb_xcc_id() { return (unsigned)__builtin_amdgcn_s_getreg((3 << 11) | 20) & 0xFu; }
#define XB_SPIN(cond, bar) do { unsigned _sp = 0; while (cond) { __builtin_amdgcn_s_sleep(1); \
    if ((++_sp & 255u) == 0u) { if (xb_ld(&(bar)[XB_TMO])) break; if (_sp > XB_SPIN_CAP) { atomicAdd(&(bar)[XB_TMO], 1u); break; } } } } while (0)

__device__ __forceinline__ int xb_lane() { int l_; asm volatile("v_mbcnt_lo_u32_b32 %0, -1, 0\n\tv_mbcnt_hi_u32_b32 %0, -1, %0" : "=v"(l_)); return l_; }
struct XcdBarrier {
    unsigned* bar; unsigned x;
    volatile LAS unsigned* st;
};

__device__ __forceinline__ XcdBarrier xcd_barrier_post(unsigned* bar, volatile LAS unsigned* st, int wv) {
    XcdBarrier b; b.bar = bar; b.x = xb_xcc_id(); b.st = st;
    if (wv == 0 && xb_lane() == 0) (void)xb_add(&bar[XB_XCNT(b.x)], 1u);
    return b;
}
__device__ __forceinline__ void xcd_barrier_complete(unsigned* bar, unsigned x, unsigned& nloc, unsigned& nx) {
    const unsigned G = gridDim.x * gridDim.y * gridDim.z;
    unsigned sum, cnt, mine, sp = 0u;
    for (;;) {
        sum = 0u; cnt = 0u; mine = 0u;
#pragma unroll
        for (unsigned j = 0; j < 16; ++j) { const unsigned c = xb_ld(&bar[XB_XCNT(j)]); sum += c; cnt += (c > 0u) ? 1u : 0u; mine = (j == x) ? c : mine; }
        if (sum == G) break;
        __builtin_amdgcn_s_sleep(1);
        if ((++sp & 255u) == 0u) { if (xb_ld(&bar[XB_TMO])) break; if (sp > XB_SPIN_CAP) { atomicAdd(&bar[XB_TMO], 1u); break; } }
    }
    nloc = mine > 0u ? mine : 1u; nx = cnt > 0u ? cnt : 1u;
}

__device__ __forceinline__ void xcd_barrier(const XcdBarrier& b, int wv) {
    asm volatile("s_waitcnt vmcnt(0)" ::: "memory");
    __syncthreads();
    if (wv == 0 && xb_lane() == 0) {
        unsigned* bar = b.bar;
        __builtin_amdgcn_s_waitcnt(0);
#if XB_EARLY_INV
        asm volatile("buffer_inv sc1" ::: "memory");
#endif
        unsigned nloc = b.st[0], nx = b.st[1];
        if (nloc == 0u) { xcd_barrier_complete(bar, b.x, nloc, nx); b.st[0] = nloc; b.st[1] = nx; }
        const unsigned old = xb_add(&bar[XB_XSUB(b.x)], 1u);
        const unsigned gen = old / nloc;
        if (old + 1u == (gen + 1u) * nloc) {
            __builtin_amdgcn_fence(__ATOMIC_RELEASE, "agent");
            asm volatile("s_waitcnt vmcnt(0)" ::: "memory");
            const unsigned og = xb_add(&bar[XB_TOP], 1u);
            const unsigned tg = og / nx;
            if (og + 1u == (tg + 1u) * nx) xb_add(&bar[XB_TOPGEN], 1u);
            else XB_SPIN(xb_ld(&bar[XB_TOPGEN]) == tg, bar);
#if !XB_EARLY_INV
            __builtin_amdgcn_fence(__ATOMIC_ACQUIRE, "agent");
#endif
            xb_add(&bar[XB_XGEN(b.x)], 1u);
            asm volatile("s_waitcnt vmcnt(0)" ::: "memory");
        } else {
            XB_SPIN(xb_ld(&bar[XB_XGEN(b.x)]) == gen, bar);
#if !XB_EARLY_INV
            __builtin_amdgcn_fence(__ATOMIC_ACQUIRE, "agent");
#endif
            asm volatile("s_waitcnt vmcnt(0)" ::: "memory");
        }
    }
    __syncthreads();
}

#define GB_CNT(g)  (4096 + 64 * (g))
#define GB_MASK(g) (4608 + 64 * (g))
__device__ __forceinline__ void grp_census_post(const XcdBarrier& b, int g, int wv) { if (wv == 0 && xb_lane() == 0) (void)__hip_atomic_fetch_or(&b.bar[GB_MASK(g)], 1u << b.x, __ATOMIC_RELAXED, __HIP_MEMORY_SCOPE_AGENT); }
__device__ __forceinline__ void grp_census_read(const XcdBarrier& b, int g, int wv) {
    if (wv == 0 && xb_lane() == 0) { const unsigned m = xb_ld(&b.bar[GB_MASK(g)]); b.st[2] = (m != 0u && (m & (m - 1u)) == 0u) ? 1u : 0u;
#ifdef FK_FORCE_NONLOCAL
        b.st[2] = 0u;
#endif
    } }
__device__ __forceinline__ void grp_barrier(const XcdBarrier& b, int g, unsigned ng, int wv) {
    asm volatile("s_waitcnt vmcnt(0)" ::: "memory");
    __syncthreads();
    if (wv == 0 && xb_lane() == 0) {
        unsigned* bar = b.bar;
        __builtin_amdgcn_s_waitcnt(0);
#if XB_EARLY_INV
        asm volatile("buffer_inv sc1" ::: "memory");
#endif
        if (b.st[2] == 0u) { __builtin_amdgcn_fence(__ATOMIC_RELEASE, "agent"); asm volatile("s_waitcnt vmcnt(0)" ::: "memory"); }
        const unsigned old = xb_add(&bar[GB_CNT(g)], 1u);
        const unsigned tgt = (old / ng + 1u) * ng;
        XB_SPIN(xb_ld(&bar[GB_CNT(g)]) < tgt, bar);
#if !XB_EARLY_INV
        __builtin_amdgcn_fence(__ATOMIC_ACQUIRE, "agent");
#endif
        asm volatile("s_waitcnt vmcnt(0)" ::: "memory");
    }
    __syncthreads();
}
__device__ __forceinline__ int fk_lane() { int l_; asm volatile("v_mbcnt_lo_u32_b32 %0, -1, 0\n\tv_mbcnt_hi_u32_b32 %0, -1, %0" : "=v"(l_)); return l_; }

struct Args { const float* in[26]; float* out; unsigned char* ws; int ph_lo, ph_hi; };

__device__ __forceinline__ unsigned short bf16r(float f) { unsigned u = __float_as_uint(f); u += 0x7fffu + ((u >> 16) & 1u); return (unsigned short)(u >> 16); }
__device__ __forceinline__ float bf2f(unsigned short b) { return __uint_as_float(((unsigned)b) << 16); }
__device__ __forceinline__ float wsum(float v, int lane) {
#pragma unroll
    for (int o = 32; o >= 1; o >>= 1) v += __builtin_bit_cast(float, __builtin_amdgcn_ds_bpermute((lane ^ o) << 2, __builtin_bit_cast(int, v)));
    return v; }

__device__ __forceinline__ int win_src(int np) { return np < 3072 ? np : np < 4608 ? np + 16 : np < 4624 ? np - 4608 + 3072 : np < 4632 ? np : -1; }
__device__ __forceinline__ void p0_transpose(LAS float* tile, const float* W, int K, int N, bf16_t* WT, int NT, int mode, const float* gain, float scale, int& tbase, int wg, int nwg, int wv) {
    const int tk = K / 128, ntile = tk * (NT / 64);
    float vn[16];
    auto load_tile = [&](int t) { const int tl = wv * 64 + fk_lane(); const int c = tl & 63, k0 = (t % tk) * 128, n0 = (t / tk) * 64, np = n0 + c, src = mode ? win_src(np) : (np < N ? np : -1);
#pragma unroll
        for (int i = 0; i < 16; ++i) { const int r = (tl >> 6) + 8 * i; vn[i] = (src >= 0) ? W[(size_t)(k0 + r) * N + src] * (gain ? gain[k0 + r] : 1.0f) * scale : 0.f; } };
    const int tfirst = ((wg - tbase) % nwg + nwg) % nwg;
    if (tfirst < ntile) load_tile(tfirst);
    for (int t = tfirst; t < ntile; t += nwg) {
        const int tl = wv * 64 + fk_lane();
        const int c = tl & 63, k0 = (t % tk) * 128, n0 = (t / tk) * 64;
        asm volatile("s_waitcnt lgkmcnt(0)" ::: "memory"); __builtin_amdgcn_s_barrier(); asm volatile("" ::: "memory");
#pragma unroll
        for (int i = 0; i < 16; ++i) tile[((tl >> 6) + 8 * i) * 65 + c] = vn[i];
        if (t + nwg < ntile) load_tile(t + nwg);
        asm volatile("s_waitcnt lgkmcnt(0)" ::: "memory"); __builtin_amdgcn_s_barrier(); asm volatile("" ::: "memory");
#pragma unroll
        for (int i = 0; i < 2; ++i) { const int item = tl + i * NTHR, rn = item >> 4, kc = item & 15;
            float v[8];
#pragma unroll
            for (int j = 0; j < 8; ++j) v[j] = tile[(kc * 8 + j) * 65 + rn];
            u32x4 w; w.x = pg8::cvt_pk_bf16(v[0], v[1]); w.y = pg8::cvt_pk_bf16(v[2], v[3]); w.z = pg8::cvt_pk_bf16(v[4], v[5]); w.w = pg8::cvt_pk_bf16(v[6], v[7]);
            *(u32x4*)(WT + (size_t)(n0 + rn) * K + k0 + kc * 8) = w; }
    }
    tbase = (tbase + ntile) % nwg;
}

__device__ __forceinline__ void p0_weights(const Args& a, LAS unsigned char* lds, int l, int sub, int nsub, int wv) {
    unsigned char* ws = a.ws; LAS float* tile = (LAS float*)lds; int tbase = 0;
    p0_transpose(tile, a.in[3] + (size_t)l * D * INC, D, INC, (bf16_t*)(ws + OFF_WIN + l * SZ_WIN), NPAD, 1, a.in[2] + l * D, 1.0f, tbase, sub, nsub, wv);
    p0_transpose(tile, a.in[18] + (size_t)l * MIXW * D, MIXW, D, (bf16_t*)(ws + OFF_WOUT + l * SZ_WOUT), D, 0, nullptr, 1.0f, tbase, sub, nsub, wv);
    p0_transpose(tile, a.in[21] + (size_t)l * D * D, D, D, (bf16_t*)(ws + OFF_WQ + l * SZ_SQ), D, 0, a.in[19] + l * D, 0.0625f * 1.4426950408889634f, tbase, sub, nsub, wv);
    p0_transpose(tile, a.in[22] + (size_t)l * D * D, D, D, (bf16_t*)(ws + OFF_WK + l * SZ_SQ), D, 0, nullptr, 1.0f, tbase, sub, nsub, wv);
    p0_transpose(tile, a.in[23] + (size_t)l * D * D, D, D, (bf16_t*)(ws + OFF_WV + l * SZ_SQ), D, 0, nullptr, 1.0f, tbase, sub, nsub, wv);
    p0_transpose(tile, a.in[24] + (size_t)l * D * D, D, D, (bf16_t*)(ws + OFF_WO + l * SZ_SQ), D, 0, nullptr, 1.0f, tbase, sub, nsub, wv);
    asm volatile("s_waitcnt vmcnt(0) lgkmcnt(0)" ::: "memory"); __builtin_amdgcn_s_barrier(); asm volatile("" ::: "memory");
}

__device__ __forceinline__ void p0_prologue(const Args& a, LAS unsigned char* lds, int wv) {
    int tid_ = wv * 64 + fk_lane(); asm volatile("" : "+v"(tid_)); const int tid = tid_, lane = tid & 63, wave = tid >> 6, wg = blockIdx.x, nwg = gridDim.x;
    unsigned char* ws = a.ws;
    p0_weights(a, lds, 0, wg, nwg, wv);
    { const float* x = a.in[0]; bf16_t* xb = (bf16_t*)(ws + OFF_XB); float* ssq0 = (float*)(ws + OFF_SSQ);
      for (int row = (wg * 8 + wave) * 4; row < MR; row += nwg * 8 * 4) { f32x4 v[4][4];
#pragma unroll
          for (int r = 0; r < 4; ++r)
#pragma unroll
              for (int i = 0; i < 4; ++i) v[r][i] = *(const f32x4*)(x + (size_t)(row + r) * D + i * 256 + lane * 4);
#pragma unroll
          for (int r = 0; r < 4; ++r) { float ss = 0.f;
#pragma unroll
              for (int i = 0; i < 4; ++i) { const f32x4 t = v[r][i]; ss += (t[0] * t[0] + t[1] * t[1]) + (t[2] * t[2] + t[3] * t[3]);
                  u32x2 w; w.x = pg8::cvt_pk_bf16(t[0], t[1]); w.y = pg8::cvt_pk_bf16(t[2], t[3]); *(u32x2*)(xb + (size_t)(row + r) * D + i * 256 + lane * 4) = w; }
              ss = wsum(ss, lane); if (lane == 0) ssq0[row + r] = ss; } } }
    { const float* mem = a.in[1];
      for (int it = wg * 8 + wave; it < 2 * 4 * MEMT; it += nwg * 8) { const int l = it >> 10, row = it & 1023; const float* g = a.in[20] + l * D; bf16_t* o = (bf16_t*)(ws + OFF_MEMN + l * SZ_SQ) + (size_t)row * D;
          f32x4 v[4]; float ss = 0.f;
#pragma unroll
          for (int i = 0; i < 4; ++i) { v[i] = *(const f32x4*)(mem + (size_t)row * D + i * 256 + lane * 4); ss += (v[i][0] * v[i][0] + v[i][1] * v[i][1]) + (v[i][2] * v[i][2] + v[i][3] * v[i][3]); }
          ss = wsum(ss, lane); const float rs = rsqrtf(ss * (1.0f / 1024.0f) + 1e-6f);
#pragma unroll
          for (int i = 0; i < 4; ++i) { const f32x4 gg = *(const f32x4*)(g + i * 256 + lane * 4); const f32x4 y = v[i] * rs * gg;
              u32x2 w; w.x = pg8::cvt_pk_bf16(y[0], y[1]); w.y = pg8::cvt_pk_bf16(y[2], y[3]); *(u32x2*)(o + i * 256 + lane * 4) = w; } } }
    if (wg == 0) { float* lb = (float*)(ws + OFF_LB); const float* lg = a.in[4];
        const float x0 = lg[tid], x1 = lg[512 + tid], mx = fmaxf(x0, x1), e0 = expf(x0 - mx), e1 = expf(x1 - mx); lb[tid] = 0.f; lb[512 + tid] = e1 / (e0 + e1); }
}
typedef float f32x16a __attribute__((ext_vector_type(16)));
__device__ __forceinline__ float bpx(float x, int mask, int lane) { return __builtin_bit_cast(float, __builtin_amdgcn_ds_bpermute((lane ^ mask) << 2, __builtin_bit_cast(int, x))); }
__device__ __forceinline__ void aglds16(const void* gsrc, unsigned lds_dst) { unsigned keep;
    asm volatile("s_mov_b32 %0, m0\n\ts_mov_b32 m0, %2\n\ts_nop 0\n\tglobal_load_lds_dwordx4 %1, off\n\ts_mov_b32 m0, %0" : "=&s"(keep) : "v"(gsrc), "s"(lds_dst) : "memory"); }
__device__ __forceinline__ void attn_dma_k(unsigned slot, const bf16_t* Kbh, int half, int wave, int lane) {
    asm volatile("" : "+v"(lane));
#pragma unroll
    for (int i = 0; i < 8; ++i) { const int p = i * 8 + wave, row = 2 * p + (lane >> 5), lc = (lane & 31) ^ (row & 15);
        aglds16((const void*)(Kbh + (size_t)(half * 128 + row) * 1024 + lc * 8), (unsigned)__builtin_amdgcn_readfirstlane((int)(slot + p * 1024))); } }
__device__ __forceinline__ void attn_dma_v(unsigned slot, const bf16_t* Vbh, int half, int wave, int lane) {
    asm volatile("" : "+v"(lane));
#pragma unroll
    for (int i = 0; i < 8; ++i) { const int p = i * 8 + wave, row = 4 * p + (lane >> 4), lc = (lane & 15) ^ (row & 15);
        aglds16((const void*)(Vbh + (size_t)row * 1024 + half * 128 + lc * 8), (unsigned)__builtin_amdgcn_readfirstlane((int)(slot + p * 1024))); } }
#ifdef ATP
#define AT_BEGIN(k) unsigned long long at_t0_##k = 0; if (ATP == (k)) at_t0_##k = __builtin_amdgcn_s_memrealtime();
#define AT_END(k) do { if (ATP == (k) && wave == 0) { const unsigned long long d_ = __builtin_amdgcn_s_memrealtime() - at_t0_##k; if (lane == 0) *(volatile LAS unsigned long long*)(lds + LDS_TP) += d_; } } while (0)
#else
#define AT_BEGIN(k)
#define AT_END(k) do { } while (0)
#endif
#define ATT_BAR() do { asm volatile("" ::: "memory"); __builtin_amdgcn_s_barrier(); asm volatile("" ::: "memory"); } while (0)
__device__ __forceinline__ void attn_phase(LAS unsigned char* lds, const bf16_t* q, const bf16_t* Km, const bf16_t* Vt, bf16_t* o, const pg8::StaticOrder& So, int wv) {
    int tid_ = wv * 64 + fk_lane(); asm volatile("" : "+v"(tid_));
    const int tid = tid_, lane0 = tid & 63, wave = wv;
    constexpr int RT = S / 256;
    const unsigned slot0 = (unsigned)(size_t)lds, slot1 = slot0 + 65536u;
    LAS unsigned char* ost = lds + 131072 + wave * 2048;
    pg8::Unit cu, nu; int ui = 0;
    bool have = So.next(0, cu);
    if (have) { const int h = cu.pn, b = cu.pm / RT; const bf16_t* Kbh = Km + (size_t)(b * 256) * 1024 + h * 256; attn_dma_k(slot0, Kbh, 0, wave, lane0); attn_dma_k(slot1, Kbh, 1, wave, lane0); }
    bf16x8 qf[16];
    if (have) { const int h = cu.pn; const size_t qrow = (size_t)cu.pm * 256 + wave * 32 + (lane0 & 31);
#pragma unroll
        for (int ks = 0; ks < 16; ++ks) qf[ks] = *(const bf16x8*)(q + qrow * 1024 + h * 256 + ks * 16 + (lane0 >> 5) * 8);
#pragma unroll
        for (int ks = 0; ks < 16; ++ks) asm volatile("" : "+v"(qf[ks])); }
    for (; have; ++ui) {
        int lane = lane0; asm volatile("" : "+v"(lane)); const int n = lane & 31, hh = lane >> 5;
        const int rt = cu.pm % RT, h = cu.pn, b = cu.pm / RT;
        const bool has_next = So.next(ui + 1, nu);
        const bf16_t* Vbh = Vt + (size_t)(h * 256) * 1024 + b * 256;
        AT_BEGIN(1)
        if (ui != 0) asm volatile("s_waitcnt vmcnt(16) lgkmcnt(0)" ::: "memory"); else asm volatile("s_waitcnt vmcnt(0) lgkmcnt(0)" ::: "memory");
        ATT_BAR();
        AT_END(1);
        AT_BEGIN(2)
        f32x16a sacc[8];
#pragma unroll
        for (int half = 0; half < 2; ++half) {
            LAS unsigned char* ks_ = lds + half * 65536;
#pragma unroll
            for (int kt = 0; kt < 4; ++kt) { f32x16a a;
#pragma unroll
                for (int r = 0; r < 16; ++r) a[r] = 0.f;
                const int key = kt * 32 + n;
#pragma unroll
                for (int k0 = 0; k0 < 16; k0 += 4) { bf16x8 kf[4];
#pragma unroll
                    for (int ks = 0; ks < 4; ++ks) kf[ks] = *(const LAS bf16x8*)(ks_ + key * 512 + (((2 * (k0 + ks) + hh) ^ (key & 15)) * 16));
#pragma unroll
                    for (int ks = 0; ks < 4; ++ks) a = __builtin_amdgcn_mfma_f32_32x32x16_bf16(kf[ks], qf[k0 + ks], a, 0, 0, 0); }
                sacc[half * 4 + kt] = a; }
            asm volatile("s_waitcnt lgkmcnt(0)" ::: "memory"); ATT_BAR();
            attn_dma_v(half ? slot1 : slot0, Vbh, half, wave, lane);
        }
        AT_END(2);
        AT_BEGIN(3)
        float mx = -3.0e38f;
#pragma unroll
        for (int t = 0; t < 8; ++t)
#pragma unroll
            for (int r = 0; r < 16; ++r) mx = fmaxf(mx, sacc[t][r]);
        mx = fmaxf(mx, bpx(mx, 32, lane));
        float sum = 0.f; bf16x8 pf[16];
#pragma unroll
        for (int t = 0; t < 8; ++t) {
#pragma unroll
            for (int r = 0; r < 16; ++r) { const float p = __builtin_amdgcn_exp2f(sacc[t][r] - mx); sacc[t][r] = p; sum += p; }
#pragma unroll
            for (int s = 0; s < 2; ++s) { u32x4 w; w.x = pg8::cvt_pk_bf16(sacc[t][8 * s], sacc[t][8 * s + 1]); w.y = pg8::cvt_pk_bf16(sacc[t][8 * s + 2], sacc[t][8 * s + 3]);
                w.z = pg8::cvt_pk_bf16(sacc[t][8 * s + 4], sacc[t][8 * s + 5]); w.w = pg8::cvt_pk_bf16(sacc[t][8 * s + 6], sacc[t][8 * s + 7]); pf[2 * t + s] = __builtin_bit_cast(bf16x8, w); } }
        sum += bpx(sum, 32, lane);
        const float inv = 1.0f / sum;
        AT_END(3);
        AT_BEGIN(4)
        f32x16a oacc[8];
#pragma unroll
        for (int dt = 0; dt < 8; ++dt)
#pragma unroll
            for (int r = 0; r < 16; ++r) oacc[dt][r] = 0.f;
        if (!has_next) nu = cu;
        const bf16_t* Kn = Km + (size_t)((nu.pm / RT) * 256) * 1024 + nu.pn * 256;
#pragma unroll
        for (int half = 0; half < 2; ++half) {
            if (half == 0 || has_next) asm volatile("s_waitcnt vmcnt(8)" ::: "memory"); else asm volatile("s_waitcnt vmcnt(0)" ::: "memory");
            ATT_BAR();
            LAS unsigned char* vs_ = lds + half * 65536;
#pragma unroll
            for (int dt = 0; dt < 8; ++dt) { const int dv = dt * 32 + n;
#pragma unroll
                for (int s0 = 0; s0 < 8; s0 += 4) { bf16x8 vf[4];
#pragma unroll
                    for (int s8 = 0; s8 < 4; ++s8) vf[s8] = *(const LAS bf16x8*)(vs_ + dv * 256 + (((2 * (s0 + s8) + hh) ^ (dv & 15)) * 16));
#pragma unroll
                    for (int s8 = 0; s8 < 4; ++s8) oacc[dt] = __builtin_amdgcn_mfma_f32_32x32x16_bf16(vf[s8], pf[half * 8 + s0 + s8], oacc[dt], 0, 0, 0); } }
            asm volatile("s_waitcnt lgkmcnt(0)" ::: "memory"); ATT_BAR();
            if (has_next) attn_dma_k(half ? slot1 : slot0, Kn, half, wave, lane);
        }
        { const int hq = nu.pn; const size_t qrow = (size_t)nu.pm * 256 + wave * 32 + n;
#pragma unroll
          for (int ks = 0; ks < 16; ++ks) qf[ks] = *(const bf16x8*)(q + qrow * 1024 + hq * 256 + ks * 16 + hh * 8); }
        AT_END(4);
        AT_BEGIN(5)
        bf16_t* obase = o + ((size_t)b * S + rt * 256 + wave * 32) * 1024 + h * 256;
#pragma unroll
        for (int dt = 0; dt < 8; ++dt) {
#pragma unroll
            for (int rg = 0; rg < 4; ++rg) { const f32x16a& oa = oacc[dt]; u32x2 w; w.x = pg8::cvt_pk_bf16(oa[4 * rg] * inv, oa[4 * rg + 1] * inv); w.y = pg8::cvt_pk_bf16(oa[4 * rg + 2] * inv, oa[4 * rg + 3] * inv);
                *(LAS u32x2*)(ost + n * 64 + (8 * rg + 4 * hh) * 2) = w; }
            asm volatile("s_waitcnt lgkmcnt(0)" ::: "memory");
            { const int row = lane >> 1, hf = lane & 1; const u32x4 t0 = *(const LAS u32x4*)(ost + row * 64 + hf * 32), t1 = *(const LAS u32x4*)(ost + row * 64 + hf * 32 + 16);
              bf16_t* dst = obase + (size_t)row * 1024 + dt * 32 + hf * 16; *(u32x4*)dst = t0; *(u32x4*)(dst + 8) = t1; }
            asm volatile("s_waitcnt lgkmcnt(0)" ::: "memory");
        }
        AT_END(5);
        cu = nu; have = has_next;
    }
    asm volatile("s_waitcnt vmcnt(0) lgkmcnt(0)" ::: "memory"); ATT_BAR();
}
constexpr int SEGC = 8, SEGT = 512, NSEG = S / SEGT, NBH = NBT * 4;
constexpr int P_AQ = 0, P_AF = 512, P_AI = 1024, P_AZ = 1536, P_GQ = 2048, P_GK = 2304, P_GV = 2560, P_GZ = 3072, P_MU = 3584, P_MZ = 4096;
constexpr int USZ = 16384 + 256;
constexpr int L_Q0 = 0, L_KM = 16384, L_QM = 32768, L_RF = 49152, L_ST = 65536, L_V0 = 98304, L_V1 = 114688, L_CV = 132096, L_CST = 148480;
constexpr int C_G = 0, C_SKIP = 512, C_ADEC = 1024, C_NVEC = 1536  , C_DINT = 2560, C_DPART = 2816, C_C1 = 3328, C_W = 3840  , C_HALO = 12544  , C_NINC = 14592  ;
typedef float f32x16 __attribute__((ext_vector_type(16)));
typedef short s16x4 __attribute__((ext_vector_type(4)));

__device__ __forceinline__ unsigned off_b(unsigned row, unsigned ch) { return 256u * row + 16u * (ch ^ (((row & 3u) << 2) | ((row >> 2) & 3u))); }
__device__ __forceinline__ unsigned rr_addr(unsigned lane, unsigned rowbase, unsigned s) { return off_b(rowbase + (lane & 31u), 2u * s + (lane >> 5)); }
__device__ __forceinline__ unsigned tr_addr(unsigned lane, unsigned c, unsigned ks, unsigned t) { const unsigned h = lane >> 5, blk = (lane >> 4) & 1u, q = (lane & 15u) >> 2, p = lane & 3u; return off_b(16u * ks + 8u * h + 4u * t + q, 4u * c + 2u * blk + (p >> 1)) + 8u * (p & 1u); }
__device__ __forceinline__ bf16x8 ld_frag(LAS unsigned char* p) { return *(const LAS bf16x8*)p; }
__device__ __forceinline__ bf16x8 tr_frag(LAS unsigned char* img, unsigned lane, unsigned c, unsigned ks) {
    const s16x4 lo = __builtin_bit_cast(s16x4, __builtin_amdgcn_ds_read_tr16_b64_v4i16((LAS s16x4*)(img + tr_addr(lane, c, ks, 0))));
    const s16x4 hi = __builtin_bit_cast(s16x4, __builtin_amdgcn_ds_read_tr16_b64_v4i16((LAS s16x4*)(img + tr_addr(lane, c, ks, 1))));
    return (bf16x8){lo[0], lo[1], lo[2], lo[3], hi[0], hi[1], hi[2], hi[3]}; }
__device__ __forceinline__ bf16x8 tr_fragb(LAS unsigned char* img, const unsigned (&tb)[2], unsigned ks) {
    const s16x4 lo = __builtin_bit_cast(s16x4, __builtin_amdgcn_ds_read_tr16_b64_v4i16((LAS s16x4*)(img + tb[0] + 4096u * ks)));
    const s16x4 hi = __builtin_bit_cast(s16x4, __builtin_amdgcn_ds_read_tr16_b64_v4i16((LAS s16x4*)(img + tb[1] + 4096u * ks)));
    return (bf16x8){lo[0], lo[1], lo[2], lo[3], hi[0], hi[1], hi[2], hi[3]}; }
__device__ __forceinline__ void glds16(const void* gsrc, unsigned lds_dst) { unsigned keep;
    asm volatile("s_mov_b32 %0, m0\n\ts_mov_b32 m0, %2\n\ts_nop 0\n\tglobal_load_lds_dwordx4 %1, off\n\ts_mov_b32 m0, %0" : "=&s"(keep) : "v"(gsrc), "s"(lds_dst) : "memory"); }
__device__ __forceinline__ void glds4(const void* gsrc, unsigned lds_dst) { unsigned keep;
    asm volatile("s_mov_b32 %0, m0\n\ts_mov_b32 m0, %2\n\ts_nop 0\n\tglobal_load_lds_dword %1, off\n\ts_mov_b32 m0, %0" : "=&s"(keep) : "v"(gsrc), "s"(lds_dst) : "memory"); }
__device__ __forceinline__ void dma_tile(LAS unsigned char* img, const bf16_t* src, size_t pitch, int npieces, int wave, int lane) {
    const unsigned base = (unsigned)(size_t)img; asm volatile("" : "+v"(lane));
    for (int p = wave; p < npieces; p += 8) { const int row = p * 4 + (lane >> 4), lc = (lane & 15) ^ (((row & 3) << 2) | ((row >> 2) & 3));
        glds16((const void*)(src + (ptrdiff_t)row * (ptrdiff_t)pitch + lc * 8), (unsigned)__builtin_amdgcn_readfirstlane((int)(base + p * 1024))); } }
template <int CTRL, int RM> __device__ __forceinline__ float dpp1(float x) { return __builtin_bit_cast(float, __builtin_amdgcn_update_dpp(0x3f800000, __builtin_bit_cast(int, x), CTRL, RM, 0xF, false)); }
template <int CTRL, int RM> __device__ __forceinline__ float dpp0(float x) { return __builtin_bit_cast(float, __builtin_amdgcn_update_dpp(0, __builtin_bit_cast(int, x), CTRL, RM, 0xF, true)); }
__device__ __forceinline__ float wave_scan(float v, int lane) {
    (void)lane;
    v += dpp0<0x111, 0xF>(v); v += dpp0<0x112, 0xF>(v); v += dpp0<0x114, 0xF>(v); v += dpp0<0x118, 0xF>(v);
    v += dpp0<0x142, 0xA>(v); v += dpp0<0x143, 0xC>(v);
    return v; }
__device__ __forceinline__ float shx(float x, int mask, int lane) { return __builtin_bit_cast(float, __builtin_amdgcn_ds_bpermute((lane ^ mask) << 2, __builtin_bit_cast(int, x))); }
__device__ __forceinline__ float sum8(float v) { v += dpp0<0xB1, 0xF>(v); v += dpp0<0x4E, 0xF>(v); v += dpp0<0x141, 0xF>(v); return v; }
__device__ __forceinline__ float rdlane(float x, int l) { return __builtin_bit_cast(float, __builtin_amdgcn_readlane(__builtin_bit_cast(int, x), l)); }
__device__ __forceinline__ float ex2(float x) { return __builtin_amdgcn_exp2f(x); }
__device__ __forceinline__ float h2f(unsigned short h) { return (float)__builtin_bit_cast(_Float16, h); }
__device__ __forceinline__ u32x4 pack8(const float (&v)[8]) { u32x4 w; w.x = pg8::cvt_pk_bf16(v[0], v[1]); w.y = pg8::cvt_pk_bf16(v[2], v[3]); w.z = pg8::cvt_pk_bf16(v[4], v[5]); w.w = pg8::cvt_pk_bf16(v[6], v[7]); return w; }
__device__ __forceinline__ float log2sig(float x) { return fminf(x, 0.f) * 1.4426950408889634f - __builtin_amdgcn_logf(1.0f + __builtin_amdgcn_exp2f(fabsf(x) * -1.4426950408889634f)); }

struct MixArgs {
    const bf16_t* proj; const float* ext; bf16_t* mix; float* U;
    const float *hgrn_norm, *gla_up, *gla_bias, *gla_norm, *conv_w, *conv_b, *wq, *wk, *wv, *ig_bias, *fg_bias, *skip, *mnorm;
};

struct Fac { float E0, Km, a63; };
__device__ __forceinline__ Fac factors(float b, float kboost, int lane) {
    (void)lane; Fac f; f.E0 = ex2(fmaxf(b, -120.f)); f.Km = __builtin_amdgcn_rcpf(f.E0) * ex2(kboost); f.a63 = rdlane(f.E0, 63); return f; }
__device__ __forceinline__ f32x16 mfma32(bf16x8 a, bf16x8 b, f32x16 c) { return __builtin_amdgcn_mfma_f32_32x32x16_bf16(a, b, c, 0, 0, 0); }

#ifdef TPROBE
#ifndef TP_PASS
#define TP_PASS 1
#endif
#ifndef TP_MIX
#define TP_MIX -1
#endif
#define TP_BEGIN(k) unsigned long long tp_t0_##k = 0; if (TPROBE == (k) && PASS == TP_PASS && (TP_MIX < 0 || MIXER == TP_MIX)) tp_t0_##k = __builtin_amdgcn_s_memrealtime();
#define TP_END(k) do { if (TPROBE == (k) && PASS == TP_PASS && (TP_MIX < 0 || MIXER == TP_MIX) && wave == 0) { const unsigned long long d_ = __builtin_amdgcn_s_memrealtime() - tp_t0_##k; if (lane == 0) *(volatile LAS unsigned long long*)(lds + LDS_TP) += d_; } } while (0)
#else
#define TP_BEGIN(k)
#define TP_END(k) do { } while (0)
#endif
#ifndef FK_KEEP_B1
#define FK_KEEP_B1 0
#endif
#define FK_BAR() do { asm volatile("" ::: "memory"); __builtin_amdgcn_s_barrier(); asm volatile("" ::: "memory"); } while (0)
template <int MIXER, int PASS>
__device__ __forceinline__ void mix_unit(LAS unsigned char* lds, const MixArgs& A, int bh, int seg, int wv) {
    constexpr int DK = (MIXER == 1) ? 64 : 128, NKS = DK / 16, NG = DK / 64;
    constexpr int NT = (DK == 128) ? 2 : 1;
    constexpr int LEAD = (PASS == 0 && MIXER != 2) ? 2 : 1;
    int tid_ = wv * 64 + fk_lane(); asm volatile("" : "+v"(tid_));
    const int tid = tid_, lane = tid & 63, wave = wv;
    TP_BEGIN(6)
    const int b = bh >> 2, h = bh & 3;
    const size_t row0 = (size_t)b * S + (size_t)seg * SEGT;
    LAS float* cst = (LAS float*)(lds + L_CST);
    LAS float* c_g = cst + C_G / 4; LAS float* c_skip = cst + C_SKIP / 4; LAS float* c_adec = cst + C_ADEC / 4; LAS float* c_c1 = cst + C_C1 / 4; LAS float* c_nbuf = cst + C_NVEC / 4; LAS float* c_w = cst + C_W / 4; LAS float* c_dint = cst + C_DINT / 4; LAS float* c_dpart = cst + C_DPART / 4; LAS float* c_ninc = cst + C_NINC / 4;
    float* slot = A.U + (size_t)((MIXER * NBH + bh) * NSEG + seg) * USZ;
    const int td = (DK == 128) ? (wave >> 1) : (wave >> 2), te0 = (DK == 128) ? (wave & 1) * 2 : (wave & 3);
    const int ti = wave >> 2, te = wave & 3;
    const int cq = MIXER == 0 ? P_AQ + h * 128 : MIXER == 1 ? P_GQ + h * 64 : P_MU + h * 128;
    const int ck = MIXER == 0 ? P_AF + h * 128 : P_GK + h * 64;
    const int cv = MIXER == 0 ? P_AI + h * 128 : P_GV + h * 128;
    const int cz = MIXER == 0 ? P_AZ + h * 128 : MIXER == 1 ? P_GZ + h * 128 : P_MZ + h * 128;
    const bf16_t* pr = A.proj + row0 * NPROJ;
    auto fbuf = [&](int cn) -> LAS unsigned char* { if (PASS == 1) return lds + L_RF; const int r = cn % 3; return lds + (r == 0 ? L_RF : r == 1 ? L_Q0 : L_QM); };
    auto vbuf = [&](int cn) -> LAS unsigned char* { if (MIXER == 2) return lds + L_V0; if (PASS == 1) return lds + ((cn & 1) ? L_V1 : L_V0); const int r = cn % 3; return lds + (r == 0 ? L_V0 : r == 1 ? L_V1 : L_ST); };
    auto ubuf = [&](int cn) -> LAS unsigned char* { return lds + ((cn & 1) ? L_RF : L_V1); };
    auto hbuf = [&](int cn) -> LAS unsigned char* { return lds + L_CST + C_HALO + (cn & 1) * 1024; };
    auto cix = [&](int cn) -> int { return PASS == 0 ? SEGC - 1 - cn : cn; };
    auto issue_dma = [&](int cn) {
        const bf16_t* prn = pr + (size_t)cix(cn) * 64 * NPROJ;
        if (MIXER == 2) { dma_tile(ubuf(cn), prn + cq, NPROJ, 16, wave, lane); dma_tile(hbuf(cn), prn + cq - 4 * (ptrdiff_t)NPROJ, NPROJ, 1, wave, lane); }
        else { if (PASS == 1) dma_tile(lds + L_CV, prn + cq, NPROJ, 16, wave, lane); dma_tile(fbuf(cn), prn + ck, NPROJ, 16, wave, lane); dma_tile(vbuf(cn), prn + cv, NPROJ, 16, wave, lane); } };
    issue_dma(0);
    if (LEAD == 2) issue_dma(1);
    { const int t127 = tid & 127, t63 = tid & 63;
      float l_g, l_skip = 0.f, l_n = 0.f, l_w0 = 0.f, l_w1 = 0.f, l_w2 = 0.f, l_w3 = 0.f, l_w4 = 0.f;
      l_g = MIXER == 0 ? A.hgrn_norm[t127] : MIXER == 1 ? A.gla_norm[t127] : A.mnorm[h * 128 + t127];
      if (MIXER == 2) { l_skip = A.skip[h * 128 + t127]; if (PASS == 1) l_n = slot[16384 + 128 + t127];
          l_w0 = A.wq[h * 512 + tid]; l_w1 = A.wk[h * 512 + tid]; l_w2 = A.wv[h * 512 + tid]; l_w3 = A.conv_w[(tid >> 7) * 512 + h * 128 + t127]; l_w4 = A.conv_b[h * 128 + t127]; }
      if (MIXER == 1) { l_w0 = A.gla_up[(tid >> 6) * 256 + h * 64 + t63]; l_w1 = A.gla_up[((tid + 512) >> 6) * 256 + h * 64 + t63]; l_w2 = A.gla_bias[h * 64 + t63]; }
      if (tid < 128) { c_g[tid] = l_g; c_skip[tid] = l_skip; c_nbuf[tid] = l_n; }
      if (MIXER == 2) { c_w[tid] = l_w0; c_w[512 + tid] = l_w1; c_w[1024 + tid] = l_w2; c_w[1536 + tid] = l_w3; if (tid < 128) c_w[2048 + tid] = l_w4; }
      if (MIXER == 1) { c_w[tid] = l_w0; c_w[512 + tid] = l_w1; if (tid < 64) c_w[1024 + tid] = l_w2; } }
    f32x16 st[NT];
#pragma unroll
    for (int s = 0; s < NT; ++s)
#pragma unroll
        for (int r = 0; r < 16; ++r) st[s][r] = (PASS == 1) ? slot[((wave * NT + s) * 16 + r) * 64 + lane] : 0.f;
    float carry[NG * 8];
#pragma unroll
    for (int i = 0; i < NG * 8; ++i) carry[i] = 0.f;
    float carry_s = 0.f;
    f32x16 nacc;
#pragma unroll
    for (int r = 0; r < 16; ++r) nacc[r] = 0.f;
    u32x4 zraw[2]; f32x4 gv[4], gvn[4]; float emi = 0.f, emf = 0.f;
    zraw[0] = zraw[1] = (u32x4){0u, 0u, 0u, 0u};
#pragma unroll
    for (int i = 0; i < 4; ++i) { gv[i] = (f32x4){0.f, 0.f, 0.f, 0.f}; gvn[i] = gv[i]; }
    auto prefetch = [&](int cn, bool first) {
        const float* er = A.ext + (row0 + (size_t)cix(cn) * 64 + lane) * 32;
        if (MIXER == 1) {
#pragma unroll
            for (int i = 0; i < 4; ++i) { const f32x4 t4 = *(const f32x4*)(er + 4 * i); if (first) gv[i] = t4; else gvn[i] = t4; } }
        if (MIXER == 2 && wave == 0) { int lg = lane; asm volatile("" : "+v"(lg)); const float* eg = A.ext + (row0 + (size_t)cix(cn) * 64 + lg) * 32 + 16 + h;
            glds4((const void*)eg, (unsigned)__builtin_amdgcn_readfirstlane((int)(size_t)(lds + L_CST + C_C1))); glds4((const void*)(eg + 4), (unsigned)__builtin_amdgcn_readfirstlane((int)(size_t)(lds + L_CST + C_C1 + 256))); } };
    const float ig_b = (MIXER == 2) ? __builtin_bit_cast(float, __builtin_amdgcn_readfirstlane(__builtin_bit_cast(int, A.ig_bias[h]))) : 0.f;
    const float fg_b = (MIXER == 2) ? __builtin_bit_cast(float, __builtin_amdgcn_readfirstlane(__builtin_bit_cast(int, A.fg_bias[h]))) : 0.f;
    prefetch(0, true);
    if (MIXER == 1) {
#pragma unroll
        for (int i = 0; i < 4; ++i) asm volatile("" : "+v"(gv[i])); }
    if (PASS == 1) {
#pragma unroll
        for (int s = 0; s < NT; ++s) { const int e = 32 * (te0 + s) + (lane & 31);
#pragma unroll
            for (int rg = 0; rg < 4; ++rg) { const int d0 = 32 * td + 8 * rg + 4 * (lane >> 5);
                u32x2 w; w.x = pg8::cvt_pk_bf16(st[s][4 * rg], st[s][4 * rg + 1]); w.y = pg8::cvt_pk_bf16(st[s][4 * rg + 2], st[s][4 * rg + 3]);
                *(LAS u32x2*)(lds + L_ST + off_b(e, d0 >> 3) + (d0 & 7) * 2) = w; } } }

    TP_END(6);
#pragma unroll 1
    for (int c = 0; c < SEGC; ++c) {
        TP_BEGIN(1)
        const int t0 = seg * SEGT + cix(c) * 64;
        LAS unsigned char* Vimg = vbuf(c);
        if (PASS == 1) { if (c > 0) asm volatile("s_waitcnt vmcnt(2) lgkmcnt(0)" ::: "memory"); else asm volatile("s_waitcnt vmcnt(0) lgkmcnt(0)" ::: "memory"); }
        else if (LEAD == 2) { if (c + 1 < SEGC) asm volatile("s_waitcnt vmcnt(4) lgkmcnt(0)" ::: "memory"); else asm volatile("s_waitcnt vmcnt(0) lgkmcnt(0)" ::: "memory"); }
        else asm volatile("s_waitcnt vmcnt(0) lgkmcnt(0)" ::: "memory");
        FK_BAR();
        TP_END(1);
        TP_BEGIN(2)
        if (PASS == 1) { int lz = lane; asm volatile("" : "+v"(lz)); const int tz = wave * 64 + lz; const bf16_t* zp = pr + (size_t)(c * 64 + (tz >> 3)) * NPROJ + cz + (tz & 7) * 16; zraw[0] = *(const u32x4*)zp; zraw[1] = *(const u32x4*)(zp + 8); }
        if (c > 0) {
            if (MIXER == 1) {
#pragma unroll
                for (int i = 0; i < 4; ++i) { gv[i] = gvn[i]; asm volatile("" : "+v"(gv[i])); } } }
        if (MIXER == 2 && c + 1 < SEGC) issue_dma(c + 1);
        Fac fsc; fsc.E0 = fsc.Km = fsc.a63 = 0.f;
        if (MIXER == 2) {
            emi = c_c1[lane]; emf = c_c1[64 + lane];
            const float mi = emi + ig_b, mf = emf + fg_b;
            const float bs = wave_scan(log2sig(mf), lane);
            if (PASS == 0) { const float r63 = rdlane(bs, 63); fsc.E0 = 0.f; fsc.Km = ex2(r63 - bs + carry_s + mi * 1.4426950408889634f); fsc.a63 = 0.f; carry_s += r63; }
            else fsc = factors(bs, mi * 1.4426950408889634f, lane); }
        bf16x8 rawq[NG], rawk[NG];
        if (MIXER != 2) {
            if (PASS == 0 && !FK_KEEP_B1) { if (MIXER == 1 && c + 1 < SEGC) prefetch(c + 1, false); if (c + LEAD < SEGC) issue_dma(c + LEAD); }
#pragma unroll
            for (int g = 0; g < NG; ++g) { rawk[g] = ld_frag(fbuf(c) + off_b(lane, wave + 8 * g)); rawq[g] = rawk[g]; if (PASS == 1) rawq[g] = ld_frag(lds + L_CV + off_b(lane, wave + 8 * g)); }
            if (PASS == 1 || FK_KEEP_B1) {
                asm volatile("s_waitcnt lgkmcnt(0)" ::: "memory"); FK_BAR();
                if (MIXER == 1 && c + 1 < SEGC) prefetch(c + 1, false);
                if (c + LEAD < SEGC) issue_dma(c + LEAD); }
        }
#ifndef REP_S0
#define REP_S0 1
#endif
#ifndef REP_S0M
#define REP_S0M 0
#endif
        _Pragma("unroll 1") for (int rep0 = 0; rep0 < ((PASS == 1 && MIXER == REP_S0M) ? REP_S0 : 1); ++rep0)
#pragma unroll
        for (int g = 0; g < NG; ++g) { const int cc = wave + 8 * g; float q8[8], k8[8], gl8[8], v8[8], ca8[8];
            if (MIXER == 0) {
#pragma unroll
                for (int j = 0; j < 8; ++j) { gl8[j] = h2f((unsigned short)rawk[g][j]); q8[j] = bf2f((unsigned short)rawq[g][j]); v8[j] = 0.f; ca8[j] = 0.f; }
#pragma unroll
                for (int j = 0; j < 8; ++j) k8[j] = 1.0f - ex2(gl8[j]);
            } else if (MIXER == 1) {
                f32x4 sg0 = *(const LAS f32x4*)(c_w + 1024 + cc * 8), sg1 = *(const LAS f32x4*)(c_w + 1024 + cc * 8 + 4);
#pragma unroll
                for (int i0 = 0; i0 < 16; i0 += 4) { f32x4 wa[4], wb[4];
#pragma unroll
                    for (int s = 0; s < 4; ++s) { wa[s] = *(const LAS f32x4*)(c_w + (i0 + s) * 64 + cc * 8); wb[s] = *(const LAS f32x4*)(c_w + (i0 + s) * 64 + cc * 8 + 4); }
                    asm volatile("" ::: "memory");
#pragma unroll
                    for (int s = 0; s < 4; ++s) { const float gi = gv[i0 >> 2][s]; sg0 += gi * wa[s]; sg1 += gi * wb[s]; } }
#pragma unroll
                for (int j = 0; j < 8; ++j) { const float sj = j < 4 ? sg0[j & 3] : sg1[j & 3]; gl8[j] = log2sig(sj) * 0.0625f; q8[j] = bf2f((unsigned short)rawq[g][j]); k8[j] = bf2f((unsigned short)rawk[g][j]); v8[j] = 0.f; ca8[j] = 0.f; }
            } else {
                f32x4 u4[4][2];
#pragma unroll
                for (int k = 0; k < 4; ++k) { const int rr = lane - k; const bf16x8 ru = ld_frag(rr >= 0 ? ubuf(c) + off_b(rr, cc) : hbuf(c) + off_b(4 + rr, cc));
#pragma unroll
                    for (int j = 0; j < 8; ++j) u4[k][j >> 2][j & 3] = bf2f((unsigned short)ru[j]);
                    if (t0 == 0 && rr < 0) { u4[k][0] = (f32x4){0.f, 0.f, 0.f, 0.f}; u4[k][1] = u4[k][0]; } }
                f32x4 ac0 = *(const LAS f32x4*)(c_w + 2048 + cc * 8), ac1 = *(const LAS f32x4*)(c_w + 2048 + cc * 8 + 4);
                { f32x4 cw0[4], cw1[4];
#pragma unroll
                  for (int tap = 0; tap < 4; ++tap) { cw0[tap] = *(const LAS f32x4*)(c_w + 1536 + tap * 128 + cc * 8); cw1[tap] = *(const LAS f32x4*)(c_w + 1536 + tap * 128 + cc * 8 + 4); }
                  asm volatile("" ::: "memory");
#pragma unroll
                  for (int tap = 0; tap < 4; ++tap) { ac0 += u4[3 - tap][0] * cw0[tap]; ac1 += u4[3 - tap][1] * cw1[tap]; } }
#pragma unroll
                for (int j = 0; j < 8; ++j) { const float aj = j < 4 ? ac0[j & 3] : ac1[j & 3]; ca8[j] = aj * pg8::fsigm(aj); }
                f32x4 qv4[2], kv4[2], vv4[2];
#pragma unroll
                for (int hg = 0; hg < 2; ++hg) { qv4[hg] = (f32x4){0.f, 0.f, 0.f, 0.f}; kv4[hg] = qv4[hg]; vv4[hg] = qv4[hg]; }
#pragma unroll
                for (int i0 = 0; i0 < 4; i0 += 2) { f32x4 wq4[2][2], wk4[2][2], wv4[2][2];
#pragma unroll
                    for (int ii = 0; ii < 2; ++ii)
#pragma unroll
                        for (int hg = 0; hg < 2; ++hg) { const int i = i0 + ii; wq4[ii][hg] = *(const LAS f32x4*)(c_w + (cc * 2 + hg) * 16 + i * 4); wk4[ii][hg] = *(const LAS f32x4*)(c_w + 512 + (cc * 2 + hg) * 16 + i * 4); wv4[ii][hg] = *(const LAS f32x4*)(c_w + 1024 + (cc * 2 + hg) * 16 + i * 4); }
                    asm volatile("" ::: "memory");
#pragma unroll
                    for (int ii = 0; ii < 2; ++ii)
#pragma unroll
                        for (int hg = 0; hg < 2; ++hg) { const int i = i0 + ii; qv4[hg] += ca8[hg * 4 + i] * wq4[ii][hg]; kv4[hg] += ca8[hg * 4 + i] * wk4[ii][hg]; vv4[hg] += u4[0][hg][i] * wv4[ii][hg]; } }
#pragma unroll
                for (int j = 0; j < 8; ++j) { q8[j] = qv4[j >> 2][j & 3]; k8[j] = kv4[j >> 2][j & 3] * 0.08838834764831845f; v8[j] = vv4[j >> 2][j & 3]; gl8[j] = 0.f; }
            }
            float E0[8], Km[8], a63[8];
            if (MIXER != 2) {
                float bb[8];
#pragma unroll
                for (int j = 0; j < 8; ++j) bb[j] = gl8[j];
#pragma unroll
                for (int j = 0; j < 8; ++j) bb[j] += dpp0<0x111, 0xF>(bb[j]);
#pragma unroll
                for (int j = 0; j < 8; ++j) bb[j] += dpp0<0x112, 0xF>(bb[j]);
#pragma unroll
                for (int j = 0; j < 8; ++j) bb[j] += dpp0<0x114, 0xF>(bb[j]);
#pragma unroll
                for (int j = 0; j < 8; ++j) bb[j] += dpp0<0x118, 0xF>(bb[j]);
                asm("s_nop 1\n\t"
                    "v_add_f32_dpp %0, %0, %0 row_bcast:15 row_mask:0xa bank_mask:0xf\n\tv_add_f32_dpp %1, %1, %1 row_bcast:15 row_mask:0xa bank_mask:0xf\n\t"
                    "v_add_f32_dpp %2, %2, %2 row_bcast:15 row_mask:0xa bank_mask:0xf\n\tv_add_f32_dpp %3, %3, %3 row_bcast:15 row_mask:0xa bank_mask:0xf\n\t"
                    "v_add_f32_dpp %4, %4, %4 row_bcast:15 row_mask:0xa bank_mask:0xf\n\tv_add_f32_dpp %5, %5, %5 row_bcast:15 row_mask:0xa bank_mask:0xf\n\t"
                    "v_add_f32_dpp %6, %6, %6 row_bcast:15 row_mask:0xa bank_mask:0xf\n\tv_add_f32_dpp %7, %7, %7 row_bcast:15 row_mask:0xa bank_mask:0xf\n\t"
                    "s_nop 1\n\t"
                    "v_add_f32_dpp %0, %0, %0 row_bcast:31 row_mask:0xc bank_mask:0xf\n\tv_add_f32_dpp %1, %1, %1 row_bcast:31 row_mask:0xc bank_mask:0xf\n\t"
                    "v_add_f32_dpp %2, %2, %2 row_bcast:31 row_mask:0xc bank_mask:0xf\n\tv_add_f32_dpp %3, %3, %3 row_bcast:31 row_mask:0xc bank_mask:0xf\n\t"
                    "v_add_f32_dpp %4, %4, %4 row_bcast:31 row_mask:0xc bank_mask:0xf\n\tv_add_f32_dpp %5, %5, %5 row_bcast:31 row_mask:0xc bank_mask:0xf\n\t"
                    "v_add_f32_dpp %6, %6, %6 row_bcast:31 row_mask:0xc bank_mask:0xf\n\tv_add_f32_dpp %7, %7, %7 row_bcast:31 row_mask:0xc bank_mask:0xf"
                    : "+v"(bb[0]), "+v"(bb[1]), "+v"(bb[2]), "+v"(bb[3]), "+v"(bb[4]), "+v"(bb[5]), "+v"(bb[6]), "+v"(bb[7]));
                if (PASS == 0) {
#pragma unroll
                    for (int j = 0; j < 8; ++j) { const float r63 = rdlane(bb[j], 63); Km[j] = ex2(r63 - bb[j] + carry[g * 8 + j]); carry[g * 8 + j] += r63; E0[j] = 0.f; a63[j] = 0.f; }
                } else {
#pragma unroll
                    for (int j = 0; j < 8; ++j) { E0[j] = ex2(fmaxf(bb[j], -120.f)); Km[j] = __builtin_amdgcn_rcpf(E0[j]); }
#pragma unroll
                    for (int j = 0; j < 8; ++j) a63[j] = rdlane(E0[j], 63);
                }
            }
            float o0[8], o2[8];
#pragma unroll
            for (int j = 0; j < 8; ++j) { if (MIXER == 2) { o0[j] = q8[j] * fsc.E0; o2[j] = k8[j] * fsc.Km; }
                else { o0[j] = q8[j] * E0[j]; o2[j] = k8[j] * Km[j]; } }
            if (PASS == 1 && lane == 63) {
                if (MIXER == 2) { const f32x4 a4 = (f32x4){fsc.a63, fsc.a63, fsc.a63, fsc.a63}; *(LAS f32x4*)(c_adec + cc * 8) = a4; *(LAS f32x4*)(c_adec + cc * 8 + 4) = a4; }
                else { *(LAS f32x4*)(c_adec + cc * 8) = (f32x4){a63[0], a63[1], a63[2], a63[3]}; *(LAS f32x4*)(c_adec + cc * 8 + 4) = (f32x4){a63[4], a63[5], a63[6], a63[7]}; } }
            *(LAS u32x4*)(lds + L_KM + off_b(lane, cc)) = pack8(o2);
            if (PASS == 1) *(LAS u32x4*)(lds + L_Q0 + off_b(lane, cc)) = pack8(o0);
            if (MIXER == 2) { *(LAS u32x4*)(lds + L_V0 + off_b(lane, cc)) = pack8(v8); if (PASS == 1) *(LAS u32x4*)(lds + L_CV + off_b(lane, cc)) = pack8(ca8); }
            asm volatile("" ::: "memory");
        }
        asm volatile("s_waitcnt lgkmcnt(0)" ::: "memory"); FK_BAR();
        TP_END(2);
        TP_BEGIN(3)
        if (c + 1 < SEGC && MIXER == 2) prefetch(c + 1, false);
        unsigned rrb[8], trE[2], trD[2], trS[NT][2];
        { int lb = lane; asm volatile("" : "+v"(lb));
#pragma unroll
          for (int s = 0; s < 8; ++s) rrb[s] = rr_addr((unsigned)lb, 0u, (unsigned)s);
#pragma unroll
          for (int t = 0; t < 2; ++t) { trE[t] = tr_addr((unsigned)lb, (unsigned)te, 0u, (unsigned)t); trD[t] = tr_addr((unsigned)lb, (unsigned)td, 0u, (unsigned)t);
#pragma unroll
              for (int s = 0; s < NT; ++s) trS[s][t] = tr_addr((unsigned)lb, (unsigned)(te0 + s), 0u, (unsigned)t); } }
        f32x16 oacc, pacc;
#pragma unroll
        for (int r = 0; r < 16; ++r) { oacc[r] = 0.f; pacc[r] = 0.f; }
        if (PASS == 1) {
            int ln1 = lane; asm volatile("" : "+v"(ln1));
#pragma unroll
            for (int s0 = 0; s0 < NKS; s0 += 4) { bf16x8 fa[4], fb[4];
#pragma unroll
              for (int s = 0; s < 4; ++s) { fa[s] = ld_frag(lds + L_Q0 + 8192 * ti + rrb[s0 + s]); fb[s] = ld_frag(lds + L_ST + 8192 * te + rrb[s0 + s]); }
#pragma unroll
              for (int s = 0; s < 4; ++s) oacc = mfma32(fa[s], fb[s], oacc); }
            if (MIXER == 2) {
                const int tid1 = wave * 64 + ln1, row = tid1 >> 3, sg = tid1 & 7; float dsum = 0.f;
#pragma unroll
                for (int hh = 0; hh < 2; ++hh) { const bf16x8 qf = ld_frag(lds + L_Q0 + off_b(row, 2 * sg + hh));
#pragma unroll
                    for (int j = 0; j < 8; ++j) dsum += bf2f((unsigned short)qf[j]) * c_nbuf[(c & 1) * 128 + sg * 16 + hh * 8 + j]; }
                dsum = sum8(dsum);
                if (sg == 0) c_dint[row] = dsum; }
            const int jb = (wave == 1) ? 1 : 0, ib = (wave == 0) ? 0 : 1;
            if (wave < 3) {
#pragma unroll
                for (int s0 = 0; s0 < NKS; s0 += 4) { bf16x8 fa[4], fb[4];
#pragma unroll
                  for (int s = 0; s < 4; ++s) { fa[s] = ld_frag(lds + L_KM + 8192 * jb + rrb[s0 + s]); fb[s] = ld_frag(lds + L_Q0 + 8192 * ib + rrb[s0 + s]); }
#pragma unroll
                  for (int s = 0; s < 4; ++s) pacc = mfma32(fa[s], fb[s], pacc); }
                if (wave < 2) {
#pragma unroll
                    for (int r = 0; r < 16; ++r) { const int jj = (r & 3) + 8 * (r >> 2) + 4 * (ln1 >> 5); if (jj > (ln1 & 31)) pacc[r] = 0.f; } }
                if (MIXER == 2) { float ps = 0.f;
#pragma unroll
                    for (int r = 0; r < 16; ++r) ps += pacc[r];
                    ps += shx(ps, 32, ln1); if (ln1 < 32) c_dpart[wave * 32 + ln1] = ps; } }
            if (wave < 3) {
                int lnp = lane; asm volatile("" : "+v"(lnp));
#pragma unroll
                for (int rg = 0; rg < 4; ++rg) { u32x2 w; w.x = pg8::cvt_pk_bf16(pacc[4 * rg], pacc[4 * rg + 1]); w.y = pg8::cvt_pk_bf16(pacc[4 * rg + 2], pacc[4 * rg + 3]);
                    *(LAS u32x2*)(lds + L_QM + off_b(32 * ib + (lnp & 31), 4 * jb + rg) + 8 * (lnp >> 5)) = w; } }
            asm volatile("s_waitcnt lgkmcnt(0)" ::: "memory"); FK_BAR();
            TP_END(3);
            int ln2 = lane; asm volatile("" : "+v"(ln2));
            { bf16x8 fa[2], fb[2];
#pragma unroll
              for (int s = 0; s < 2; ++s) { fa[s] = ld_frag(lds + L_QM + 8192 * ti + rrb[s]); fb[s] = tr_fragb(Vimg, trE, s); }
#pragma unroll
              for (int s = 0; s < 2; ++s) oacc = mfma32(fa[s], fb[s], oacc);
              if (ti == 1) {
#pragma unroll
                  for (int s = 0; s < 2; ++s) { fa[s] = ld_frag(lds + L_QM + 8192 + rrb[2 + s]); fb[s] = tr_fragb(Vimg, trE, 2 + s); }
#pragma unroll
                  for (int s = 0; s < 2; ++s) oacc = mfma32(fa[s], fb[s], oacc); } }
        }
        TP_BEGIN(4)
        if (PASS == 0) {
            int ln4 = lane; asm volatile("" : "+v"(ln4));
            const short one_or_zero = ((ln4 & 31) == 0) ? (short)0x3f80 : (short)0;
            const bf16x8 onesB = (bf16x8){one_or_zero, one_or_zero, one_or_zero, one_or_zero, one_or_zero, one_or_zero, one_or_zero, one_or_zero};
#pragma unroll
            for (int h4 = 0; h4 < 4; h4 += 2) { bf16x8 fa[2], fb[NT][2];
#pragma unroll
              for (int s4 = 0; s4 < 2; ++s4) { fa[s4] = tr_fragb(lds + L_KM, trD, h4 + s4);
#pragma unroll
                  for (int s = 0; s < NT; ++s) fb[s][s4] = tr_fragb(Vimg, trS[s], h4 + s4); }
#pragma unroll
              for (int s4 = 0; s4 < 2; ++s4) {
#pragma unroll
                  for (int s = 0; s < NT; ++s) st[s] = mfma32(fa[s4], fb[s][s4], st[s]);
                  if (MIXER == 2 && te0 == 0) nacc = mfma32(fa[s4], onesB, nacc); } }
        } else if (c + 1 < SEGC) {
            int ln4 = lane; asm volatile("" : "+v"(ln4));
            f32x16 tmp[NT];
#pragma unroll
            for (int s = 0; s < NT; ++s)
#pragma unroll
                for (int r = 0; r < 16; ++r) tmp[s][r] = 0.f;
#pragma unroll
            for (int h4 = 0; h4 < 4; h4 += 2) { bf16x8 fa[2], fb[NT][2];
#pragma unroll
              for (int s4 = 0; s4 < 2; ++s4) { fa[s4] = tr_fragb(lds + L_KM, trD, h4 + s4);
#pragma unroll
                  for (int s = 0; s < NT; ++s) fb[s][s4] = tr_fragb(Vimg, trS[s], h4 + s4); }
#pragma unroll
              for (int s4 = 0; s4 < 2; ++s4)
#pragma unroll
                  for (int s = 0; s < NT; ++s) tmp[s] = mfma32(fa[s4], fb[s][s4], tmp[s]); }
#pragma unroll
            for (int rg = 0; rg < 4; ++rg) { const f32x4 av = *(const LAS f32x4*)(c_adec + 32 * td + 8 * rg + 4 * (ln4 >> 5));
#pragma unroll
                for (int s = 0; s < NT; ++s)
#pragma unroll
                    for (int q4 = 0; q4 < 4; ++q4) st[s][4 * rg + q4] = (st[s][4 * rg + q4] + tmp[s][4 * rg + q4]) * av[q4]; }
            if (MIXER == 2 && te0 == 0) {
                f32x16 nt;
#pragma unroll
                for (int r = 0; r < 16; ++r) nt[r] = 0.f;
                const short one_or_zero = ((ln4 & 31) == 0) ? (short)0x3f80 : (short)0;
                const bf16x8 onesB = (bf16x8){one_or_zero, one_or_zero, one_or_zero, one_or_zero, one_or_zero, one_or_zero, one_or_zero, one_or_zero};
#pragma unroll
                for (int s4 = 0; s4 < 4; ++s4) nt = mfma32(tr_fragb(lds + L_KM, trD, s4), onesB, nt);
                if ((ln4 & 31) == 0) {
#pragma unroll
                    for (int rg = 0; rg < 4; ++rg) *(LAS f32x4*)(c_ninc + 32 * td + 8 * rg + 4 * (ln4 >> 5)) = (f32x4){nt[4 * rg], nt[4 * rg + 1], nt[4 * rg + 2], nt[4 * rg + 3]}; } }
#pragma unroll
            for (int s = 0; s < NT; ++s) { const int e = 32 * (te0 + s) + (ln4 & 31);
#pragma unroll
                for (int rg = 0; rg < 4; ++rg) { const int d0 = 32 * td + 8 * rg + 4 * (ln4 >> 5);
                    u32x2 w; w.x = pg8::cvt_pk_bf16(st[s][4 * rg], st[s][4 * rg + 1]); w.y = pg8::cvt_pk_bf16(st[s][4 * rg + 2], st[s][4 * rg + 3]);
                    *(LAS u32x2*)(lds + L_ST + off_b(e, d0 >> 3) + (d0 & 7) * 2) = w; } }
        }
        TP_END(4);
        TP_BEGIN(5)
        if (PASS == 1) {
            int ln5 = lane; asm volatile("" : "+v"(ln5));
            asm volatile("s_waitcnt lgkmcnt(0)" ::: "memory"); FK_BAR();
            if (MIXER == 2 && c + 1 < SEGC) { const int t5 = wave * 64 + ln5; if (t5 < 128) c_nbuf[((c + 1) & 1) * 128 + t5] = c_adec[t5] * (c_nbuf[(c & 1) * 128 + t5] + c_ninc[t5]); }
            LAS unsigned char* ob = lds + L_Q0;
#pragma unroll
            for (int r = 0; r < 16; ++r) { const int i = 32 * ti + (r & 3) + 8 * (r >> 2) + 4 * (ln5 >> 5); *(LAS float*)(ob + i * 512 + (32 * te + (ln5 & 31)) * 4) = oacc[r]; }
            asm volatile("s_waitcnt lgkmcnt(0)" ::: "memory"); FK_BAR();
            const int tid5 = wave * 64 + ln5, row = tid5 >> 3, sg = tid5 & 7, e0 = sg * 16; float ov[16], zv[16];
#pragma unroll
            for (int q4 = 0; q4 < 4; ++q4) { const f32x4 t4 = *(const LAS f32x4*)(ob + row * 512 + (e0 + 4 * q4) * 4);
#pragma unroll
                for (int j = 0; j < 4; ++j) ov[4 * q4 + j] = t4[j]; }
#pragma unroll
            for (int hh = 0; hh < 2; ++hh) { const unsigned zz[4] = {zraw[hh].x, zraw[hh].y, zraw[hh].z, zraw[hh].w};
#pragma unroll
                for (int j = 0; j < 4; ++j) { zv[hh * 8 + 2 * j] = __uint_as_float(zz[j] << 16); zv[hh * 8 + 2 * j + 1] = __uint_as_float(zz[j] & 0xffff0000u); } }
            float y[16];
            if (MIXER == 2) {
                const float den = c_dint[row] + (row < 32 ? c_dpart[row] : c_dpart[32 + (row - 32)] + c_dpart[64 + (row - 32)]);
                const float idn = 1.0f / fmaxf(fabsf(den), 1.0f); float sm = 0.f;
#pragma unroll
                for (int j = 0; j < 16; ++j) { ov[j] *= idn; sm += ov[j]; }
                sm = sum8(sm);
                const float mu = sm * (1.0f / 128.0f); float sq = 0.f;
#pragma unroll
                for (int j = 0; j < 16; ++j) { ov[j] -= mu; sq += ov[j] * ov[j]; }
                sq = sum8(sq);
                const float rs = rsqrtf(sq * (1.0f / 128.0f) + 1e-6f);
#pragma unroll
                for (int hh = 0; hh < 2; ++hh) { const bf16x8 cvf = ld_frag(lds + L_CV + off_b(row, 2 * sg + hh));
#pragma unroll
                    for (int j = 0; j < 8; ++j) { const int e = e0 + hh * 8 + j; y[hh * 8 + j] = (ov[hh * 8 + j] * rs * c_g[e] + c_skip[e] * bf2f((unsigned short)cvf[j])) * zv[hh * 8 + j]; } }
            } else {
                float sq = 0.f;
#pragma unroll
                for (int j = 0; j < 16; ++j) sq += ov[j] * ov[j];
                sq = sum8(sq);
                const float rs = rsqrtf(sq * (1.0f / 128.0f) + 1e-6f);
#pragma unroll
                for (int j = 0; j < 16; ++j) y[j] = ov[j] * rs * c_g[e0 + j] * zv[j];
            }
            bf16_t* mo = A.mix + (row0 + (size_t)c * 64 + row) * MIXW + MIXER * 512 + h * 128 + e0;
            u32x4 w0, w1; w0.x = pg8::cvt_pk_bf16(y[0], y[1]); w0.y = pg8::cvt_pk_bf16(y[2], y[3]); w0.z = pg8::cvt_pk_bf16(y[4], y[5]); w0.w = pg8::cvt_pk_bf16(y[6], y[7]);
            w1.x = pg8::cvt_pk_bf16(y[8], y[9]); w1.y = pg8::cvt_pk_bf16(y[10], y[11]); w1.z = pg8::cvt_pk_bf16(y[12], y[13]); w1.w = pg8::cvt_pk_bf16(y[14], y[15]);
            *(u32x4*)mo = w0; *(u32x4*)(mo + 8) = w1;
        }
        TP_END(5);
    }
    if (PASS == 0) {
#pragma unroll
        for (int s = 0; s < NT; ++s)
#pragma unroll
            for (int r = 0; r < 16; ++r) slot[((wave * NT + s) * 16 + r) * 64 + lane] = st[s][r];
        if (lane == 0) {
#pragma unroll
            for (int i = 0; i < NG * 8; ++i) { const int d = (wave + 8 * (i >> 3)) * 8 + (i & 7); slot[16384 + d] = ex2(MIXER == 2 ? carry_s : carry[i]); } }
        if (MIXER == 2 && te0 == 0 && (lane & 31) == 0) {
#pragma unroll
            for (int r = 0; r < 16; ++r) slot[16384 + 128 + 32 * td + (r & 3) + 8 * (r >> 2) + 4 * (lane >> 5)] = nacc[r]; }
    }
    asm volatile("s_waitcnt vmcnt(0) lgkmcnt(0)" ::: "memory"); FK_BAR();
}

__device__ __forceinline__ void mix_combine(float* U, int G, int wg, int wv) {
    int tid_ = wv * 64 + fk_lane(); asm volatile("" : "+v"(tid_)); const int tid = tid_;
    const int nslab = 3 * NBH * 16384, nvec = NBH * 128;
    for (int idx = wg * NTHR + tid; idx < nslab + nvec; idx += G * NTHR) {
        int mixer, bh, e, d; bool isn = false;
        if (idx < nslab) { mixer = idx / (NBH * 16384); const int rem = idx - mixer * (NBH * 16384); bh = rem >> 14; e = rem & 16383;
            if (mixer == 1 && e >= 8192) continue;
            const int ts = e >> 10, r = (e >> 6) & 15, ln = e & 63; const int wv = (mixer == 1) ? ts : (ts >> 1); const int tdd = (mixer == 1) ? (wv >> 2) : (wv >> 1);
            d = 32 * tdd + (r & 3) + 8 * (r >> 2) + 4 * (ln >> 5); }
        else { const int k = idx - nslab; mixer = 2; bh = k >> 7; d = k & 127; e = 16384 + 128 + d; isn = true; }
        (void)isn;
        float* base = U + (size_t)((mixer * NBH + bh) * NSEG) * USZ; float uu[NSEG], aa[NSEG];
#pragma unroll
        for (int sgm = 0; sgm < NSEG; ++sgm) { uu[sgm] = base[(size_t)sgm * USZ + e]; aa[sgm] = base[(size_t)sgm * USZ + 16384 + d]; }
        float carry = 0.f;
#pragma unroll
        for (int sgm = 0; sgm < NSEG; ++sgm) { base[(size_t)sgm * USZ + e] = carry; carry = aa[sgm] * carry + uu[sgm]; }
    }
}
#ifndef REP_INP
#define REP_INP 1
#endif
#ifndef REP_A
#define REP_A 1
#endif
#ifndef REP_B
#define REP_B 1
#endif
#ifndef REP_B0
#define REP_B0 1
#endif
#ifndef REP_B1
#define REP_B1 1
#endif
#ifndef REP_B2
#define REP_B2 1
#endif
#ifndef REP_Q
#define REP_Q 1
#endif
#ifndef REP_ATT
#define REP_ATT 1
#endif
template <class T> __device__ __forceinline__ T* opq(T* p) { auto g = (__attribute__((address_space(1))) T*)p; asm volatile("" : "+s"(g)); return (T*)g; }
__global__ void __launch_bounds__(NTHR, 2) fwd(Args a) {
    extern __shared__ __attribute__((aligned(16))) unsigned char lds_raw[];
    LAS unsigned char* lds = (LAS unsigned char*)lds_raw;
    unsigned char* ws = a.ws;
    const int wv = __builtin_amdgcn_readfirstlane((int)threadIdx.x >> 6);
    if (wv == 0) { const int l0 = fk_lane(); if (l0 < 8) ((LAS unsigned*)(lds + LDS_TP))[l0] = 0u; }
    __syncthreads();
    XcdBarrier bar = xcd_barrier_post((unsigned*)(ws + OFF_CTL), (volatile LAS unsigned*)(lds + LDS_BAR), wv);
    const int lo = a.ph_lo, hi = a.ph_hi, G = gridDim.x, wg = blockIdx.x; (void)lo; (void)hi;
    grp_census_post(bar, wg & 7, wv);
#ifdef FK_PHASE_RANGE
#define IN(k) (lo <= (k) && (k) < hi)
#else
#define IN(k) true
#endif
#ifdef PHPROBE
#define PH_BEGIN(k) unsigned long long ph_t0_##k = 0; if (PHPROBE == (k)) ph_t0_##k = __builtin_amdgcn_s_memrealtime();
#define PH_END(k) do { if (PHPROBE == (k) && wv == 0) { const unsigned long long d_ = __builtin_amdgcn_s_memrealtime() - ph_t0_##k; if (fk_lane() == 0) *(volatile LAS unsigned long long*)(lds + LDS_TP) += d_; } } while (0)
#else
#define PH_BEGIN(k)
#define PH_END(k) do { } while (0)
#endif
#define SEAM(k) do { if (IN(k) && IN((k) + 1)) { PH_BEGIN(100) xcd_barrier(bar, wv); PH_END(100); } } while (0)
#ifdef FK_SKEW_AT
#define SKEW(p) do { if (FK_SKEW_AT == (p) && (((wg & 7) & FK_SKEW_MASK) == FK_SKEW_VAL)) { for (int i_ = 0; i_ < FK_SKEW_N; ++i_) __builtin_amdgcn_s_sleep(127); } } while (0)
#else
#define SKEW(p) do { } while (0)
#endif
#define GSEAM(k) do { if (IN(k) && IN((k) + 1)) { PH_BEGIN(100) if (G == 256) grp_barrier(bar, wg & 7, 32u, wv); else xcd_barrier(bar, wv); PH_END(100); } } while (0)
    float* ssq = (float*)(ws + OFF_SSQ);
    const size_t qoff = (G == 256) ? (size_t)(wg & 7) * ((size_t)4096 * NPROJ * 2 - (size_t)4096 * 2048) : (size_t)0, ooff = (G == 256) ? qoff + (size_t)4096 * 2048 : SZ_XB;
    bf16_t* xb = (bf16_t*)(ws + OFF_XB);

    { PH_BEGIN(0) if (IN(0)) p0_prologue(a, lds, wv); PH_END(0); }
    SEAM(0);
    grp_census_read(bar, wg & 7, wv);
    if (IN(2)) { const int c = wg; int sub = -1, nsub = 96;
        if (G == 256) { if (c >= 144 && !(c >= 160 && c < 176)) sub = c < 160 ? c - 144 : 16 + (c - 176); } else { sub = c; nsub = G; }
        if (sub >= 0) p0_weights(a, lds, 1, sub, nsub, wv); }
#pragma unroll 1
    for (int l = 0; l < 2; ++l) {
        const int pb = 2 + 8 * l;
        if (IN(pb)) {
            { pg8::Gemm g{(const bf16_t*)(opq(ws) + OFF_MEMN + l * SZ_SQ), (const bf16_t*)(opq(ws) + OFF_WK + l * SZ_SQ), 1024, 1024, 1024}; pg8::StaticOrder So; So.init(1024, 1024, G, (wg + G - G / 2) % G);
              pg8::EpiBf16S E{(bf16_t*)(opq(ws) + OFF_KM + l * SZ_SQ), 1024, nullptr}; pg8::gemm_phase<pg8::EpiBf16S, pg8::StaticOrder>(lds, g, So, E, nullptr, wv); }
            { pg8::Gemm g{(const bf16_t*)(opq(ws) + OFF_WV + l * SZ_SQ), (const bf16_t*)(opq(ws) + OFF_MEMN + l * SZ_SQ), 1024, 1024, 1024}; pg8::StaticOrder So; So.init(1024, 1024, G, (wg + G - G / 2 - 32) % G);
              pg8::EpiVt E{(bf16_t*)(opq(ws) + OFF_VT + l * SZ_SQ)}; pg8::gemm_phase<pg8::EpiVt, pg8::StaticOrder>(lds, g, So, E, nullptr, wv); }
        }
        SKEW(5);
#ifdef FK_STAGGER
        if ((wg >> 3) & 1) { for (int i = 0; i < FK_STAGGER; ++i) __builtin_amdgcn_s_sleep(127); }
#endif
        PH_BEGIN(1)
        for (int rep = 0; rep < REP_INP; ++rep) if (IN(pb)) {
            pg8::Gemm g{opq(xb), (const bf16_t*)(opq(ws) + OFF_WIN + l * SZ_WIN), MR, NPAD, D}; pg8::StaticOrder So; So.init(MR, NPAD, G, wg);
            pg8::EpiInProj E{(bf16_t*)(opq(ws) + OFF_PROJ), (float*)(opq(ws) + OFF_EXT), opq(ssq) + (size_t)(2 * l) * 32768, (const float*)(opq(ws) + OFF_LB) + l * 512};
            pg8::gemm_phase<pg8::EpiInProj, pg8::StaticOrder>(lds, g, So, E, nullptr, wv);
        }
        PH_END(1);
        SEAM(pb);
        MixArgs MA{(const bf16_t*)(opq(ws) + OFF_PROJ), (const float*)(opq(ws) + OFF_EXT), (bf16_t*)(opq(ws) + OFF_MIX), opq(a.out)  ,
                   a.in[5] + l * 128, a.in[6] + l * 16 * 256, a.in[7] + l * 256, a.in[8] + l * 128, a.in[9] + l * 4 * 512, a.in[10] + l * 512, a.in[11] + l * 128 * 16, a.in[12] + l * 128 * 16, a.in[13] + l * 128 * 16,
                   a.in[14] + l * 4, a.in[15] + l * 4, a.in[16] + l * 512, a.in[17] + l * 512};
#define MIX_BH(u)  (G == 256 ? ((u) & 7) / 2 * 4 + ((u) >> 6) : (u) / NSEG)
#define MIX_SEG(u) (G == 256 ? ((u) & 1) * 8 + (((u) >> 3) & 7) : (u) % NSEG)
        for (int rep = 0; rep < REP_A; ++rep) {
        PH_BEGIN(2)
        if (IN(pb + 1)) {
            for (int u = wg; u < NBH * NSEG; u += G) mix_unit<0, 0>(lds, MA, MIX_BH(u), MIX_SEG(u), wv);
            for (int u = wg; u < NBH * NSEG; u += G) mix_unit<1, 0>(lds, MA, MIX_BH(u), MIX_SEG(u), wv);
            for (int u = wg; u < NBH * NSEG; u += G) mix_unit<2, 0>(lds, MA, MIX_BH(u), MIX_SEG(u), wv);
        }
        PH_END(2);
        SEAM(pb + 1);
        PH_BEGIN(3)
        if (IN(pb + 2)) mix_combine(MA.U, G, wg, wv);
        PH_END(3);
        SEAM(pb + 2);
        }
        SKEW(1);
        PH_BEGIN(4)
        for (int rep = 0; rep < REP_B; ++rep) if (IN(pb + 3)) {
            for (int r0 = 0; r0 < REP_B0; ++r0) for (int u = wg; u < NBH * NSEG; u += G) mix_unit<0, 1>(lds, MA, MIX_BH(u), MIX_SEG(u), wv);
            for (int r1 = 0; r1 < REP_B1; ++r1) for (int u = wg; u < NBH * NSEG; u += G) mix_unit<1, 1>(lds, MA, MIX_BH(u), MIX_SEG(u), wv);
            for (int r2 = 0; r2 < REP_B2; ++r2) for (int u = wg; u < NBH * NSEG; u += G) mix_unit<2, 1>(lds, MA, MIX_BH(u), MIX_SEG(u), wv);
        }
        PH_END(4);
        GSEAM(pb + 3);
        SKEW(2);
        PH_BEGIN(5)
        if (IN(pb + 4)) {
            pg8::Gemm g{(const bf16_t*)(opq(ws) + OFF_MIX), (const bf16_t*)(opq(ws) + OFF_WOUT + l * SZ_WOUT), MR, D, MIXW}; pg8::StaticOrder So; So.init(MR, D, G, wg);
            pg8::EpiResid E{l == 0 ? opq(a.in[0]) : (const float*)nullptr, opq(xb), opq(ssq) + (size_t)(2 * l + 1) * 32768};
            pg8::gemm_phase<pg8::EpiResid, pg8::StaticOrder>(lds, g, So, E, nullptr, wv);
        }
        PH_END(5);
        GSEAM(pb + 4);
        SKEW(3);
        PH_BEGIN(6)
        for (int rep = 0; rep < REP_Q; ++rep) if (IN(pb + 5)) {
            pg8::Gemm g{opq(xb), (const bf16_t*)(opq(ws) + OFF_WQ + l * SZ_SQ), MR, D, D}; pg8::StaticOrder So; So.init(MR, D, G, wg);
            pg8::EpiBf16S E{(bf16_t*)(opq(ws) + OFF_PROJ + qoff), D, opq(ssq) + (size_t)(2 * l + 1) * 32768};
            pg8::gemm_phase<pg8::EpiBf16S, pg8::StaticOrder>(lds, g, So, E, nullptr, wv);
        }
        PH_END(6);
        PH_BEGIN(7)
        for (int rep = 0; rep < REP_ATT; ++rep) if (IN(pb + 6)) { pg8::StaticOrder So; So.init(MR, D, G, wg);
            attn_phase(lds, (const bf16_t*)(opq(ws) + OFF_PROJ + qoff), (const bf16_t*)(opq(ws) + OFF_KM + l * SZ_SQ), (const bf16_t*)(opq(ws) + OFF_VT + l * SZ_SQ), (bf16_t*)(opq(ws) + OFF_PROJ + ooff), So, wv); }
        PH_END(7);
        GSEAM(pb + 6);
        SKEW(4);
        PH_BEGIN(8)
        if (IN(pb + 7)) {
            pg8::Gemm g{(const bf16_t*)(opq(ws) + OFF_PROJ + ooff), (const bf16_t*)(opq(ws) + OFF_WO + l * SZ_SQ), MR, D, D}; pg8::StaticOrder So; So.init(MR, D, G, wg);
            pg8::EpiResid E{(const float*)nullptr, opq(xb), opq(ssq) + (size_t)(2 * l + 2) * 32768};
            pg8::gemm_phase<pg8::EpiResid, pg8::StaticOrder>(lds, g, So, E, nullptr, wv);
        }
        PH_END(8);
        if (l == 0) { GSEAM(pb + 7);
            if (G == 256 && !(wg & 1)) { if (wv == 0 && fk_lane() == 0) { unsigned* cb = (unsigned*)(ws + OFF_CTL); XB_SPIN(xb_ld(&cb[GB_CNT((wg & 7) + 1)]) < 32u, cb); } __syncthreads(); } }
        else SEAM(pb + 7);
    }
    PH_BEGIN(18)
    if (IN(18)) { const int lane = fk_lane(), wave = wv; const float* gf = a.in[25]; const float* sq = ssq + (size_t)4 * 32768;
        for (int row = wg * 8 + wave; row < MR; row += G * 8) { const float rs = rsqrtf(sq[row] * (1.0f / 1024.0f) + 1e-6f);
#pragma unroll
            for (int i = 0; i < 2; ++i) { const int c0 = i * 512 + lane * 8; const u32x4 o = *(const u32x4*)(xb + (size_t)row * D + c0); const f32x4 g0 = *(const f32x4*)(gf + c0), g1 = *(const f32x4*)(gf + c0 + 4);
                const f32x4 x0 = (f32x4){__uint_as_float(o.x << 16), __uint_as_float(o.x & 0xffff0000u), __uint_as_float(o.y << 16), __uint_as_float(o.y & 0xffff0000u)};
                const f32x4 x1 = (f32x4){__uint_as_float(o.z << 16), __uint_as_float(o.z & 0xffff0000u), __uint_as_float(o.w << 16), __uint_as_float(o.w & 0xffff0000u)};
                float* p = a.out + (size_t)row * D + c0; *(f32x4*)p = x0 * rs * g0; *(f32x4*)(p + 4) = x1 * rs * g1; } } }
    PH_END(18);
#undef IN
#undef SEAM
#ifdef PHMIN
    { if (wv == 0 && fk_lane() == 0) { const unsigned long long acc = *(volatile LAS unsigned long long*)(lds + LDS_TP); atomicMax((unsigned*)(ws + OFF_CTL) + 16000, 0x80000000u - (unsigned)acc); }
      xcd_barrier(bar, wv);
      if (wv == 0 && fk_lane() == 0) { const unsigned m = __hip_atomic_load((unsigned*)(ws + OFF_CTL) + 16000, __ATOMIC_RELAXED, __HIP_MEMORY_SCOPE_AGENT); *(volatile LAS unsigned long long*)(lds + LDS_TP) = (unsigned long long)(0x80000000u - m); }
      __syncthreads(); }
#endif
#if defined(TPROBE) || defined(PHPROBE) || defined(ATP) || defined(GPROBE)
    if (wv == 0) { asm volatile("s_waitcnt vmcnt(0) lgkmcnt(0)" ::: "memory"); const unsigned long long acc = *(volatile LAS unsigned long long*)(lds + LDS_TP), t0 = __builtin_amdgcn_s_memrealtime(); while (__builtin_amdgcn_s_memrealtime() - t0 < acc) __builtin_amdgcn_s_sleep(8); }
#endif
}
}
static int fk_launch(void* const* d_in, void* d_out, void* d_ws, int lo, int hi, hipStream_t stream) {
    static int grid = 0;
    if (grid == 0) {
        int dev = 0, cus = 0, per_cu = 0;
        if (hipGetDevice(&dev) != hipSuccess || hipDeviceGetAttribute(&cus, hipDeviceAttributeMultiprocessorCount, dev) != hipSuccess) { grid = -1; return -1; }
        if (hipFuncSetAttribute((const void*)fk::fwd, hipFuncAttributeMaxDynamicSharedMemorySize, fk::LDS_BYTES) != hipSuccess) { fprintf(stderr, "hipFuncSetAttribute failed\n"); grid = -1; return -1; }
        if (hipOccupancyMaxActiveBlocksPerMultiprocessor(&per_cu, (const void*)fk::fwd, fk::NTHR, fk::LDS_BYTES) != hipSuccess || per_cu < 1) { fprintf(stderr, "occupancy query: %d\n", per_cu); (void)hipGetLastError(); grid = -1; return -1; }
        grid = cus;
    }
    if (grid < 0) return -1;
    (void)hipMemsetAsync(d_ws, 0, fk::ZERO_BYTES, stream);
    fk::Args a{};
    for (int i = 0; i < 26; ++i) a.in[i] = (const float*)d_in[i];
    a.out = (float*)d_out; a.ws = (unsigned char*)d_ws; a.ph_lo = lo; a.ph_hi = hi;
    hipLaunchKernelGGL(fk::fwd, dim3(grid), dim3(fk::NTHR), fk::LDS_BYTES, stream, a);
    return 0;
}
extern "C" void kernel_launch(void* const* d_in, const int* in_sizes, int n_in, void* d_out, int out_size, void* d_ws, size_t ws_size, hipStream_t stream) {
    if (n_in != 26 || ws_size < fk::WS_END || out_size != fk::MR * fk::D) { fprintf(stderr, "kernel_launch: unexpected shapes (n_in %d, ws %zu, out %d)\n", n_in, ws_size, out_size); return; }
    fk_launch(d_in, d_out, d_ws, 0, 19, stream);
}
```
